# Optimizing an MI355X kernel written in HIP

```python
import math
import jax, jax.numpy as jnp
from jax import lax
import numpy as np

D_MODEL = 4096
BATCH = 2
SEQ = 8192
DEPTH = 1
DEC_BATCH = 32
DEC_SEQ = 32
PAST_LEN = 1024

CHUNK = 64
MIX_WIDTH = D_MODEL
ATTN_WIDTH = D_MODEL // 2
HEAD_DIM = 64
N_Q_HEADS = ATTN_WIDTH // HEAD_DIM
N_KV_HEADS = 8
Q_PER_KV = N_Q_HEADS // N_KV_HEADS
KV_WIDTH = N_KV_HEADS * HEAD_DIM
WINDOW = 128
WINDOW_CHUNKS = WINDOW // CHUNK
ROPE_DIM = HEAD_DIM // 4
ROPE_THETA = 500000.0
ATTN_SCALE = HEAD_DIM ** -0.5
SSM_WIDTH = MIX_WIDTH - ATTN_WIDTH
SSM_HEAD_DIM = 64
N_SSM_HEADS = SSM_WIDTH // SSM_HEAD_DIM
N_SSM_GROUPS = 8
HEADS_PER_GROUP = N_SSM_HEADS // N_SSM_GROUPS
D_STATE = 128
BC_WIDTH = N_SSM_GROUPS * D_STATE
CONV_WIDTH = 4
CONV_CH = SSM_WIDTH + 2 * BC_WIDTH
SSD_CHUNK = CHUNK
FFN_HIDDEN = 4 * D_MODEL
RMS_EPS = 1e-6
NEG_INF = -1e30
SPLIT_POINTS = (ATTN_WIDTH,
                ATTN_WIDTH + KV_WIDTH,
                ATTN_WIDTH + 2 * KV_WIDTH,
                ATTN_WIDTH + 2 * KV_WIDTH + SSM_WIDTH,
                ATTN_WIDTH + 2 * KV_WIDTH + 2 * SSM_WIDTH,
                ATTN_WIDTH + 2 * KV_WIDTH + 2 * SSM_WIDTH + BC_WIDTH,
                ATTN_WIDTH + 2 * KV_WIDTH + 2 * SSM_WIDTH + 2 * BC_WIDTH)
IN_PROJ_WIDTH = ATTN_WIDTH + 2 * KV_WIDTH + 2 * SSM_WIDTH + 2 * BC_WIDTH + N_SSM_HEADS

kernel_name = "hymba_swa_sink_mamba2_streaming_step"


def rms_norm(x, w):
    xf = x.astype(jnp.float32)
    xf = xf * lax.rsqrt(jnp.mean(xf * xf, axis=-1, keepdims=True) + RMS_EPS)
    return (xf * w.astype(jnp.float32)).astype(x.dtype)


def partial_rope(x, pos):
    half = ROPE_DIM // 2
    inv_freq = ROPE_THETA ** (-jnp.arange(half, dtype=jnp.float32) / half)
    ang = pos.astype(jnp.float32)[:, None] * inv_freq[None, :]
    cos = jnp.cos(ang)[:, None, :]
    sin = jnp.sin(ang)[:, None, :]
    xr = x[..., :ROPE_DIM].astype(jnp.float32)
    x1, x2 = xr[..., :half], xr[..., half:]
    rot = jnp.concatenate([x1 * cos - x2 * sin, x2 * cos + x1 * sin], axis=-1)
    return jnp.concatenate([rot.astype(x.dtype), x[..., ROPE_DIM:]], axis=-1)


def sink_softmax(s, sink):
    m = jnp.maximum(jnp.max(s, axis=-1, keepdims=True), sink)
    e = jnp.exp(s - m)
    return e / (jnp.sum(e, axis=-1, keepdims=True) + jnp.exp(sink - m))


def band_attention(q, k, v, sinks):
    b, t = q.shape[:2]
    nc = t // CHUNK
    nband = WINDOW_CHUNKS + 1
    qb = q.reshape(b, nc, CHUNK, N_KV_HEADS, Q_PER_KV, HEAD_DIM)
    pad = ((0, 0), (WINDOW, 0), (0, 0), (0, 0))
    kp = jnp.pad(k, pad).reshape(b, nc + WINDOW_CHUNKS, CHUNK, N_KV_HEADS, HEAD_DIM)
    vp = jnp.pad(v, pad).reshape(b, nc + WINDOW_CHUNKS, CHUNK, N_KV_HEADS, HEAD_DIM)
    kb = jnp.concatenate([kp[:, i:i + nc] for i in range(nband)], axis=2)
    vb = jnp.concatenate([vp[:, i:i + nc] for i in range(nband)], axis=2)
    key_pos = jnp.arange(nc)[:, None] * CHUNK - WINDOW + jnp.arange(nband * CHUNK)[None, :]
    valid = (key_pos >= 0)[None, :, None, None, None, :]
    s = jnp.einsum('bcqhgd,bckhd->bchgqk', qb, kb).astype(jnp.float32) * ATTN_SCALE
    s = jnp.where(valid, s, NEG_INF)
    sink = sinks.astype(jnp.float32).reshape(N_KV_HEADS, Q_PER_KV)[None, None, :, :, None, None]
    p = sink_softmax(s, sink)
    o = jnp.einsum('bchgqk,bckhd->bcqhgd', p.astype(v.dtype), vb)
    return o.reshape(b, t, ATTN_WIDTH)


def cached_attention(q, k_all, v_all, sinks):
    b, t = q.shape[:2]
    qg = q.reshape(b, t, N_KV_HEADS, Q_PER_KV, HEAD_DIM)
    s = jnp.einsum('bqhgd,bkhd->bhgqk', qg, k_all).astype(jnp.float32) * ATTN_SCALE
    sink = sinks.astype(jnp.float32).reshape(N_KV_HEADS, Q_PER_KV)[None, :, :, None, None]
    p = sink_softmax(s, sink)
    o = jnp.einsum('bhgqk,bkhd->bqhgd', p.astype(v_all.dtype), v_all)
    return o.reshape(b, t, ATTN_WIDTH)


def causal_conv(xbc, conv_state, conv_w, conv_b):
    t = xbc.shape[1]
    xp = jnp.concatenate([conv_state.astype(xbc.dtype), xbc], axis=1)
    out = conv_b
    for i in range(CONV_WIDTH):
        out = out + xp[:, i:i + t] * conv_w[i]
    return jax.nn.silu(out), xp[:, xp.shape[1] - (CONV_WIDTH - 1):]


def segsum(x):
    t = x.shape[-1]
    xe = jnp.broadcast_to(x[..., None], x.shape + (t,))
    strict = jnp.tril(jnp.ones((t, t), dtype=bool), -1)
    xs = jnp.cumsum(jnp.where(strict, xe, 0.0), axis=-2)
    incl = jnp.tril(jnp.ones((t, t), dtype=bool), 0)
    return jnp.where(incl, xs, -jnp.inf)


def ssd(x, dt, a, bmat, cmat, init_state, chunk):
    b, t = x.shape[:2]
    nc = t // chunk
    xd = (x * dt[..., None]).reshape(b, nc, chunk, N_SSM_GROUPS, HEADS_PER_GROUP, SSM_HEAD_DIM)
    ad = (dt * a).reshape(b, nc, chunk, N_SSM_GROUPS, HEADS_PER_GROUP).transpose(0, 3, 4, 1, 2)
    bb = bmat.reshape(b, nc, chunk, N_SSM_GROUPS, D_STATE)
    cc = cmat.reshape(b, nc, chunk, N_SSM_GROUPS, D_STATE)
    a_cum = jnp.cumsum(ad, axis=-1)
    lmat = jnp.exp(segsum(ad))
    cb = jnp.einsum('bclgn,bcsgn->bgcls', cc, bb)
    y_diag = jnp.einsum('bgrcls,bcsgrp->bclgrp', cb[:, :, None] * lmat, xd)
    decay_states = jnp.exp(a_cum[..., -1:] - a_cum)
    states = jnp.einsum('bclgn,bgrcl,bclgrp->bcgrpn', bb, decay_states, xd)
    init = init_state.reshape(b, N_SSM_GROUPS, HEADS_PER_GROUP, SSM_HEAD_DIM, D_STATE)
    states = jnp.concatenate([init[:, None], states], axis=1)
    a_last = jnp.pad(a_cum[..., -1], ((0, 0), (0, 0), (0, 0), (1, 0)))
    decay_chunk = jnp.exp(segsum(a_last))
    new_states = jnp.einsum('bgrzc,bcgrpn->bzgrpn', decay_chunk, states)
    prev_states, final = new_states[:, :-1], new_states[:, -1]
    y_off = jnp.einsum('bclgn,bcgrpn,bgrcl->bclgrp', cc, prev_states, jnp.exp(a_cum))
    y = (y_diag + y_off).reshape(b, t, N_SSM_HEADS, SSM_HEAD_DIM)
    return y, final.reshape(b, N_SSM_HEADS, SSM_HEAD_DIM, D_STATE)


def gated_group_norm(y, z, w):
    g = y * jax.nn.silu(z)
    b, t, _ = g.shape
    gg = g.reshape(b, t, N_SSM_GROUPS, SSM_WIDTH // N_SSM_GROUPS)
    gg = gg * lax.rsqrt(jnp.mean(gg * gg, axis=-1, keepdims=True) + RMS_EPS)
    return gg.reshape(b, t, SSM_WIDTH) * w.astype(jnp.float32)


def trunk_layer(x, pos, past_k, past_v, conv_state, ssm_state, n_keep,
                norm_mix_w, w_in, q_norm_w, k_norm_w, attn_sinks, conv_w, conv_b,
                dt_bias, a_log, d_skip, ssm_norm_w, w_out, norm_ffn_w, w_up, w_down):
    b, t, _ = x.shape
    h = rms_norm(x, norm_mix_w)
    proj = jnp.einsum('btd,dp->btp', h, w_in)
    q, k, v, xs, z, bm, cm, dt_raw = jnp.split(proj, list(SPLIT_POINTS), axis=-1)
    q = rms_norm(q.reshape(b, t, N_Q_HEADS, HEAD_DIM), q_norm_w)
    k = rms_norm(k.reshape(b, t, N_KV_HEADS, HEAD_DIM), k_norm_w)
    v = v.reshape(b, t, N_KV_HEADS, HEAD_DIM)
    q = partial_rope(q, pos)
    k = partial_rope(k, pos)
    if past_k is None:
        attn = band_attention(q, k, v, attn_sinks)
        new_k = k[:, t - n_keep:]
        new_v = v[:, t - n_keep:]
    else:
        k_all = jnp.concatenate([past_k.astype(k.dtype), k], axis=1)
        v_all = jnp.concatenate([past_v.astype(v.dtype), v], axis=1)
        attn = cached_attention(q, k_all, v_all, attn_sinks)
        new_k = k_all[:, k_all.shape[1] - n_keep:]
        new_v = v_all[:, v_all.shape[1] - n_keep:]
    xbc = jnp.concatenate([xs, bm, cm], axis=-1)
    xbc, new_conv = causal_conv(xbc, conv_state, conv_w, conv_b)
    xs, bm, cm = jnp.split(xbc, [SSM_WIDTH, SSM_WIDTH + BC_WIDTH], axis=-1)
    dt = jax.nn.softplus(dt_raw.astype(jnp.float32) + dt_bias.astype(jnp.float32))
    a = -jnp.exp(a_log.astype(jnp.float32))
    xs_f = xs.astype(jnp.float32).reshape(b, t, N_SSM_HEADS, SSM_HEAD_DIM)
    y, new_ssm = ssd(xs_f, dt, a,
                     bm.astype(jnp.float32).reshape(b, t, N_SSM_GROUPS, D_STATE),
                     cm.astype(jnp.float32).reshape(b, t, N_SSM_GROUPS, D_STATE),
                     ssm_state.astype(jnp.float32), min(SSD_CHUNK, t))
    y = y + xs_f * d_skip.astype(jnp.float32)[:, None]
    y = gated_group_norm(y.reshape(b, t, SSM_WIDTH), z.astype(jnp.float32), ssm_norm_w)
    mix = jnp.concatenate([attn, y.astype(x.dtype)], axis=-1)
    x = x + jnp.einsum('btm,md->btd', mix, w_out)
    h2 = rms_norm(x, norm_ffn_w)
    u = jax.nn.relu(jnp.einsum('btd,df->btf', h2, w_up))
    x = x + jnp.einsum('btf,fd->btd', u * u, w_down)
    return x, new_k, new_v, new_conv, new_ssm.astype(x.dtype)


def setup_inputs(seed: int = 0) -> dict:
    key = jax.random.key(seed)
    ks = jax.random.split(key, 24)
    f32 = jnp.float32

    def nrm(k, shape, scale):
        return scale * jax.random.normal(k, shape, f32)

    n_keep = min(WINDOW, PAST_LEN)
    dt0 = jnp.exp(jax.random.uniform(ks[13], (DEPTH, N_SSM_HEADS), f32,
                                     math.log(1e-3), math.log(1e-1)))
    return {
        "x_prompt": nrm(ks[0], (BATCH, SEQ, D_MODEL), 1.0),
        "x_sample": nrm(ks[1], (DEC_BATCH, DEC_SEQ, D_MODEL), 1.0),
        "cache_k": nrm(ks[2], (DEPTH, DEC_BATCH, n_keep, N_KV_HEADS, HEAD_DIM), 1.0),
        "cache_v": nrm(ks[3], (DEPTH, DEC_BATCH, n_keep, N_KV_HEADS, HEAD_DIM), 1.0),
        "state_conv": nrm(ks[4], (DEPTH, DEC_BATCH, CONV_WIDTH - 1, CONV_CH), 1.0),
        "state_ssm": nrm(ks[5], (DEPTH, DEC_BATCH, N_SSM_HEADS, SSM_HEAD_DIM, D_STATE), 0.1),
        "norm_mix_w": 1.0 + nrm(ks[6], (DEPTH, D_MODEL), 0.02),
        "w_in": nrm(ks[7], (DEPTH, D_MODEL, IN_PROJ_WIDTH), D_MODEL ** -0.5),
        "q_norm_w": 1.0 + nrm(ks[8], (DEPTH, HEAD_DIM), 0.02),
        "k_norm_w": 1.0 + nrm(ks[9], (DEPTH, HEAD_DIM), 0.02),
        "attn_sinks": nrm(ks[10], (DEPTH, N_Q_HEADS), 0.5),
        "conv_w": nrm(ks[11], (DEPTH, CONV_WIDTH, CONV_CH), 0.5),
        "conv_b": nrm(ks[12], (DEPTH, CONV_CH), 0.01),
        "dt_bias": dt0 + jnp.log(-jnp.expm1(-dt0)),
        "a_log": jnp.log(jax.random.uniform(ks[14], (DEPTH, N_SSM_HEADS), f32, 1.0, 16.0)),
        "d_skip": 1.0 + nrm(ks[15], (DEPTH, N_SSM_HEADS), 0.1),
        "ssm_norm_w": 1.0 + nrm(ks[16], (DEPTH, SSM_WIDTH), 0.02),
        "w_out": nrm(ks[17], (DEPTH, MIX_WIDTH, D_MODEL), MIX_WIDTH ** -0.5),
        "norm_ffn_w": 1.0 + nrm(ks[18], (DEPTH, D_MODEL), 0.02),
        "w_up": nrm(ks[19], (DEPTH, D_MODEL, FFN_HIDDEN), D_MODEL ** -0.5),
        "w_down": nrm(ks[20], (DEPTH, FFN_HIDDEN, D_MODEL), FFN_HIDDEN ** -0.5),
    }


def reference(x_prompt, x_sample, cache_k, cache_v, state_conv, state_ssm,
              norm_mix_w, w_in, q_norm_w, k_norm_w, attn_sinks, conv_w, conv_b,
              dt_bias, a_log, d_skip, ssm_norm_w, w_out, norm_ffn_w, w_up, w_down):
    n_keep = cache_k.shape[2]
    t_p = x_prompt.shape[1]
    t_s = x_sample.shape[1]
    b_p = x_prompt.shape[0]
    pos_p = jnp.arange(t_p, dtype=jnp.int32)
    pos_s = PAST_LEN + jnp.arange(t_s, dtype=jnp.int32)
    hp, hs = x_prompt, x_sample
    k_p, v_p, c_p, s_p = [], [], [], []
    k_s, v_s, c_s, s_s = [], [], [], []
    for layer in range(DEPTH):
        lw = (norm_mix_w[layer], w_in[layer], q_norm_w[layer], k_norm_w[layer],
              attn_sinks[layer], conv_w[layer], conv_b[layer], dt_bias[layer],
              a_log[layer], d_skip[layer], ssm_norm_w[layer], w_out[layer],
              norm_ffn_w[layer], w_up[layer], w_down[layer])
        conv0 = jnp.zeros((b_p, CONV_WIDTH - 1, CONV_CH), x_prompt.dtype)
        ssm0 = jnp.zeros((b_p, N_SSM_HEADS, SSM_HEAD_DIM, D_STATE), jnp.float32)
        hp, nk, nv, nconv, nssm = trunk_layer(hp, pos_p, None, None, conv0, ssm0, n_keep, *lw)
        k_p.append(nk); v_p.append(nv); c_p.append(nconv); s_p.append(nssm)
        hs, nk, nv, nconv, nssm = trunk_layer(hs, pos_s, cache_k[layer], cache_v[layer],
                                              state_conv[layer], state_ssm[layer], n_keep, *lw)
        k_s.append(nk); v_s.append(nv); c_s.append(nconv); s_s.append(nssm)
    return (hp, hs, jnp.stack(k_p), jnp.stack(v_p), jnp.stack(c_p), jnp.stack(s_p),
            jnp.stack(k_s), jnp.stack(v_s), jnp.stack(c_s), jnp.stack(s_s))
```

```cpp
#include <hip/hip_runtime.h>
#include <cstdio>
#include <cstdint>
namespace pg8 {
#define PG8_LAS __attribute__((address_space(3)))
typedef unsigned short bf16_t;
typedef short bf16x8 __attribute__((ext_vector_type(8)));
typedef float f32x4 __attribute__((ext_vector_type(4)));
typedef unsigned u32x4 __attribute__((ext_vector_type(4)));
constexpr int BM = 256, BK = 64, HALF = 128, HTB = HALF * BK * 2  , STAGE_BYTES = 8 * HTB, NXCD = 8, WGM = 8;

__host__ __device__ __forceinline__ int lds_byte(int r, int c) { const int st = (r >> 4) * 2 + (c >> 5), rr = r & 15, cc = c & 31, ob = rr * 64 + cc * 2; return st * 1024 + (ob ^ (((ob >> 9) & 1) << 5)); }
__host__ __device__ __forceinline__ void stage_rc(int b, int& R, int& C) { const int st = b / 1024, sb = b % 1024, swz = sb ^ (((sb >> 9) & 1) << 5); R = (st >> 1) * 16 + swz / 64; C = (st & 1) * 32 + (swz % 64) / 2; }
__host__ __device__ __forceinline__ int perm32(int rho) { const int n = rho >> 4, i = rho & 15; return 8 * (i >> 2) + 4 * n + (i & 3); }

struct Unit { int pm, pn; };
struct Gemm { const bf16_t* A; const bf16_t* Bt; int M, N, K; };

struct StaticOrder {
    int nM, nN, nwg, G, c;
    __host__ __device__ void init(int M, int N, int G_, int c_) { nM = M / BM; nN = N / BM; nwg = nM * nN; G = G_; c = c_; }
    __host__ __device__ bool next(int i, Unit& u) const {
        const long L = (long)i * G + c; if (L >= nwg) return false;
        int wgid = (int)L; { const int q = nwg / NXCD, r = nwg % NXCD, xcd = wgid % NXCD, off = wgid / NXCD; wgid = (xcd < r ? xcd * (q + 1) : r * (q + 1) + (xcd - r) * q) + off; }
        const int nig = WGM * nN, gid = wgid / nig, fm = gid * WGM, gsz = (nM - fm) < WGM ? (nM - fm) : WGM;
        u.pm = fm + ((wgid % nig) % gsz); u.pn = (wgid % nig) / gsz; return true;
    }
    __device__ __forceinline__ void a_ready(const Unit&) const {}
    __device__ __forceinline__ void done(const Unit&) const {}
};

__device__ __forceinline__ unsigned cvt_pk_bf16(float lo, float hi) { unsigned r; asm volatile("v_cvt_pk_bf16_f32 %0, %1, %2" : "=v"(r) : "v"(lo), "v"(hi)); return r; }
typedef unsigned u32x2 __attribute__((ext_vector_type(2)));

struct EpiProj {
    static constexpr bool PERM = true, AFTER_DRAIN = false;
    bf16_t* O; int ldc; float* dt; int dt_pn;
    __device__ __forceinline__ void operator()(const f32x4 (&acc)[2][2][4][2], const Unit& u, int wr, int wc, int fr, int fq) const {
        const int row0 = u.pm * BM + wr * 64 + fr; const int col0 = u.pn * BM + wc * 32 + 8 * fq;
#pragma unroll
        for (int ai = 0; ai < 2; ++ai)
#pragma unroll
            for (int m = 0; m < 4; ++m) { bf16_t* rowp = O + (size_t)(row0 + ai * HALF + m * 16) * ldc + col0;
#pragma unroll
                for (int bj = 0; bj < 2; ++bj) { const f32x4 v0 = acc[ai][bj][m][0], v1 = acc[ai][bj][m][1];
                    u32x4 w; w.x = cvt_pk_bf16(v0[0], v0[1]); w.y = cvt_pk_bf16(v0[2], v0[3]); w.z = cvt_pk_bf16(v1[0], v1[1]); w.w = cvt_pk_bf16(v1[2], v1[3]);
                    *(u32x4*)(rowp + bj * HALF) = w; } }
        if (u.pn == dt_pn && wc == 0) {
#pragma unroll
            for (int ai = 0; ai < 2; ++ai)
#pragma unroll
                for (int m = 0; m < 4; ++m) { float* dp = dt + (size_t)(row0 + ai * HALF + m * 16) * 32 + 8 * fq;
                    *(f32x4*)(dp) = acc[ai][0][m][0]; *(f32x4*)(dp + 4) = acc[ai][0][m][1]; }
        }
    }
};
struct EpiOut {
    static constexpr bool PERM = false, AFTER_DRAIN = false;
    const float* xp; const float* xs; float* out; bf16_t* xb; float* part; int np_rows;
    __device__ __forceinline__ void operator()(const f32x4 (&acc)[2][2][4][2], const Unit& u, int wr, int wc, int fr, int fq) const {
        const int col0 = u.pn * BM + wc * 32 + 4 * fq;
#pragma unroll
        for (int ai = 0; ai < 2; ++ai)
#pragma unroll
            for (int m = 0; m < 4; ++m) { const int row = u.pm * BM + ai * HALF + wr * 64 + m * 16 + fr;
                const float* xr = (row < np_rows) ? xp + (size_t)row * 4096 : xs + (size_t)(row - np_rows) * 4096;
                float ss = 0.f;
#pragma unroll
                for (int bj = 0; bj < 2; ++bj)
#pragma unroll
                    for (int n = 0; n < 2; ++n) { const int c = col0 + bj * HALF + n * 16; const f32x4 v = *(const f32x4*)(xr + c) + acc[ai][bj][m][n];
                        *(f32x4*)(out + (size_t)row * 4096 + c) = v; ss += (v[0] * v[0] + v[1] * v[1]) + (v[2] * v[2] + v[3] * v[3]);
                        u32x2 w; w.x = cvt_pk_bf16(v[0], v[1]); w.y = cvt_pk_bf16(v[2], v[3]); *(u32x2*)(xb + (size_t)row * 4096 + c) = w; }
                ss += __shfl_xor(ss, 16); ss += __shfl_xor(ss, 32);
                if (fq == 0) part[(size_t)row * 64 + u.pn * 4 + wc] = ss; }
    }
};
struct EpiUp {
    static constexpr bool PERM = true, AFTER_DRAIN = false;
    bf16_t* O; int ldc; const float* rstd;
    __device__ __forceinline__ void operator()(const f32x4 (&acc)[2][2][4][2], const Unit& u, int wr, int wc, int fr, int fq) const {
        const int row0 = u.pm * BM + wr * 64 + fr; const int col0 = u.pn * BM + wc * 32 + 8 * fq;
#pragma unroll
        for (int ai = 0; ai < 2; ++ai)
#pragma unroll
            for (int m = 0; m < 4; ++m) { const int row = row0 + ai * HALF + m * 16; const float rs = rstd[row]; bf16_t* rowp = O + (size_t)row * ldc + col0;
#pragma unroll
                for (int bj = 0; bj < 2; ++bj) { f32x4 v0 = acc[ai][bj][m][0] * rs, v1 = acc[ai][bj][m][1] * rs;
#pragma unroll
                    for (int i = 0; i < 4; ++i) { const float a = v0[i] > 0.f ? v0[i] : 0.f, b = v1[i] > 0.f ? v1[i] : 0.f; v0[i] = a * a; v1[i] = b * b; }
                    u32x4 w; w.x = cvt_pk_bf16(v0[0], v0[1]); w.y = cvt_pk_bf16(v0[2], v0[3]); w.z = cvt_pk_bf16(v1[0], v1[1]); w.w = cvt_pk_bf16(v1[2], v1[3]);
                    *(u32x4*)(rowp + bj * HALF) = w; } }
    }
};
struct EpiDown {
    static constexpr bool PERM = false, AFTER_DRAIN = false;
    float* out;
    __device__ __forceinline__ void operator()(const f32x4 (&acc)[2][2][4][2], const Unit& u, int wr, int wc, int fr, int fq) const {
        const int col0 = u.pn * BM + wc * 32 + 4 * fq;
#pragma unroll
        for (int ai = 0; ai < 2; ++ai)
#pragma unroll
            for (int m = 0; m < 4; ++m) { float* rowp = out + (size_t)(u.pm * BM + ai * HALF + wr * 64 + m * 16 + fr) * 4096 + col0;
#pragma unroll
                for (int bj = 0; bj < 2; ++bj)
#pragma unroll
                    for (int n = 0; n < 2; ++n) { f32x4* p = (f32x4*)(rowp + bj * HALF + n * 16); *p = *p + acc[ai][bj][m][n]; } }
    }
};

template <class Epi, class Sched, bool ALIGN_EPI = false, bool SP2 = false>
__device__ __forceinline__ void gemm_phase(PG8_LAS unsigned char* lds, const Gemm g, const Sched& S, const Epi& E) {
    const int tid = threadIdx.x, wid = __builtin_amdgcn_readfirstlane(tid >> 6), lane = tid & 63, wr = wid >> 2, wc = wid & 3, fr = lane & 15, fq = lane >> 4;
    const int K = g.K, nt = K / BK;
    unsigned voffA[2], voffB[2];
#pragma unroll
    for (int i = 0; i < 2; ++i) { int R, C; stage_rc(tid * 16 + i * 8192, R, C); const int Rb = Epi::PERM ? ((R & ~31) + perm32(R & 31)) : R;
        voffA[i] = (unsigned)(R * K + C) * 2u; voffB[i] = (unsigned)(Rb * K + C) * 2u; }
    const size_t kstep = (size_t)(BK * 2);
    const size_t hstep = (size_t)HALF * K * 2;
    const size_t tstep = 2 * hstep;
    const unsigned ldsw = (unsigned)wid * 1024u;
    const int aoff = lds_byte(wr * 64 + fr, fq * 8), boff = lds_byte(wc * 32 + fr, fq * 8);
#define PG8_SA(b, h) (((b) * 2 + (h)) * HTB)
#define PG8_SB(b, h) ((4 + (b) * 2 + (h)) * HTB)
#define PG8_STAGE(bufoff, gbase, voff) do { _Pragma("unroll") for (int _i = 0; _i < 2; ++_i) \
        __builtin_amdgcn_global_load_lds((const unsigned*)((const char*)(gbase) + (voff)[_i]), (PG8_LAS unsigned*)(lds + (bufoff) + ldsw + _i * 8192), 16, 0, 0); } while (0)
#define PG8_LDA(dst, b, h) do { _Pragma("unroll") for (int m = 0; m < 4; ++m) _Pragma("unroll") for (int k = 0; k < 2; ++k) dst[m][k] = *(const PG8_LAS bf16x8*)(lds + PG8_SA(b, h) + aoff + m * 2048 + k * 1024); } while (0)
#define PG8_LDB(dst, b, h) do { _Pragma("unroll") for (int n = 0; n < 2; ++n) _Pragma("unroll") for (int k = 0; k < 2; ++k) dst[n][k] = *(const PG8_LAS bf16x8*)(lds + PG8_SB(b, h) + boff + n * 2048 + k * 1024); } while (0)
#define PG8_MMA(ai, bj, At, Bt) do { __builtin_amdgcn_s_setprio(1); _Pragma("unroll") for (int m = 0; m < 4; ++m) _Pragma("unroll") for (int n = 0; n < 2; ++n) _Pragma("unroll") for (int k = 0; k < 2; ++k) \
        acc[ai][bj][m][n] = __builtin_amdgcn_mfma_f32_16x16x32_bf16(Bt[n][k], At[m][k], acc[ai][bj][m][n], 0, 0, 0); __builtin_amdgcn_s_setprio(0); } while (0)
#define PG8_WAIT_V(n) asm volatile("s_waitcnt vmcnt(" #n ")" ::: "memory")
#define PG8_WAIT_L(n) asm volatile("s_waitcnt lgkmcnt(" #n ")" ::: "memory")
#define PG8_BAR __builtin_amdgcn_s_barrier()
#define PG8_SCHED __builtin_amdgcn_sched_barrier(0)
    Unit cur, nxt; int ui = 0;
    if (!S.next(0, cur)) return;
    f32x4 acc[2][2][4][2];
#pragma unroll
    for (int a = 0; a < 2; ++a)
#pragma unroll
        for (int b = 0; b < 2; ++b)
#pragma unroll
            for (int m = 0; m < 4; ++m)
#pragma unroll
                for (int n = 0; n < 2; ++n) acc[a][b][m][n] = (f32x4){0.f, 0.f, 0.f, 0.f};
    bf16x8 At[4][2], B0[2][2], B1[2][2];
    const char* cA = (const char*)g.A + (size_t)cur.pm * tstep; const char* cB = (const char*)g.Bt + (size_t)cur.pn * tstep;
    S.a_ready(cur);
    if constexpr (SP2) {
        PG8_STAGE(PG8_SB(0, 0), cB, voffB); PG8_STAGE(PG8_SB(0, 1), cB + hstep, voffB); PG8_STAGE(PG8_SA(0, 0), cA, voffA); PG8_STAGE(PG8_SA(0, 1), cA + hstep, voffA);
        if (wr == 1) PG8_BAR;
        PG8_WAIT_V(2); PG8_BAR;
        PG8_STAGE(PG8_SB(1, 0), cB + kstep, voffB); PG8_STAGE(PG8_SA(1, 0), cA + kstep, voffA); PG8_STAGE(PG8_SB(1, 1), cB + hstep + kstep, voffB);
        PG8_WAIT_V(6); PG8_BAR;
    } else {
        PG8_STAGE(PG8_SB(0, 0), cB, voffB); PG8_STAGE(PG8_SA(0, 0), cA, voffA); PG8_STAGE(PG8_SB(0, 1), cB + hstep, voffB); PG8_STAGE(PG8_SA(0, 1), cA + hstep, voffA);
        if (wr == 1) PG8_BAR;
        PG8_WAIT_V(4); PG8_BAR;
        PG8_STAGE(PG8_SB(1, 0), cB + kstep, voffB); PG8_STAGE(PG8_SA(1, 0), cA + kstep, voffA); PG8_STAGE(PG8_SB(1, 1), cB + hstep + kstep, voffB);
        PG8_WAIT_V(6); PG8_BAR;
    }
    for (;;) {
        const bool has_next = S.next(ui + 1, nxt);
        const char* nA = has_next ? (const char*)g.A + (size_t)nxt.pm * tstep : cA; const char* nB = has_next ? (const char*)g.Bt + (size_t)nxt.pn * tstep : cB;
        for (int t = 0; t < nt; t += 2) {
            const bool last = (t == nt - 2);
            const char* a1 = cA + (size_t)(t + 1) * kstep;
            const char* a2 = last ? nA : cA + (size_t)(t + 2) * kstep; const char* b2 = last ? nB : cB + (size_t)(t + 2) * kstep;
            const char* a3 = a2 + kstep; const char* b3 = b2 + kstep;
            if (last && has_next) S.a_ready(nxt);
            if constexpr (SP2) {
            PG8_LDB(B0, 0, 0); PG8_LDB(B1, 0, 1); PG8_SCHED; PG8_LDA(At, 0, 0); PG8_STAGE(PG8_SA(1, 1), a1 + hstep, voffA);
            PG8_WAIT_V(8); PG8_WAIT_L(0); PG8_BAR; PG8_MMA(0, 0, At, B0); PG8_MMA(0, 1, At, B1); PG8_BAR; PG8_SCHED;
            PG8_LDA(At, 0, 1); PG8_STAGE(PG8_SB(0, 0), b2, voffB); PG8_STAGE(PG8_SB(0, 1), b2 + hstep, voffB); PG8_STAGE(PG8_SA(0, 0), a2, voffA);
            PG8_WAIT_V(8); PG8_WAIT_L(0); PG8_BAR; PG8_MMA(1, 0, At, B0); PG8_MMA(1, 1, At, B1); PG8_BAR; PG8_SCHED;
            PG8_LDB(B0, 1, 0); PG8_LDB(B1, 1, 1); PG8_SCHED; PG8_LDA(At, 1, 0); PG8_STAGE(PG8_SA(0, 1), a2 + hstep, voffA);
            PG8_WAIT_V(8); PG8_WAIT_L(0); PG8_BAR; PG8_MMA(0, 0, At, B0); PG8_MMA(0, 1, At, B1); PG8_BAR; PG8_SCHED;
            PG8_LDA(At, 1, 1); PG8_STAGE(PG8_SB(1, 0), b3, voffB); PG8_STAGE(PG8_SB(1, 1), b3 + hstep, voffB); PG8_STAGE(PG8_SA(1, 0), a3, voffA);
            PG8_WAIT_V(8); PG8_WAIT_L(0); PG8_BAR; PG8_MMA(1, 0, At, B0); PG8_MMA(1, 1, At, B1); PG8_BAR; PG8_SCHED;
            } else {
            PG8_LDB(B0, 0, 0); PG8_SCHED; PG8_LDA(At, 0, 0); PG8_STAGE(PG8_SA(1, 1), a1 + hstep, voffA);
            PG8_WAIT_L(8); PG8_BAR; PG8_WAIT_L(0); PG8_MMA(0, 0, At, B0); PG8_BAR; PG8_SCHED;
            PG8_LDB(B1, 0, 1); PG8_STAGE(PG8_SB(0, 0), b2, voffB);
            PG8_BAR; PG8_WAIT_L(0); PG8_MMA(0, 1, At, B1); PG8_BAR;
            PG8_LDA(At, 0, 1); PG8_STAGE(PG8_SA(0, 0), a2, voffA);
            PG8_BAR; PG8_WAIT_L(0); PG8_MMA(1, 0, At, B0); PG8_BAR; PG8_SCHED;
            PG8_STAGE(PG8_SB(0, 1), b2 + hstep, voffB);
            PG8_WAIT_V(6); PG8_BAR; PG8_MMA(1, 1, At, B1); PG8_BAR;
            PG8_LDB(B0, 1, 0); PG8_SCHED; PG8_LDA(At, 1, 0); PG8_STAGE(PG8_SA(0, 1), a2 + hstep, voffA);
            PG8_WAIT_L(8); PG8_BAR; PG8_WAIT_L(0); PG8_MMA(0, 0, At, B0); PG8_BAR; PG8_SCHED;
            PG8_LDB(B1, 1, 1); PG8_STAGE(PG8_SB(1, 0), b3, voffB);
            PG8_BAR; PG8_WAIT_L(0); PG8_MMA(0, 1, At, B1); PG8_BAR;
            PG8_LDA(At, 1, 1); PG8_STAGE(PG8_SA(1, 0), a3, voffA);
            PG8_BAR; PG8_WAIT_L(0); PG8_MMA(1, 0, At, B0); PG8_BAR; PG8_SCHED;
            PG8_STAGE(PG8_SB(1, 1), b3 + hstep, voffB);
            PG8_WAIT_V(6); PG8_BAR; PG8_MMA(1, 1, At, B1); PG8_BAR;
            }
        }
        if constexpr (ALIGN_EPI) { if (wr == 0) PG8_BAR; }
        if constexpr (!Epi::AFTER_DRAIN) { E(acc, cur, wr, wc, fr, fq); S.done(cur); }
        if (!has_next) break;
#pragma unroll
        for (int a = 0; a < 2; ++a)
#pragma unroll
            for (int b = 0; b < 2; ++b)
#pragma unroll
                for (int m = 0; m < 4; ++m)
#pragma unroll
                    for (int n = 0; n < 2; ++n) acc[a][b][m][n] = (f32x4){0.f, 0.f, 0.f, 0.f};
        cur = nxt; cA = nA; cB = nB; ++ui;
        if constexpr (ALIGN_EPI) { if (wr == 1) PG8_BAR; }
    }
    PG8_WAIT_V(0);
    if constexpr (!ALIGN_EPI) { if (wr == 0) PG8_BAR; }
    PG8_BAR;
    if constexpr (Epi::AFTER_DRAIN) { E.fused(acc, cur, wr, wc, fr, fq, lds, wid, lane); S.done(cur); }
#undef PG8_SA
#undef PG8_SB
#undef PG8_STAGE
#undef PG8_LDA
#undef PG8_LDB
#undef PG8_MMA
#undef PG8_WAIT_V
#undef PG8_WAIT_L
#undef PG8_BAR
#undef PG8_SCHED
}
}
#ifndef PG8_SP2
#define PG8_SP2 true
#endif
#ifndef PG8_ALIGN
#define PG8_ALIGN true
#endif
constexpr int NWAVES = 8;
constexpr int DM = 4096, SEQ = 8192, NB_P = 2, NB_S = 32, DSEQ = 32, PAST = 1024;
constexpr int NTOK_P = NB_P * SEQ, NTOK_S = NB_S * DSEQ, M = NTOK_P + NTOK_S;
constexpr int NPROJ = 9248, LDP = 9472;
constexpr int OFF_Q = 0, OFF_K = 2048, OFF_V = 2560, OFF_XS = 3072, OFF_Z = 5120, OFF_B = 7168, OFF_C = 8192, OFF_DT = 9216;
constexpr int FF = 16384;
constexpr float RMS_EPS = 1e-6f;
constexpr size_t O_Y = 0, O_KP = (size_t)M * DM, O_VP = O_KP + 131072, O_CP = O_VP + 131072, O_SP = O_CP + 24576, O_KS = O_SP + 524288, O_VS = O_KS + 2097152,
                 O_CS = O_VS + 2097152, O_SS = O_CS + 393216, O_END = O_SS + 8388608;
constexpr size_t MiB = 1u << 20;
constexpr size_t WS_CTL = 0, CTL_ZERO_BYTES = 1 * MiB;
constexpr size_t WS_ROPE = 1 * MiB;
constexpr size_t WS_DT = 2 * MiB;
constexpr size_t WS_PART = 5 * MiB;
constexpr size_t WS_RSTD = 10 * MiB;
constexpr size_t WS_DECAY = 11 * MiB;
constexpr size_t WS_WUP = 16 * MiB;
constexpr size_t WS_WDN = 144 * MiB;
constexpr size_t WS_X1B = 272 * MiB;
constexpr size_t WS_WOUT = 408 * MiB;
constexpr size_t WS_U = 440 * MiB;
constexpr size_t WS_WIN = 440 * MiB;
constexpr size_t WS_H = 514 * MiB;
constexpr size_t WS_PROJ = 650 * MiB;
constexpr size_t WS_KN = 984 * MiB;
constexpr size_t WS_END = 1020 * MiB;
static_assert(WS_PROJ + (size_t)M * LDP * 2 <= WS_KN && WS_U + (size_t)M * FF * 2 <= WS_KN && WS_WIN + (size_t)LDP * DM * 2 <= WS_H && WS_H + (size_t)M * DM * 2 <= WS_PROJ, "ws map");
static_assert(WS_X1B + (size_t)M * DM * 2 <= WS_WOUT && WS_DT + (size_t)M * 32 * 4 <= WS_PART && WS_PART + (size_t)M * 64 * 4 <= WS_RSTD, "ws map 2");
constexpr int CW_TMO = 0, CW_CODE = 1, CW_BAR = 4096;

constexpr int RING_OFF = 0, RING_BYTES = 131072;
constexpr int LDSCTL_OFF = RING_BYTES, MISC_OFF = LDSCTL_OFF + 320;
constexpr int LDS_BYTES = 147456;
static_assert(MISC_OFF + 128 <= LDS_BYTES, "LDS map");

#define GAS __attribute__((address_space(1)))
#define LAS __attribute__((address_space(3)))
typedef unsigned short bf16;
typedef unsigned v4u __attribute__((ext_vector_type(4)));
typedef unsigned v2u __attribute__((ext_vector_type(2)));
typedef float f32x4 __attribute__((ext_vector_type(4)));
typedef short bf16x8 __attribute__((ext_vector_type(8)));
typedef GAS unsigned gu32;
#define RLX_AGENT __ATOMIC_RELAXED, __HIP_MEMORY_SCOPE_AGENT
#define LDS_WAIT() asm volatile("s_waitcnt lgkmcnt(0)" ::: "memory")
#define VM_WAIT() asm volatile("s_waitcnt vmcnt(0)" ::: "memory")
__device__ __forceinline__ unsigned f2bf(float f) { unsigned u = __builtin_bit_cast(unsigned, f); return (u + 0x7fffu + ((u >> 16) & 1u)) >> 16; }
__device__ __forceinline__ unsigned pk2(float lo, float hi) { return f2bf(lo) | (f2bf(hi) << 16); }
__device__ __forceinline__ float bf2f(unsigned short b) { return __builtin_bit_cast(float, (unsigned)b << 16); }
__device__ __forceinline__ float bflo(unsigned w) { return __builtin_bit_cast(float, w << 16); }
__device__ __forceinline__ float bfhi(unsigned w) { return __builtin_bit_cast(float, w & 0xffff0000u); }
__device__ __forceinline__ float silu_f(float v) { return v / (1.f + __expf(-v)); }
__device__ __forceinline__ float softplus_f(float v) { return v > 20.f ? v : log1pf(__expf(v)); }

#define XB_TMO      128
#define XB_XCNT(j)  (256  + 64 * (j))
#define XB_XSUB(j)  (1280 + 64 * (j))
#define XB_XGEN(j)  (2304 + 64 * (j))
#define XB_TOP      3328
#define XB_TOPGEN   3392
#define XCD_BAR_WORDS 3456
#define XB_SPIN_CAP (1u << 18)

__device__ __forceinline__ unsigned xb_ld(unsigned* p)              { return __hip_atomic_load(p, __ATOMIC_RELAXED, __HIP_MEMORY_SCOPE_AGENT); }
__device__ __forceinline__ unsigned xb_add(unsigned* p, unsigned v) { return __hip_atomic_fetch_add(p, v, __ATOMIC_RELAXED, __HIP_MEMORY_SCOPE_AGENT); }
__device__ __forceinline__ unsigned xb_xcc_id() { return (unsigned)__builtin_amdgcn_s_getreg((3 << 11) | 20) & 0xFu; }
#define XB_SPIN(cond, bar) do { unsigned _sp = 0; while (cond) { __builtin_amdgcn_s_sleep(1); \
    if ((++_sp & 255u) == 0u) { if (xb_ld(&(bar)[XB_TMO])) break; if (_sp > XB_SPIN_CAP) { atomicAdd(&(bar)[XB_TMO], 1u); break; } } } } while (0)

struct XcdBarrier {
    unsigned* bar; unsigned x;
    volatile LAS unsigned* st;
};

__device__ __forceinline__ XcdBarrier xcd_barrier_post(unsigned* bar, volatile LAS unsigned* st) {
    XcdBarrier b; b.bar = bar; b.x = xb_xcc_id(); b.st = st;
    if (threadIdx.x == 0) (void)xb_add(&bar[XB_XCNT(b.x)], 1u);
    return b;
}
__device__ __forceinline__ void xcd_barrier_complete(unsigned* bar, unsigned x, unsigned& nloc, unsigned& nx) {
    const unsigned G = gridDim.x * gridDim.y * gridDim.z;
    unsigned sum, cnt, mine, sp = 0u;
    for (;;) {
        sum = 0u; cnt = 0u; mine = 0u;
#pragma unroll
        for (unsigned j = 0; j < 16; ++j) { const unsigned c = xb_ld(&bar[XB_XCNT(j)]); sum += c; cnt += (c > 0u) ? 1u : 0u; mine = (j == x) ? c : mine; }
        if (sum == G) break;
        __builtin_amdgcn_s_sleep(1);
        if ((++sp & 255u) == 0u) { if (xb_ld(&bar[XB_TMO])) break; if (sp > XB_SPIN_CAP) { atomicAdd(&bar[XB_TMO], 1u); break; } }
    }
    nloc = mine > 0u ? mine : 1u; nx = cnt > 0u ? cnt : 1u;
}

__device__ __forceinline__ void xcd_barrier(const XcdBarrier& b) {
    asm volatile("s_waitcnt vmcnt(0)" ::: "memory");
    __syncthreads();
    if (threadIdx.x == 0) {
        unsigned* bar = b.bar;
        __builtin_amdgcn_s_waitcnt(0);
        unsigned nloc = b.st[0], nx = b.st[1];
        if (nloc == 0u) { xcd_barrier_complete(bar, b.x, nloc, nx); b.st[0] = nloc; b.st[1] = nx; }
        const unsigned old = xb_add(&bar[XB_XSUB(b.x)], 1u);
        const unsigned gen = old / nloc;
        if (old + 1u == (gen + 1u) * nloc) {
            __builtin_amdgcn_fence(__ATOMIC_RELEASE, "agent");
            asm volatile("s_waitcnt vmcnt(0)" ::: "memory");
            const unsigned og = xb_add(&bar[XB_TOP], 1u);
            const unsigned tg = og / nx;
            if (og + 1u == (tg + 1u) * nx) xb_add(&bar[XB_TOPGEN], 1u);
            else XB_SPIN(xb_ld(&bar[XB_TOPGEN]) == tg, bar);
            __builtin_amdgcn_fence(__ATOMIC_ACQUIRE, "agent");
            xb_add(&bar[XB_XGEN(b.x)], 1u);
            asm volatile("s_waitcnt vmcnt(0)" ::: "memory");
        } else {
            XB_SPIN(xb_ld(&bar[XB_XGEN(b.x)]) == gen, bar);
            __builtin_amdgcn_fence(__ATOMIC_ACQUIRE, "agent");
            asm volatile("s_waitcnt vmcnt(0)" ::: "memory");
        }
    }
    __syncthreads();
}

struct Args {
    const float* in[21]; float* out; unsigned char* ws; int ph_lo, ph_hi;
};
enum { IN_XP = 0, IN_XS, IN_CK, IN_CV, IN_SCONV, IN_SSSM, IN_NMIX, IN_WIN, IN_QNW, IN_KNW, IN_SINK, IN_CONVW, IN_CONVB, IN_DTB, IN_ALOG, IN_DSKIP, IN_SNW, IN_WOUT, IN_NFFN, IN_WUP, IN_WDN };
enum { PH_PRO = 0, PH_INPROJ = 1, PH_MIXA = 2, PH_MIXB = 3, PH_MIXC = 4, PH_OUT = 5, PH_RSTD = 6, PH_UP = 7, PH_DOWN = 8, PH_N = 9 };

struct Frame {
    LAS unsigned char* lds;
    volatile LAS unsigned* MISC;
    gu32* ctl;
    int tid, lane, wave;
    int vcu, G;
};
__device__ __forceinline__ float wave_sum(float v) {
#pragma unroll
    for (int o = 1; o < 64; o <<= 1) v += __shfl_xor(v, o);
    return v;
}
__device__ __forceinline__ void p0_transpose_item(const float* W, int K, int N, bf16* WT, const float* kscale, LAS float* scr, int item, int lane) {
    const int nblk = N / 32, kb = item / nblk, nb = item % nblk, k0 = 64 * kb, n0 = 32 * nb;
#pragma unroll 8
    for (int i = 0; i < 32; ++i) { const int kk = 2 * i + (lane >> 5); float v = W[(size_t)(k0 + kk) * N + n0 + (lane & 31)]; if (kscale) v *= kscale[k0 + kk]; scr[kk * 33 + (lane & 31)] = v; }
    LDS_WAIT(); asm volatile("" ::: "memory");
    const int c = lane & 7;
#pragma unroll
    for (int j = 0; j < 4; ++j) { const int n = (lane >> 3) + 8 * j; const LAS float* s = scr + (8 * c) * 33 + n;
        v4u o; o.x = pk2(s[0 * 33], s[1 * 33]); o.y = pk2(s[2 * 33], s[3 * 33]); o.z = pk2(s[4 * 33], s[5 * 33]); o.w = pk2(s[6 * 33], s[7 * 33]);
        *(GAS v4u*)(WT + (size_t)(n0 + n) * K + k0 + 8 * c) = o; }
    LDS_WAIT(); asm volatile("" ::: "memory");
}
__device__ __forceinline__ void rms_row_to_bf16(int lane, const float* xrow, const float* w, bf16* orow) {
    const GAS f32x4* xr = (const GAS f32x4*)xrow + lane; const GAS f32x4* wr = (const GAS f32x4*)w + lane;
    f32x4 v[16]; float s = 0.f;
#pragma unroll
    for (int j = 0; j < 16; ++j) { v[j] = xr[64 * j]; s += (v[j].x * v[j].x + v[j].y * v[j].y) + (v[j].z * v[j].z + v[j].w * v[j].w); }
    const float rstd = 1.f / sqrtf(wave_sum(s) * (1.f / DM) + RMS_EPS);
    GAS unsigned long long* o8 = (GAS unsigned long long*)orow + lane;
#pragma unroll
    for (int j = 0; j < 16; ++j) { const f32x4 g = wr[64 * j];
        o8[64 * j] = (unsigned long long)pk2(v[j].x * rstd * g.x, v[j].y * rstd * g.y) | ((unsigned long long)pk2(v[j].z * rstd * g.z, v[j].w * rstd * g.w) << 32); }
}
__device__ __forceinline__ void p0_prologue(Frame& F, const Args& A) {
    unsigned char* ws = A.ws;
    LAS float* scr = (LAS float*)(F.lds + RING_OFF + F.wave * 16384);
    const int gw = F.vcu * NWAVES + F.wave, NGW = F.G * NWAVES;
    constexpr int I_IN = (DM / 64) * (NPROJ / 32), I_OUT = (DM / 64) * (DM / 32), I_UP = (DM / 64) * (FF / 32), I_DN = (FF / 64) * (DM / 32);
    constexpr int NITEMS = I_IN + I_OUT + I_UP + I_DN;
    for (int it = gw; it < NITEMS; it += NGW) {
        int r = it;
        if (r < I_IN) { p0_transpose_item(A.in[IN_WIN], DM, NPROJ, (bf16*)(ws + WS_WIN), nullptr, scr, r, F.lane); continue; } r -= I_IN;
        if (r < I_OUT) { p0_transpose_item(A.in[IN_WOUT], DM, DM, (bf16*)(ws + WS_WOUT), nullptr, scr, r, F.lane); continue; } r -= I_OUT;
        if (r < I_UP) { p0_transpose_item(A.in[IN_WUP], DM, FF, (bf16*)(ws + WS_WUP), A.in[IN_NFFN], scr, r, F.lane); continue; } r -= I_UP;
        p0_transpose_item(A.in[IN_WDN], FF, DM, (bf16*)(ws + WS_WDN), nullptr, scr, r, F.lane);
    }
    { GAS v4u* z = (GAS v4u*)(ws + WS_WIN + (size_t)NPROJ * DM * 2); const int nz = (LDP - NPROJ) * DM * 2 / 16;
      for (int i = gw * 64 + F.lane; i < nz; i += NGW * 64) z[i] = (v4u){0u, 0u, 0u, 0u}; }
    { float* rope = (float*)(ws + WS_ROPE);
      for (int i = gw * 64 + F.lane; i < SEQ * 8; i += NGW * 64) { const int pos = i >> 3, k = i & 7;
          const double inv = pow(500000.0, -(double)k / 8.0); const double ang = (double)pos * inv; rope[pos * 16 + k] = (float)cos(ang); rope[pos * 16 + 8 + k] = (float)sin(ang); } }
    bf16* H = (bf16*)(ws + WS_H);
    for (int m = gw; m < M; m += NGW) { const float* xr = m < NTOK_P ? A.in[IN_XP] + (size_t)m * DM : A.in[IN_XS] + (size_t)(m - NTOK_P) * DM;
        rms_row_to_bf16(F.lane, xr, A.in[IN_NMIX], H + (size_t)m * DM); }
}

__global__ void __launch_bounds__(NWAVES * 64, 2) mega_fwd(Args args) {
    extern __shared__ __attribute__((aligned(16))) unsigned char lds[];
    Frame F;
    F.lds = (LAS unsigned char*)lds;
    F.MISC = (volatile LAS unsigned*)(F.lds + MISC_OFF);
    F.tid = threadIdx.x; F.lane = F.tid & 63; F.wave = __builtin_amdgcn_readfirstlane(F.tid >> 6);
    F.G = gridDim.x; { const int bx = blockIdx.x; F.vcu = (F.G % 8 == 0) ? (bx % 8) * (F.G / 8) + bx / 8 : bx; }
    unsigned char* ws = args.ws;
    F.ctl = (gu32*)(ws + WS_CTL);
    for (int u = F.tid; u < (LDS_BYTES - LDSCTL_OFF) / 4; u += NWAVES * 64) ((LAS unsigned*)(F.lds + LDSCTL_OFF))[u] = 0u;
    __syncthreads();
    const int lo = args.ph_lo, hi = args.ph_hi;
    const bool multi = (hi - lo) > 1;
    XcdBarrier bar; bar.bar = (unsigned*)(F.ctl + CW_BAR); bar.x = 0; bar.st = nullptr;
    if (multi) bar = xcd_barrier_post((unsigned*)(F.ctl + CW_BAR), F.MISC + 8);
#define IN(k) (lo <= (k) && (k) < hi)
#define SEAM(k) do { if (IN(k) && IN((k) + 1)) xcd_barrier(bar); } while (0)

    if (IN(PH_PRO)) { p0_prologue(F, args); SEAM(PH_PRO); }

    if (IN(PH_INPROJ)) {
        pg8::Gemm g{(const bf16*)(ws + WS_H), (const bf16*)(ws + WS_WIN), M, LDP, DM}; pg8::StaticOrder S; S.init(M, LDP, F.G, (int)blockIdx.x);
        pg8::EpiProj E{(bf16*)(ws + WS_PROJ), LDP, (float*)(ws + WS_DT), OFF_DT / 256};
        pg8::gemm_phase<pg8::EpiProj, pg8::StaticOrder, PG8_ALIGN, PG8_SP2>(F.lds + RING_OFF, g, S, E);
        SEAM(PH_INPROJ);
    }
    if (IN(PH_OUT)) {
        pg8::Gemm g{(const bf16*)(ws + WS_H), (const bf16*)(ws + WS_WOUT), M, DM, DM}; pg8::StaticOrder S; S.init(M, DM, F.G, (int)blockIdx.x);
        pg8::EpiOut E{args.in[IN_XP], args.in[IN_XS], args.out + O_Y, (bf16*)(ws + WS_X1B), (float*)(ws + WS_PART), NTOK_P};
        pg8::gemm_phase<pg8::EpiOut, pg8::StaticOrder, PG8_ALIGN, PG8_SP2>(F.lds + RING_OFF, g, S, E);
        SEAM(PH_OUT);
    }
    if (IN(PH_RSTD)) {
        const float* part = (const float*)(ws + WS_PART); float* rstd = (float*)(ws + WS_RSTD);
        const int gw = F.vcu * NWAVES + F.wave, NGW = F.G * NWAVES;
        for (int m = gw; m < M; m += NGW) { const float s = wave_sum(part[(size_t)m * 64 + F.lane]); if (F.lane == 0) rstd[m] = 1.f / sqrtf(s * (1.f / DM) + RMS_EPS); }
        SEAM(PH_RSTD);
    }
    if (IN(PH_UP)) {
        pg8::Gemm g{(const bf16*)(ws + WS_X1B), (const bf16*)(ws + WS_WUP), M, FF, DM}; pg8::StaticOrder S; S.init(M, FF, F.G, (int)blockIdx.x);
        pg8::EpiUp E{(bf16*)(ws + WS_U), FF, (const float*)(ws + WS_RSTD)};
        pg8::gemm_phase<pg8::EpiUp, pg8::StaticOrder, PG8_ALIGN, PG8_SP2>(F.lds + RING_OFF, g, S, E);
        SEAM(PH_UP);
    }
    if (IN(PH_DOWN)) {
        pg8::Gemm g{(const bf16*)(ws + WS_U), (const bf16*)(ws + WS_WDN), M, DM, FF}; pg8::StaticOrder S; S.init(M, DM, F.G, (int)blockIdx.x);
        pg8::EpiDown E{args.out + O_Y};
        pg8::gemm_phase<pg8::EpiDown, pg8::StaticOrder, PG8_ALIGN, PG8_SP2>(F.lds + RING_OFF, g, S, E);
    }
#undef IN
#undef SEAM
}

struct RowInfo { int samp, b, t, pos; };
__device__ __forceinline__ RowInfo row_info(int row) { RowInfo r; if (row < NTOK_P) { r.samp = 0; r.b = row >> 13; r.t = row & (SEQ - 1); r.pos = r.t; } else { const int q = row - NTOK_P; r.samp = 1; r.b = q >> 5; r.t = q & 31; r.pos = PAST + r.t; } return r; }

__global__ void __launch_bounds__(256) nv_prep(Args A) {
    const int row = blockIdx.x, tid = threadIdx.x, lane = tid & 63, w = tid >> 6;
    const RowInfo ri = row_info(row);
    unsigned char* ws = A.ws; const bf16* proj = (const bf16*)(ws + WS_PROJ); const bf16* pr = proj + (size_t)row * LDP;
    const float* rope = (const float*)(ws + WS_ROPE) + ri.pos * 16; float* kn = (float*)(ws + WS_KN) + (size_t)row * 512; float* bc = (float*)(ws + WS_X1B) + (size_t)row * 2048;
    float* out = A.out;
    for (int hh = 0; hh < 2; ++hh) { const int h = w + 4 * hh;
        const float kv = bf2f(pr[OFF_K + h * 64 + lane]);
        const float ss = wave_sum(kv * kv);
        const float kk = kv * (1.f / sqrtf(ss * (1.f / 64.f) + RMS_EPS)) * A.in[IN_KNW][lane];
        const float partner = __shfl_xor(kk, 8);
        float o = kk;
        if (lane < 16) { const float c = rope[lane & 7], s = rope[8 + (lane & 7)]; o = (lane < 8) ? kk * c - partner * s : kk * c + partner * s; }
        kn[h * 64 + lane] = o;
        const float vv = bf2f(pr[OFF_V + h * 64 + lane]);
        if (!ri.samp) { if (ri.t >= SEQ - 128) { const size_t off = ((size_t)(ri.b * 128 + ri.t - (SEQ - 128)) * 8 + h) * 64 + lane; out[O_KP + off] = o; out[O_VP + off] = vv; } }
        else { const size_t off = ((size_t)(ri.b * 128 + 96 + ri.t) * 8 + h) * 64 + lane; out[O_KS + off] = o; out[O_VS + off] = vv; }
    }
    if (ri.samp) {
        for (int i = tid; i < 3 * 512; i += 256) { const int j = ri.t * 3 + i / 512, e = i % 512; const size_t src = ((size_t)(ri.b * 128 + 32 + j)) * 512 + e, dst = ((size_t)(ri.b * 128 + j)) * 512 + e;
            out[O_KS + dst] = A.in[IN_CK][src]; out[O_VS + dst] = A.in[IN_CV][src]; }
    }
    for (int i = 0; i < 8; ++i) { const int c2 = tid * 8 + i, cc = 2048 + c2; float acc = A.in[IN_CONVB][cc];
        for (int j = 0; j < 4; ++j) { const int tt = ri.t - 3 + j; float v;
            if (tt >= 0) v = bf2f(proj[(size_t)(row - 3 + j) * LDP + OFF_B + c2]); else v = ri.samp ? A.in[IN_SCONV][((size_t)ri.b * 3 + (3 + tt)) * 4096 + cc] : 0.f;
            acc += A.in[IN_CONVW][j * 4096 + cc] * v; }
        bc[c2] = silu_f(acc); }
    const int tl = ri.samp ? DSEQ : SEQ;
    if (ri.t >= tl - 3) { float* dst = out + (ri.samp ? O_CS : O_CP) + ((size_t)ri.b * 3 + (ri.t - (tl - 3))) * 4096;
        for (int c = tid; c < 4096; c += 256) dst[c] = bf2f(pr[c < 2048 ? OFF_XS + c : OFF_B + (c - 2048)]); }
}

template <bool SAMPLE> __global__ void __launch_bounds__(256) nv_attn(Args A) {
    const int tid = threadIdx.x, lane = tid & 63, g = tid >> 6;
    unsigned char* ws = A.ws; const bf16* proj = (const bf16*)(ws + WS_PROJ); const float* knb = (const float*)(ws + WS_KN); bf16* mix = (bf16*)(ws + WS_H);
    int b, c, kvh, row, pos; bool valid = true;
    if (!SAMPLE) { const int blk = blockIdx.x; b = blk >> 10; c = (blk >> 3) & 127; kvh = blk & 7; row = b * SEQ + c * 64 + lane; pos = c * 64 + lane; }
    else { const int blk = blockIdx.x; b = blk >> 3; c = 0; kvh = blk & 7; const int t = lane & 31; valid = lane < 32; row = NTOK_P + b * DSEQ + t; pos = PAST + t; }
    const int qh = kvh * 4 + g;
    float q[64]; float ss = 0.f;
    for (int d = 0; d < 64; ++d) { q[d] = bf2f(proj[(size_t)row * LDP + OFF_Q + qh * 64 + d]); ss += q[d] * q[d]; }
    const float rs = 1.f / sqrtf(ss * (1.f / 64.f) + RMS_EPS);
    for (int d = 0; d < 64; ++d) q[d] = q[d] * rs * A.in[IN_QNW][d];
    { const float* rope = (const float*)(ws + WS_ROPE) + pos * 16;
      for (int i = 0; i < 8; ++i) { const float cs = rope[i], sn = rope[8 + i], x1 = q[i], x2 = q[8 + i]; q[i] = x1 * cs - x2 * sn; q[8 + i] = x2 * cs + x1 * sn; } }
    for (int d = 0; d < 64; ++d) q[d] *= 0.125f;
    float m = A.in[IN_SINK][qh], l = 1.f; float o[64];
    for (int d = 0; d < 64; ++d) o[d] = 0.f;
    const int nk = SAMPLE ? 160 : 192;
    for (int kk = 0; kk < nk; ++kk) {
        const float* kp; const float* vpf = nullptr; const bf16* vpb = nullptr;
        if (!SAMPLE) { const int kt = c * 64 - 128 + kk; if (kt < 0) continue; const size_t kr = (size_t)b * SEQ + kt; kp = knb + kr * 512 + kvh * 64; vpb = proj + kr * LDP + OFF_V + kvh * 64; }
        else if (kk < 128) { const size_t off = ((size_t)(b * 128 + kk) * 8 + kvh) * 64; kp = A.in[IN_CK] + off; vpf = A.in[IN_CV] + off; }
        else { const size_t kr = (size_t)NTOK_P + b * DSEQ + (kk - 128); kp = knb + kr * 512 + kvh * 64; vpb = proj + kr * LDP + OFF_V + kvh * 64; }
        float s = 0.f;
        for (int d = 0; d < 64; ++d) s += q[d] * kp[d];
        const float mn = fmaxf(m, s), corr = __expf(m - mn), p = __expf(s - mn);
        l = l * corr + p; m = mn;
        if (vpf) { for (int d = 0; d < 64; ++d) o[d] = o[d] * corr + p * vpf[d]; }
        else { for (int d = 0; d < 64; ++d) o[d] = o[d] * corr + p * bf2f(vpb[d]); }
    }
    if (valid) { const float il = 1.f / l; bf16* dst = mix + (size_t)row * DM + qh * 64;
        for (int d = 0; d < 64; d += 2) *(unsigned*)(dst + d) = pk2(o[d] * il, o[d + 1] * il); }
}

__global__ void __launch_bounds__(256) nv_scan(Args A) {
    __shared__ float sB[16][256];
    const int tid = threadIdx.x, p = tid & 63, r = tid >> 6;
    const int seq = blockIdx.x >> 3, g = blockIdx.x & 7, h = g * 4 + r, ch = h * 64 + p;
    const bool samp = seq >= NB_P; const int b = samp ? seq - NB_P : seq; const int T = samp ? DSEQ : SEQ; const int row0 = samp ? NTOK_P + b * DSEQ : b * SEQ;
    unsigned char* ws = A.ws; const bf16* proj = (const bf16*)(ws + WS_PROJ); const float* bc = (const float*)(ws + WS_X1B); const float* dtr = (const float*)(ws + WS_DT);
    bf16* ybuf = (bf16*)(ws + WS_WIN);
    const float a = -__expf(A.in[IN_ALOG][h]), dtb = A.in[IN_DTB][h], D = A.in[IN_DSKIP][h];
    const float w0 = A.in[IN_CONVW][ch], w1 = A.in[IN_CONVW][4096 + ch], w2 = A.in[IN_CONVW][8192 + ch], w3 = A.in[IN_CONVW][12288 + ch], cb = A.in[IN_CONVB][ch];
    float x1 = 0.f, x2 = 0.f, x3 = 0.f; float st[128];
    if (samp) { x1 = A.in[IN_SCONV][((size_t)b * 3 + 0) * 4096 + ch]; x2 = A.in[IN_SCONV][((size_t)b * 3 + 1) * 4096 + ch]; x3 = A.in[IN_SCONV][((size_t)b * 3 + 2) * 4096 + ch];
        const float* s0 = A.in[IN_SSSM] + ((size_t)(b * 32 + h) * 64 + p) * 128;
        for (int n = 0; n < 128; ++n) st[n] = s0[n]; }
    else { for (int n = 0; n < 128; ++n) st[n] = 0.f; }
    for (int t0 = 0; t0 < T; t0 += 16) {
        __syncthreads();
        for (int i = tid; i < 16 * 256; i += 256) { const int tt = i >> 8, j = i & 255; sB[tt][j] = bc[(size_t)(row0 + t0 + tt) * 2048 + (j < 128 ? g * 128 + j : 1024 + g * 128 + (j - 128))]; }
        __syncthreads();
        for (int tt = 0; tt < 16; ++tt) { const int row = row0 + t0 + tt;
            const float xr = bf2f(proj[(size_t)row * LDP + OFF_XS + ch]);
            const float xc = silu_f(cb + w0 * x1 + w1 * x2 + w2 * x3 + w3 * xr); x1 = x2; x2 = x3; x3 = xr;
            const float dtv = softplus_f(dtr[(size_t)row * 32 + h] + dtb), dA = __expf(dtv * a), xdt = xc * dtv;
            float y = 0.f;
#pragma unroll
            for (int n = 0; n < 128; ++n) { st[n] = st[n] * dA + xdt * sB[tt][n]; y += sB[tt][128 + n] * st[n]; }
            y += xc * D;
            ybuf[(size_t)row * 2048 + ch] = (bf16)f2bf(y); }
    }
    float* so = A.out + (samp ? O_SS : O_SP) + ((size_t)(b * 32 + h) * 64 + p) * 128;
    for (int n = 0; n < 128; ++n) so[n] = st[n];
}

__global__ void __launch_bounds__(256) nv_gate(Args A) {
    const int row = blockIdx.x, tid = threadIdx.x;
    unsigned char* ws = A.ws; const bf16* proj = (const bf16*)(ws + WS_PROJ); const bf16* ybuf = (const bf16*)(ws + WS_WIN); bf16* mix = (bf16*)(ws + WS_H);
    float gv[8]; float ss = 0.f;
    for (int i = 0; i < 8; ++i) { const int c = tid * 8 + i; const float y = bf2f(ybuf[(size_t)row * 2048 + c]), z = bf2f(proj[(size_t)row * LDP + OFF_Z + c]); gv[i] = y * silu_f(z); ss += gv[i] * gv[i]; }
#pragma unroll
    for (int o = 1; o < 32; o <<= 1) ss += __shfl_xor(ss, o);
    const float rs = 1.f / sqrtf(ss * (1.f / 256.f) + RMS_EPS);
    for (int i = 0; i < 8; i += 2) { const int c = tid * 8 + i; *(unsigned*)(mix + (size_t)row * DM + 2048 + c) = pk2(gv[i] * rs * A.in[IN_SNW][c], gv[i + 1] * rs * A.in[IN_SNW][c + 1]); }
}

extern "C" void kernel_launch(void* const* d_in, const int* in_sizes, int n_in, void* d_out, int out_size, void* d_ws, size_t ws_size, hipStream_t stream) {
    static int grid = 0;
    if (grid == 0) {
        if (n_in != 21 || in_sizes[0] != NTOK_P * DM || (size_t)out_size != O_END || ws_size < WS_END) {
            fprintf(stderr, "kernel_launch: unexpected shapes: n_in %d in0 %d out %d ws %zu (need %zu)\n", n_in, n_in > 0 ? in_sizes[0] : -1, out_size, ws_size, (size_t)WS_END); grid = -1; return; }
        int dev = 0, cus = 0, per_cu = 0;
        if (hipGetDevice(&dev) != hipSuccess || hipDeviceGetAttribute(&cus, hipDeviceAttributeMultiprocessorCount, dev) != hipSuccess) { grid = -1; return; }
        if (hipFuncSetAttribute((const void*)mega_fwd, hipFuncAttributeMaxDynamicSharedMemorySize, LDS_BYTES) != hipSuccess) { fprintf(stderr, "kernel_launch: hipFuncSetAttribute failed\n"); grid = -1; return; }
        if (hipOccupancyMaxActiveBlocksPerMultiprocessor(&per_cu, (const void*)mega_fwd, NWAVES * 64, LDS_BYTES) != hipSuccess || per_cu < 1)
            fprintf(stderr, "kernel_launch: note: occupancy query reports %d workgroups per CU\n", per_cu);
        (void)hipGetLastError();
        grid = cus;
    }
    if (grid < 0) return;
    if (hipMemsetAsync((char*)d_ws + WS_CTL, 0, CTL_ZERO_BYTES, stream) != hipSuccess) return;
    Args a{};
    for (int i = 0; i < 21; ++i) a.in[i] = (const float*)d_in[i];
    a.out = (float*)d_out; a.ws = (unsigned char*)d_ws;
#define MEGA(lo_, hi_) do { a.ph_lo = (lo_); a.ph_hi = (hi_); hipLaunchKernelGGL(mega_fwd, dim3(grid), dim3(NWAVES * 64), LDS_BYTES, stream, a); } while (0)
    MEGA(PH_PRO, PH_PRO + 1);
    MEGA(PH_INPROJ, PH_INPROJ + 1);
    a.ph_lo = 0; a.ph_hi = 0;
    hipLaunchKernelGGL(nv_prep, dim3(M), dim3(256), 0, stream, a);
    hipLaunchKernelGGL(nv_attn<false>, dim3(NB_P * 128 * 8), dim3(256), 0, stream, a);
    hipLaunchKernelGGL(nv_attn<true>, dim3(NB_S * 8), dim3(256), 0, stream, a);
    hipLaunchKernelGGL(nv_scan, dim3((NB_P + NB_S) * 8), dim3(256), 0, stream, a);
    hipLaunchKernelGGL(nv_gate, dim3(M), dim3(256), 0, stream, a);
    MEGA(PH_OUT, PH_OUT + 1);
    MEGA(PH_RSTD, PH_RSTD + 1);
    MEGA(PH_UP, PH_UP + 1);
    MEGA(PH_DOWN, PH_DOWN + 1);
    const hipError_t le = hipPeekAtLastError();
    if (le != hipSuccess) fprintf(stderr, "kernel_launch: launch failed: %s\n", hipGetErrorName(le));
}
```

```cpp
#define DOWN_WGM 4
#ifndef PG8_BAL
#define PG8_BAL 1
#endif
#include <hip/hip_runtime.h>
#include <cstdio>
#include <cstdint>
namespace pg8 {
#define PG8_LAS __attribute__((address_space(3)))
typedef unsigned short bf16_t;
typedef short bf16x8 __attribute__((ext_vector_type(8)));
typedef float f32x4 __attribute__((ext_vector_type(4)));
typedef unsigned u32x4 __attribute__((ext_vector_type(4)));
constexpr int BM = 256, BK = 64, HALF = 128, HTB = HALF * BK * 2  , STAGE_BYTES = 8 * HTB, NXCD = 8, WGM = 8;

__host__ __device__ __forceinline__ int lds_byte(int r, int c) { const int st = (r >> 4) * 2 + (c >> 5), rr = r & 15, cc = c & 31, ob = rr * 64 + cc * 2; return st * 1024 + (ob ^ (((ob >> 9) & 1) << 5)); }
__host__ __device__ __forceinline__ void stage_rc(int b, int& R, int& C) { const int st = b / 1024, sb = b % 1024, swz = sb ^ (((sb >> 9) & 1) << 5); R = (st >> 1) * 16 + swz / 64; C = (st & 1) * 32 + (swz % 64) / 2; }
__host__ __device__ __forceinline__ int perm32(int rho) { const int n = rho >> 4, i = rho & 15; return 8 * (i >> 2) + 4 * n + (i & 3); }

struct Unit { int pm, pn; };
struct Gemm { const bf16_t* A; const bf16_t* Bt; int M, N, K, ld, kstep; size_t tstep; };
__host__ __device__ __forceinline__ Gemm gemm_rm(const bf16_t* A, const bf16_t* Bt, int M, int N, int K, int Ktot) { return Gemm{A, Bt, M, N, K, Ktot, 128, (size_t)512 * Ktot}; }
__host__ __device__ __forceinline__ Gemm gemm_blk(const bf16_t* A, const bf16_t* Bt, int M, int N, int K, int Ktot) { return Gemm{A, Bt, M, N, K, 64, 32768, (size_t)512 * Ktot}; }
__host__ __device__ __forceinline__ size_t blk_off(int row, int col, int Ktot) { return ((size_t)(row >> 8) * (Ktot >> 6) + (col >> 6)) * 16384 + (size_t)(row & 255) * 64 + (col & 63); }

struct StaticOrder {
    int nM, nN, nwg, G, c, wgm = WGM;
    __host__ __device__ __forceinline__ void init(int M, int N, int G_, int c_) { nM = M / BM; nN = N / BM; nwg = nM * nN; G = G_; c = c_; }
    __host__ __device__ __forceinline__ bool next(int i, Unit& u) const {
        const long L = (long)i * G + c; if (L >= nwg) return false;
        int wgid = (int)L; { const int q = nwg / NXCD, r = nwg % NXCD, xcd = wgid % NXCD, off = wgid / NXCD; wgid = (xcd < r ? xcd * (q + 1) : r * (q + 1) + (xcd - r) * q) + off; }
        const int nig = wgm * nN, gid = wgid / nig, fm = gid * wgm, gsz = (nM - fm) < wgm ? (nM - fm) : wgm;
        u.pm = fm + ((wgid % nig) % gsz); u.pn = (wgid % nig) / gsz; return true;
    }
    __device__ __forceinline__ void a_ready(const Unit&) const {}
    __device__ __forceinline__ void done(const Unit&) const {}
};

typedef float f32x2_t __attribute__((ext_vector_type(2))); typedef __bf16 bf16x2_t __attribute__((ext_vector_type(2)));
__device__ __forceinline__ unsigned cvt_pk_bf16(float lo, float hi) { const f32x2_t v = {lo, hi}; const bf16x2_t b = __builtin_convertvector(v, bf16x2_t); return __builtin_bit_cast(unsigned, b); }
typedef unsigned u32x2 __attribute__((ext_vector_type(2)));

struct EpiProj {
    static constexpr bool PERM = true, AFTER_DRAIN = false;
    bf16_t* O; int ldc; float* dt; int dt_pn;
    __device__ __forceinline__ void operator()(const f32x4 (&acc)[2][2][4][2], const Unit& u, int wr, int wc, int fr, int fq) const {
        const int row0 = u.pm * BM + wr * 64 + fr; const int col0 = u.pn * BM + wc * 32 + 8 * fq;
#pragma unroll
        for (int ai = 0; ai < 2; ++ai)
#pragma unroll
            for (int m = 0; m < 4; ++m) { bf16_t* rowp = O + (size_t)(row0 + ai * HALF + m * 16) * ldc + col0;
#pragma unroll
                for (int bj = 0; bj < 2; ++bj) { const f32x4 v0 = acc[ai][bj][m][0], v1 = acc[ai][bj][m][1];
                    u32x4 w; w.x = cvt_pk_bf16(v0[0], v0[1]); w.y = cvt_pk_bf16(v0[2], v0[3]); w.z = cvt_pk_bf16(v1[0], v1[1]); w.w = cvt_pk_bf16(v1[2], v1[3]);
                    *(u32x4*)(rowp + bj * HALF) = w; } }
        if (u.pn == dt_pn && wc == 0) {
#pragma unroll
            for (int ai = 0; ai < 2; ++ai)
#pragma unroll
                for (int m = 0; m < 4; ++m) { float* dp = dt + (size_t)(row0 + ai * HALF + m * 16) * 32 + 8 * fq;
                    *(f32x4*)(dp) = acc[ai][0][m][0]; *(f32x4*)(dp + 4) = acc[ai][0][m][1]; }
        }
    }
};
struct EpiOut {
    static constexpr bool PERM = true, AFTER_DRAIN = false;
    const float* xp; const float* xs; float* out; bf16_t* xb; float* part; int np_rows;
    __device__ __forceinline__ void operator()(const f32x4 (&acc)[2][2][4][2], const Unit& u, int wr, int wc, int fr, int fq) const {
        const int col0 = u.pn * BM + wc * 32 + 8 * fq;
#pragma unroll
        for (int ai = 0; ai < 2; ++ai)
#pragma unroll
            for (int m = 0; m < 4; ++m) { const int row = u.pm * BM + ai * HALF + wr * 64 + m * 16 + fr;
                const float* xr = (row < np_rows) ? xp + (size_t)row * 4096 : xs + (size_t)(row - np_rows) * 4096;
                float ss = 0.f;
#pragma unroll
                for (int bj = 0; bj < 2; ++bj) { const int c = col0 + bj * HALF;
                    const f32x4 v0 = *(const f32x4*)(xr + c) + acc[ai][bj][m][0], v1 = *(const f32x4*)(xr + c + 4) + acc[ai][bj][m][1];
                    ss += ((v0[0] * v0[0] + v0[1] * v0[1]) + (v0[2] * v0[2] + v0[3] * v0[3])) + ((v1[0] * v1[0] + v1[1] * v1[1]) + (v1[2] * v1[2] + v1[3] * v1[3]));
                    u32x4 w; w.x = cvt_pk_bf16(v0[0], v0[1]); w.y = cvt_pk_bf16(v0[2], v0[3]); w.z = cvt_pk_bf16(v1[0], v1[1]); w.w = cvt_pk_bf16(v1[2], v1[3]);
                    *(u32x4*)(xb + (size_t)row * 4096 + c) = w; }
                ss += __shfl_xor(ss, 16); ss += __shfl_xor(ss, 32);
                if (fq == 0) part[(size_t)row * 64 + u.pn * 4 + wc] = ss; }
    }
};
struct EpiUp {
    static constexpr bool PERM = true, AFTER_DRAIN = false;
    bf16_t* O; int ldc; const float* rstd;
    __device__ __forceinline__ void operator()(const f32x4 (&acc)[2][2][4][2], const Unit& u, int wr, int wc, int fr, int fq) const {
        const int row0 = u.pm * BM + wr * 64 + fr; const int col0 = u.pn * BM + wc * 32 + 8 * fq;
#pragma unroll
        for (int ai = 0; ai < 2; ++ai)
#pragma unroll
            for (int m = 0; m < 4; ++m) { const int row = row0 + ai * HALF + m * 16; const float rs = rstd[row]; bf16_t* rowp = O + blk_off(row, col0, ldc);
#pragma unroll
                for (int bj = 0; bj < 2; ++bj) { f32x4 v0 = acc[ai][bj][m][0] * rs, v1 = acc[ai][bj][m][1] * rs;
#pragma unroll
                    for (int i = 0; i < 4; ++i) { const float a = v0[i] > 0.f ? v0[i] : 0.f, b = v1[i] > 0.f ? v1[i] : 0.f; v0[i] = a * a; v1[i] = b * b; }
                    u32x4 w; w.x = cvt_pk_bf16(v0[0], v0[1]); w.y = cvt_pk_bf16(v0[2], v0[3]); w.z = cvt_pk_bf16(v1[0], v1[1]); w.w = cvt_pk_bf16(v1[2], v1[3]);
                    *(u32x4*)(rowp + (size_t)bj * 2 * 16384) = w; } }
    }
};
struct EpiDown {
    static constexpr bool PERM = true, AFTER_DRAIN = false;
    float* out; const bf16_t* xb;
    __device__ __forceinline__ void operator()(const f32x4 (&acc)[2][2][4][2], const Unit& u, int wr, int wc, int fr, int fq) const {
        const int col0 = u.pn * BM + wc * 32 + 8 * fq;
#pragma unroll
        for (int ai = 0; ai < 2; ++ai)
#pragma unroll
            for (int m = 0; m < 4; ++m) { const size_t ro = (size_t)(u.pm * BM + ai * HALF + wr * 64 + m * 16 + fr) * 4096 + col0;
#pragma unroll
                for (int bj = 0; bj < 2; ++bj) { const u32x4 w = *(const u32x4*)(xb + ro + bj * HALF);
                    const f32x4 r0 = {__builtin_bit_cast(float, w.x << 16), __builtin_bit_cast(float, w.x & 0xffff0000u), __builtin_bit_cast(float, w.y << 16), __builtin_bit_cast(float, w.y & 0xffff0000u)};
                    const f32x4 r1 = {__builtin_bit_cast(float, w.z << 16), __builtin_bit_cast(float, w.z & 0xffff0000u), __builtin_bit_cast(float, w.w << 16), __builtin_bit_cast(float, w.w & 0xffff0000u)};
                    *(f32x4*)(out + ro + bj * HALF) = r0 + acc[ai][bj][m][0]; *(f32x4*)(out + ro + bj * HALF + 4) = r1 + acc[ai][bj][m][1]; } }
    }
};

struct EpiPart {
    static constexpr bool PERM = true, AFTER_DRAIN = false;
    float* slab;
    __device__ __forceinline__ void operator()(const f32x4 (&acc)[2][2][4][2], const Unit& u, int wr, int wc, int fr, int fq) const {
        const int col0 = wc * 32 + 8 * fq;
#pragma unroll
        for (int ai = 0; ai < 2; ++ai)
#pragma unroll
            for (int m = 0; m < 4; ++m) { float* rowp = slab + (size_t)(ai * HALF + wr * 64 + m * 16 + fr) * 256 + col0;
#pragma unroll
                for (int bj = 0; bj < 2; ++bj) { *(f32x4*)(rowp + bj * HALF) = acc[ai][bj][m][0]; *(f32x4*)(rowp + bj * HALF + 4) = acc[ai][bj][m][1]; } }
    }
};
struct HeadOrder : StaticOrder { int nr; __device__ __forceinline__ bool next(int i, Unit& u) const { return i < nr && StaticOrder::next(i, u); } };
struct TailOrder : StaticOrder { int round; __device__ __forceinline__ bool next(int i, Unit& u) const { return i == 0 && StaticOrder::next(round, u); } };

struct PanelTail { int pm, pn; __device__ __forceinline__ bool next(int i, Unit& u) const { if (i) return false; u.pm = pm; u.pn = pn; return true; }
    __device__ __forceinline__ void a_ready(const Unit&) const {} __device__ __forceinline__ void done(const Unit&) const {} };
#if defined(PROBE_SHADOW_UP)
struct ShEpi { static constexpr bool PERM = true, AFTER_DRAIN = false; EpiUp e;
    __device__ __forceinline__ void operator()(const f32x4 (&acc)[2][2][4][2], const Unit& u, int wr, int wc, int fr, int fq) const { Unit z; z.pm = PROBE_SHADOW_UP == 2 ? 0 : u.pm; z.pn = PROBE_SHADOW_UP == 2 ? 0 : u.pn; e(acc, z, wr, wc, fr, fq); } };
#endif
#if defined(PROBE_SHADOW_DOWN)
struct ShEpiD { static constexpr bool PERM = false, AFTER_DRAIN = false; EpiDown e;
    __device__ __forceinline__ void operator()(const f32x4 (&acc)[2][2][4][2], const Unit& u, int wr, int wc, int fr, int fq) const { Unit z; z.pm = 0; z.pn = 0; e(acc, z, wr, wc, fr, fq); } };
#endif
struct RangeOrder : StaticOrder { int r0, r1; __device__ __forceinline__ bool next(int i, Unit& u) const { return (i + r0) < r1 && StaticOrder::next(i + r0, u); } };
template <class Epi, class Sched, bool ALIGN_EPI = false, bool SP2 = false>
__device__ __forceinline__ void gemm_phase(PG8_LAS unsigned char* lds, const Gemm g, const Sched& S, const Epi& E) {
    int tid_ = threadIdx.x; asm volatile("" : "+v"(tid_));
    const int tid = tid_, wid = __builtin_amdgcn_readfirstlane(tid >> 6), lane = tid & 63, wr = wid >> 2, wc = wid & 3, fr = lane & 15, fq = lane >> 4;
    const int K = g.K, nt = K / BK, LD = g.ld;
    unsigned voffA[2], voffB[2];
#pragma unroll
    for (int i = 0; i < 2; ++i) { int R, C; stage_rc(tid * 16 + i * 8192, R, C); const int Rb = Epi::PERM ? ((R & ~31) + perm32(R & 31)) : R;
        voffA[i] = (unsigned)(R * LD + C) * 2u; voffB[i] = (unsigned)(Rb * LD + C) * 2u; }
    const size_t kstep = (size_t)g.kstep;
    const size_t hstep = (size_t)HALF * LD * 2;
    const size_t tstep = g.tstep;
    const unsigned ldsw = (unsigned)wid * 1024u;
    const int aoff = lds_byte(wr * 64 + fr, fq * 8), boff = lds_byte(wc * 32 + fr, fq * 8);
#define PG8_SA(b, h) (((b) * 2 + (h)) * HTB)
#define PG8_SB(b, h) ((4 + (b) * 2 + (h)) * HTB)
#define PG8_STAGE(bufoff, gbase, voff) do { _Pragma("unroll") for (int _i = 0; _i < 2; ++_i) \
        __builtin_amdgcn_global_load_lds((const unsigned*)((const char*)(gbase) + (voff)[_i]), (PG8_LAS unsigned*)(lds + (bufoff) + ldsw + _i * 8192), 16, 0, 0); } while (0)
#define PG8_LDA(dst, b, h) do { _Pragma("unroll") for (int m = 0; m < 4; ++m) _Pragma("unroll") for (int k = 0; k < 2; ++k) dst[m][k] = *(const PG8_LAS bf16x8*)(lds + PG8_SA(b, h) + aoff + m * 2048 + k * 1024); } while (0)
#define PG8_LDB(dst, b, h) do { _Pragma("unroll") for (int n = 0; n < 2; ++n) _Pragma("unroll") for (int k = 0; k < 2; ++k) dst[n][k] = *(const PG8_LAS bf16x8*)(lds + PG8_SB(b, h) + boff + n * 2048 + k * 1024); } while (0)
#define PG8_MMA(ai, bj, At, Bt) do { __builtin_amdgcn_s_setprio(1); _Pragma("unroll") for (int m = 0; m < 4; ++m) _Pragma("unroll") for (int n = 0; n < 2; ++n) _Pragma("unroll") for (int k = 0; k < 2; ++k) \
        acc[ai][bj][m][n] = __builtin_amdgcn_mfma_f32_16x16x32_bf16(Bt[n][k], At[m][k], acc[ai][bj][m][n], 0, 0, 0); __builtin_amdgcn_s_setprio(0); } while (0)
#define PG8_WAIT_V(n) asm volatile("s_waitcnt vmcnt(" #n ")" ::: "memory")
#define PG8_WAIT_L(n) asm volatile("s_waitcnt lgkmcnt(" #n ")" ::: "memory")
#define PG8_BAR __builtin_amdgcn_s_barrier()
#define PG8_SCHED __builtin_amdgcn_sched_barrier(0)
    Unit cur, nxt; int ui = 0;
    if (!S.next(0, cur)) return;
    f32x4 acc[2][2][4][2];
#pragma unroll
    for (int a = 0; a < 2; ++a)
#pragma unroll
        for (int b = 0; b < 2; ++b)
#pragma unroll
            for (int m = 0; m < 4; ++m)
#pragma unroll
                for (int n = 0; n < 2; ++n) acc[a][b][m][n] = (f32x4){0.f, 0.f, 0.f, 0.f};
    bf16x8 At[4][2], B0[2][2], B1[2][2];
#if PG8_BAL
    bf16x8 B0n[2][2];
#endif
    const char* cA = (const char*)g.A + (size_t)cur.pm * tstep; const char* cB = (const char*)g.Bt + (size_t)cur.pn * tstep;
    S.a_ready(cur);
    if constexpr (SP2) {
#if PG8_BAL
        PG8_STAGE(PG8_SB(0, 0), cB, voffB); PG8_STAGE(PG8_SB(0, 1), cB + hstep, voffB); PG8_STAGE(PG8_SA(0, 0), cA, voffA);
        PG8_STAGE(PG8_SA(0, 1), cA + hstep, voffA); PG8_STAGE(PG8_SB(1, 0), cB + kstep, voffB);
        PG8_STAGE(PG8_SB(1, 1), cB + hstep + kstep, voffB); PG8_STAGE(PG8_SA(1, 0), cA + kstep, voffA);
        if (wr == 1) PG8_BAR;
        PG8_WAIT_V(8); PG8_BAR;
        if (wr == 1) { PG8_LDB(B0, 0, 0); PG8_WAIT_L(0); }
        PG8_BAR;
        if (wr == 0) { PG8_LDB(B0, 0, 0); PG8_WAIT_L(0); }
        PG8_BAR;
#else
        PG8_STAGE(PG8_SB(0, 0), cB, voffB); PG8_STAGE(PG8_SB(0, 1), cB + hstep, voffB); PG8_STAGE(PG8_SA(0, 0), cA, voffA); PG8_STAGE(PG8_SA(0, 1), cA + hstep, voffA);
        if (wr == 1) PG8_BAR;
        PG8_WAIT_V(2); PG8_BAR;
        PG8_STAGE(PG8_SB(1, 0), cB + kstep, voffB); PG8_STAGE(PG8_SA(1, 0), cA + kstep, voffA); PG8_STAGE(PG8_SB(1, 1), cB + hstep + kstep, voffB);
        PG8_WAIT_V(6); PG8_BAR;
#endif
    } else {
        PG8_STAGE(PG8_SB(0, 0), cB, voffB); PG8_STAGE(PG8_SA(0, 0), cA, voffA); PG8_STAGE(PG8_SB(0, 1), cB + hstep, voffB); PG8_STAGE(PG8_SA(0, 1), cA + hstep, voffA);
        if (wr == 1) PG8_BAR;
        PG8_WAIT_V(4); PG8_BAR;
        PG8_STAGE(PG8_SB(1, 0), cB + kstep, voffB); PG8_STAGE(PG8_SA(1, 0), cA + kstep, voffA); PG8_STAGE(PG8_SB(1, 1), cB + hstep + kstep, voffB);
        PG8_WAIT_V(6); PG8_BAR;
    }
    for (;;) {
        const bool has_next = S.next(ui + 1, nxt);
        const char* nA = has_next ? (const char*)g.A + (size_t)nxt.pm * tstep : cA; const char* nB = has_next ? (const char*)g.Bt + (size_t)nxt.pn * tstep : cB;
        for (int t = 0; t < nt; t += 2) {
            const bool last = (t == nt - 2);
            const char* a1 = cA + (size_t)(t + 1) * kstep;
            const char* a2 = last ? nA : cA + (size_t)(t + 2) * kstep; const char* b2 = last ? nB : cB + (size_t)(t + 2) * kstep;
            const char* a3 = a2 + kstep; const char* b3 = b2 + kstep;
            if (last && has_next) S.a_ready(nxt);
            if constexpr (SP2) {
#if PG8_BAL
            PG8_LDB(B1, 0, 1); PG8_SCHED; PG8_LDA(At, 0, 0); PG8_STAGE(PG8_SA(1, 1), a1 + hstep, voffA); PG8_STAGE(PG8_SB(0, 0), b2, voffB);
            PG8_WAIT_V(8); PG8_WAIT_L(0); PG8_BAR; PG8_MMA(0, 0, At, B0); PG8_MMA(0, 1, At, B1); PG8_BAR; PG8_SCHED;
            PG8_LDA(At, 0, 1); PG8_LDB(B0n, 1, 0); PG8_STAGE(PG8_SB(0, 1), b2 + hstep, voffB); PG8_STAGE(PG8_SA(0, 0), a2, voffA);
            PG8_WAIT_V(8); PG8_WAIT_L(0); PG8_BAR; PG8_MMA(1, 0, At, B0); PG8_MMA(1, 1, At, B1); PG8_BAR; PG8_SCHED;
            PG8_LDB(B1, 1, 1); PG8_SCHED; PG8_LDA(At, 1, 0); PG8_STAGE(PG8_SA(0, 1), a2 + hstep, voffA); PG8_STAGE(PG8_SB(1, 0), b3, voffB);
            PG8_WAIT_V(8); PG8_WAIT_L(0); PG8_BAR; PG8_MMA(0, 0, At, B0n); PG8_MMA(0, 1, At, B1); PG8_BAR; PG8_SCHED;
            PG8_LDA(At, 1, 1); PG8_LDB(B0, 0, 0); PG8_STAGE(PG8_SB(1, 1), b3 + hstep, voffB); PG8_STAGE(PG8_SA(1, 0), a3, voffA);
            PG8_WAIT_V(8); PG8_WAIT_L(0); PG8_BAR; PG8_MMA(1, 0, At, B0n); PG8_MMA(1, 1, At, B1); PG8_BAR; PG8_SCHED;
#else
            PG8_LDB(B0, 0, 0); PG8_LDB(B1, 0, 1); PG8_SCHED; PG8_LDA(At, 0, 0); PG8_STAGE(PG8_SA(1, 1), a1 + hstep, voffA);
            PG8_WAIT_V(8); PG8_WAIT_L(0); PG8_BAR; PG8_MMA(0, 0, At, B0); PG8_MMA(0, 1, At, B1); PG8_BAR; PG8_SCHED;
            PG8_LDA(At, 0, 1); PG8_STAGE(PG8_SB(0, 0), b2, voffB); PG8_STAGE(PG8_SB(0, 1), b2 + hstep, voffB); PG8_STAGE(PG8_SA(0, 0), a2, voffA);
            PG8_WAIT_V(8); PG8_WAIT_L(0); PG8_BAR; PG8_MMA(1, 0, At, B0); PG8_MMA(1, 1, At, B1); PG8_BAR; PG8_SCHED;
            PG8_LDB(B0, 1, 0); PG8_LDB(B1, 1, 1); PG8_SCHED; PG8_LDA(At, 1, 0); PG8_STAGE(PG8_SA(0, 1), a2 + hstep, voffA);
            PG8_WAIT_V(8); PG8_WAIT_L(0); PG8_BAR; PG8_MMA(0, 0, At, B0); PG8_MMA(0, 1, At, B1); PG8_BAR; PG8_SCHED;
            PG8_LDA(At, 1, 1); PG8_STAGE(PG8_SB(1, 0), b3, voffB); PG8_STAGE(PG8_SB(1, 1), b3 + hstep, voffB); PG8_STAGE(PG8_SA(1, 0), a3, voffA);
            PG8_WAIT_V(8); PG8_WAIT_L(0); PG8_BAR; PG8_MMA(1, 0, At, B0); PG8_MMA(1, 1, At, B1); PG8_BAR; PG8_SCHED;
#endif
            } else {
            PG8_LDB(B0, 0, 0); PG8_SCHED; PG8_LDA(At, 0, 0); PG8_STAGE(PG8_SA(1, 1), a1 + hstep, voffA);
            PG8_WAIT_L(8); PG8_BAR; PG8_WAIT_L(0); PG8_MMA(0, 0, At, B0); PG8_BAR; PG8_SCHED;
            PG8_LDB(B1, 0, 1); PG8_STAGE(PG8_SB(0, 0), b2, voffB);
            PG8_BAR; PG8_WAIT_L(0); PG8_MMA(0, 1, At, B1); PG8_BAR;
            PG8_LDA(At, 0, 1); PG8_STAGE(PG8_SA(0, 0), a2, voffA);
            PG8_BAR; PG8_WAIT_L(0); PG8_MMA(1, 0, At, B0); PG8_BAR; PG8_SCHED;
            PG8_STAGE(PG8_SB(0, 1), b2 + hstep, voffB);
            PG8_WAIT_V(6); PG8_BAR; PG8_MMA(1, 1, At, B1); PG8_BAR;
            PG8_LDB(B0, 1, 0); PG8_SCHED; PG8_LDA(At, 1, 0); PG8_STAGE(PG8_SA(0, 1), a2 + hstep, voffA);
            PG8_WAIT_L(8); PG8_BAR; PG8_WAIT_L(0); PG8_MMA(0, 0, At, B0); PG8_BAR; PG8_SCHED;
            PG8_LDB(B1, 1, 1); PG8_STAGE(PG8_SB(1, 0), b3, voffB);
            PG8_BAR; PG8_WAIT_L(0); PG8_MMA(0, 1, At, B1); PG8_BAR;
            PG8_LDA(At, 1, 1); PG8_STAGE(PG8_SA(1, 0), a3, voffA);
            PG8_BAR; PG8_WAIT_L(0); PG8_MMA(1, 0, At, B0); PG8_BAR; PG8_SCHED;
            PG8_STAGE(PG8_SB(1, 1), b3 + hstep, voffB);
            PG8_WAIT_V(6); PG8_BAR; PG8_MMA(1, 1, At, B1); PG8_BAR;
            }
        }
        if constexpr (ALIGN_EPI) { if (wr == 0) PG8_BAR; }
        if constexpr (!Epi::AFTER_DRAIN) { E(acc, cur, wr, wc, fr, fq); S.done(cur); }
        if (!has_next) break;
#pragma unroll
        for (int a = 0; a < 2; ++a)
#pragma unroll
            for (int b = 0; b < 2; ++b)
#pragma unroll
                for (int m = 0; m < 4; ++m)
#pragma unroll
                    for (int n = 0; n < 2; ++n) acc[a][b][m][n] = (f32x4){0.f, 0.f, 0.f, 0.f};
        cur = nxt; cA = nA; cB = nB; ++ui;
        if constexpr (ALIGN_EPI) { if (wr == 1) PG8_BAR; }
    }
    PG8_WAIT_V(0);
    if constexpr (!ALIGN_EPI) { if (wr == 0) PG8_BAR; }
    PG8_BAR;
    if constexpr (Epi::AFTER_DRAIN) { E.fused(acc, cur, wr, wc, fr, fq, lds, wid, lane); S.done(cur); }
#undef PG8_SA
#undef PG8_SB
#undef PG8_STAGE
#undef PG8_LDA
#undef PG8_LDB
#undef PG8_MMA
#undef PG8_WAIT_V
#undef PG8_WAIT_L
#undef PG8_BAR
#undef PG8_SCHED
}
}
#ifndef PG8_SP2
#define PG8_SP2 true
#endif
#ifndef PG8_ALIGN
#define PG8_ALIGN true
#endif
constexpr int NWAVES = 8;
constexpr int DM = 4096, SEQ = 8192, NB_P = 2, NB_S = 32, DSEQ = 32, PAST = 1024;
constexpr int NTOK_P = NB_P * SEQ, NTOK_S = NB_S * DSEQ, M = NTOK_P + NTOK_S;
constexpr int NPROJ = 9248, LDP = 9472;
constexpr int OFF_Q = 0, OFF_K = 2048, OFF_V = 2560, OFF_XS = 3072, OFF_Z = 5120, OFF_B = 7168, OFF_C = 8192, OFF_DT = 9216;
constexpr int FF = 16384;
constexpr float RMS_EPS = 1e-6f;
constexpr size_t O_Y = 0, O_KP = (size_t)M * DM, O_VP = O_KP + 131072, O_CP = O_VP + 131072, O_SP = O_CP + 24576, O_KS = O_SP + 524288, O_VS = O_KS + 2097152,
                 O_CS = O_VS + 2097152, O_SS = O_CS + 393216, O_END = O_SS + 8388608;
constexpr size_t MiB = 1u << 20;
constexpr size_t WS_CTL = 0, CTL_ZERO_BYTES = 64 * 1024;
constexpr size_t WS_ROPE = 1 * MiB;
constexpr size_t WS_DT = 2 * MiB;
constexpr size_t WS_PART = 5 * MiB;
constexpr size_t WS_RSTD = 10 * MiB;
constexpr size_t WS_DECAY = 11 * MiB;
constexpr size_t WS_WUP = 16 * MiB;
constexpr size_t WS_WDN = 144 * MiB;
constexpr size_t WS_X1B = 272 * MiB;
constexpr size_t WS_WOUT = 408 * MiB;
constexpr size_t WS_U = 440 * MiB;
constexpr size_t WS_WIN = 440 * MiB;
constexpr size_t WS_H = 514 * MiB;
constexpr size_t WS_PROJ = 650 * MiB;
constexpr size_t WS_KN = 984 * MiB;
constexpr size_t WS_END = 1020 * MiB;
static_assert(WS_PROJ + (size_t)M * LDP * 2 <= WS_KN && WS_U + (size_t)M * FF * 2 <= WS_KN && WS_WIN + (size_t)LDP * DM * 2 <= WS_H && WS_H + (size_t)M * DM * 2 <= WS_PROJ, "ws map");
static_assert(WS_X1B + (size_t)M * DM * 2 <= WS_WOUT && WS_DT + (size_t)M * 32 * 4 <= WS_PART && WS_PART + (size_t)M * 64 * 4 <= WS_RSTD, "ws map 2");
constexpr int CW_TMO = 0, CW_CODE = 1, CW_BAR = 4096;
static_assert((CW_BAR + 3 * 3456) * 4 <= (int)CTL_ZERO_BYTES, "barrier regions inside the per-call memset");

constexpr int RING_OFF = 0, RING_BYTES = 133120;
constexpr int LDSCTL_OFF = RING_BYTES, MISC_OFF = LDSCTL_OFF + 320;
constexpr int LDS_BYTES = 147456;
static_assert(MISC_OFF + 128 <= LDS_BYTES, "LDS map");

#define GAS __attribute__((address_space(1)))
#define LAS __attribute__((address_space(3)))
typedef unsigned short bf16;
typedef unsigned v4u __attribute__((ext_vector_type(4)));
typedef unsigned v2u __attribute__((ext_vector_type(2)));
typedef float f32x4 __attribute__((ext_vector_type(4)));
typedef short bf16x8 __attribute__((ext_vector_type(8)));
typedef GAS unsigned gu32;
#define RLX_AGENT __ATOMIC_RELAXED, __HIP_MEMORY_SCOPE_AGENT
#define LDS_WAIT() asm volatile("s_waitcnt lgkmcnt(0)" ::: "memory")
#define VM_WAIT() asm volatile("s_waitcnt vmcnt(0)" ::: "memory")
__device__ __forceinline__ unsigned f2bf(float f) { unsigned u = __builtin_bit_cast(unsigned, f); return (u + 0x7fffu + ((u >> 16) & 1u)) >> 16; }
typedef float f32x2_g __attribute__((ext_vector_type(2))); typedef __bf16 bf16x2_g __attribute__((ext_vector_type(2)));
__device__ __forceinline__ unsigned pk2(float lo, float hi) { const f32x2_g v = {lo, hi}; const bf16x2_g b = __builtin_convertvector(v, bf16x2_g); return __builtin_bit_cast(unsigned, b); }
__device__ __forceinline__ float bf2f(unsigned short b) { return __builtin_bit_cast(float, (unsigned)b << 16); }
__device__ __forceinline__ float bflo(unsigned w) { return __builtin_bit_cast(float, w << 16); }
__device__ __forceinline__ float bfhi(unsigned w) { return __builtin_bit_cast(float, w & 0xffff0000u); }
__device__ __forceinline__ float silu_f(float v) { return v / (1.f + __expf(-v)); }
__device__ __forceinline__ float softplus_f(float v) { return v > 20.f ? v : log1pf(__expf(v)); }

#define XB_TMO      128
#define XB_XCNT(j)  (256  + 64 * (j))
#define XB_XSUB(j)  (1280 + 64 * (j))
#define XB_XGEN(j)  (2304 + 64 * (j))
#define XB_TOP      3328
#define XB_TOPGEN   3392
#define XCD_BAR_WORDS 3456
#define XB_SPIN_CAP (1u << 18)

__device__ __forceinline__ unsigned xb_ld(unsigned* p)              { return __hip_atomic_load(p, __ATOMIC_RELAXED, __HIP_MEMORY_SCOPE_AGENT); }
__device__ __forceinline__ unsigned xb_add(unsigned* p, unsigned v) { return __hip_atomic_fetch_add(p, v, __ATOMIC_RELAXED, __HIP_MEMORY_SCOPE_AGENT); }
__device__ __forceinline__ unsigned xb_xcc_id() { return (unsigned)__builtin_amdgcn_s_getreg((3 << 11) | 20) & 0xFu; }
#define XB_SPIN(cond, bar) do { unsigned _sp = 0; while (cond) { __builtin_amdgcn_s_sleep(1); \
    if ((++_sp & 255u) == 0u) { if (xb_ld(&(bar)[XB_TMO])) break; if (_sp > XB_SPIN_CAP) { atomicAdd(&(bar)[XB_TMO], 1u); break; } } } } while (0)

struct XcdBarrier {
    unsigned* bar; unsigned x;
    volatile LAS unsigned* st;
};

__device__ __forceinline__ XcdBarrier xcd_barrier_post(unsigned* bar, volatile LAS unsigned* st) {
    XcdBarrier b; b.bar = bar; b.x = xb_xcc_id(); b.st = st;
    if (threadIdx.x == 0) (void)xb_add(&bar[XB_XCNT(b.x)], 1u);
    return b;
}
__device__ __forceinline__ void xcd_barrier_complete(unsigned* bar, unsigned x, unsigned& nloc, unsigned& nx) {
    const unsigned G = gridDim.x * gridDim.y * gridDim.z;
    unsigned sum, cnt, mine, sp = 0u;
    for (;;) {
        sum = 0u; cnt = 0u; mine = 0u;
#pragma unroll
        for (unsigned j = 0; j < 16; ++j) { const unsigned c = xb_ld(&bar[XB_XCNT(j)]); sum += c; cnt += (c > 0u) ? 1u : 0u; mine = (j == x) ? c : mine; }
        if (sum == G) break;
        __builtin_amdgcn_s_sleep(1);
        if ((++sp & 255u) == 0u) { if (xb_ld(&bar[XB_TMO])) break; if (sp > XB_SPIN_CAP) { atomicAdd(&bar[XB_TMO], 1u); break; } }
    }
    nloc = mine > 0u ? mine : 1u; nx = cnt > 0u ? cnt : 1u;
}

__device__ __forceinline__ void xcd_barrier(const XcdBarrier& b) {
    asm volatile("s_waitcnt vmcnt(0)" ::: "memory");
    __syncthreads();
    if (threadIdx.x == 0) {
        unsigned* bar = b.bar;
        __builtin_amdgcn_s_waitcnt(0);
        unsigned nloc = b.st[0], nx = b.st[1];
        if (nloc == 0u) { xcd_barrier_complete(bar, b.x, nloc, nx); b.st[0] = nloc; b.st[1] = nx; }
        const unsigned old = xb_add(&bar[XB_XSUB(b.x)], 1u);
        const unsigned gen = old / nloc;
        if (old + 1u == (gen + 1u) * nloc) {
            __builtin_amdgcn_fence(__ATOMIC_RELEASE, "agent");
            asm volatile("s_waitcnt vmcnt(0)" ::: "memory");
            const unsigned og = xb_add(&bar[XB_TOP], 1u);
            const unsigned tg = og / nx;
            if (og + 1u == (tg + 1u) * nx) xb_add(&bar[XB_TOPGEN], 1u);
            else XB_SPIN(xb_ld(&bar[XB_TOPGEN]) == tg, bar);
            __builtin_amdgcn_fence(__ATOMIC_ACQUIRE, "agent");
            xb_add(&bar[XB_XGEN(b.x)], 1u);
            asm volatile("s_waitcnt vmcnt(0)" ::: "memory");
        } else {
            XB_SPIN(xb_ld(&bar[XB_XGEN(b.x)]) == gen, bar);
            __builtin_amdgcn_fence(__ATOMIC_ACQUIRE, "agent");
            asm volatile("s_waitcnt vmcnt(0)" ::: "memory");
        }
    }
    __syncthreads();
}

struct Args {
    const float* in[21]; float* out; unsigned char* ws; int ph_lo, ph_hi, li, pad;
};
enum { IN_XP = 0, IN_XS, IN_CK, IN_CV, IN_SCONV, IN_SSSM, IN_NMIX, IN_WIN, IN_QNW, IN_KNW, IN_SINK, IN_CONVW, IN_CONVB, IN_DTB, IN_ALOG, IN_DSKIP, IN_SNW, IN_WOUT, IN_NFFN, IN_WUP, IN_WDN };
enum { PH_PRO = 0, PH_INPROJ = 1, PH_MIXA = 2, PH_MIXB = 3, PH_MIXC = 4, PH_OUT = 5, PH_RSTD = 6, PH_UP = 7, PH_DOWN = 8, PH_DOWN2 = 9, PH_N = 10 };

struct Frame {
    LAS unsigned char* lds;
    volatile LAS unsigned* MISC;
    gu32* ctl;
    int tid, lane, wave;
    int vcu, G;
};
__device__ __forceinline__ float wave_sum(float v) {
#pragma unroll
    for (int o = 1; o < 64; o <<= 1) v += __shfl_xor(v, o);
    return v;
}
struct TItem { const float* W; bf16* WT; const float* kscale; int K, N, k0, n0, ncols, blocked; };
constexpr int T_NB_IN = (NPROJ + 63) / 64;
constexpr int T_I_IN = (DM / 64) * T_NB_IN, T_I_OUT = (DM / 64) * (DM / 64), T_I_UP = (DM / 64) * (FF / 64), T_I_DN = (FF / 64) * (DM / 64);
constexpr int T_NITEMS = T_I_IN + T_I_OUT + T_I_UP + T_I_DN;
__device__ __forceinline__ TItem p0_item(const Args& A, int it) {
    unsigned char* ws = A.ws;
    constexpr int NB_IN = T_NB_IN;
    constexpr int I_IN = T_I_IN, I_OUT = T_I_OUT, I_UP = T_I_UP;
    TItem t; int r = it;
    if (r < I_IN) { const int kb = r / NB_IN, nb = r % NB_IN; t = TItem{A.in[IN_WIN], (bf16*)(ws + WS_WIN), nullptr, DM, NPROJ, 64 * kb, 64 * nb, (nb == NB_IN - 1) ? NPROJ - 64 * (NB_IN - 1) : 64, 0}; return t; } r -= I_IN;
    if (r < I_OUT) { t = TItem{A.in[IN_WOUT], (bf16*)(ws + WS_WOUT), nullptr, DM, DM, 64 * (r / (DM / 64)), 64 * (r % (DM / 64)), 64, 0}; return t; } r -= I_OUT;
    if (r < I_UP) { t = TItem{A.in[IN_WUP], (bf16*)(ws + WS_WUP), A.in[IN_NFFN], DM, FF, 64 * (r / (FF / 64)), 64 * (r % (FF / 64)), 64, 0}; return t; } r -= I_UP;
    t = TItem{A.in[IN_WDN], (bf16*)(ws + WS_WDN), nullptr, FF, DM, 64 * (r / (DM / 64)), 64 * (r % (DM / 64)), 64, 1}; return t;
}
__device__ __forceinline__ void p0_tload(const TItem& t, int lane, f32x4 (&v)[16]) {
    const int kr = lane >> 4, c4 = (lane & 15) * 4; const bool lok = c4 < t.ncols;
#pragma unroll
    for (int i = 0; i < 16; ++i) v[i] = lok ? __builtin_nontemporal_load((const GAS f32x4*)(t.W + (size_t)(t.k0 + 4 * i + kr) * t.N + t.n0 + c4)) : (f32x4){0.f, 0.f, 0.f, 0.f};
}
__device__ __forceinline__ void p0_tstore(const TItem& t, int lane, LAS float* scr, f32x4 (&v)[16]) {
    const int kr = lane >> 4, c4 = (lane & 15) * 4;
    if (t.kscale) {
#pragma unroll
        for (int i = 0; i < 16; ++i) v[i] = v[i] * t.kscale[t.k0 + 4 * i + kr]; }
#pragma unroll
    for (int i = 0; i < 16; ++i) { LAS float* d = scr + (4 * i + kr) * 65 + c4; d[0] = v[i][0]; d[1] = v[i][1]; d[2] = v[i][2]; d[3] = v[i][3]; }
    LDS_WAIT(); asm volatile("" ::: "memory");
    const int c = lane & 7;
#pragma unroll
    for (int j = 0; j < 8; ++j) { const int n = (lane >> 3) + 8 * j; const LAS float* s = scr + (8 * c) * 65 + n;
        v4u o; o.x = pk2(s[0 * 65], s[1 * 65]); o.y = pk2(s[2 * 65], s[3 * 65]); o.z = pk2(s[4 * 65], s[5 * 65]); o.w = pk2(s[6 * 65], s[7 * 65]);
        if (n < t.ncols) *(GAS v4u*)(t.WT + (t.blocked ? pg8::blk_off(t.n0 + n, t.k0 + 8 * c, t.K) : (size_t)(t.n0 + n) * t.K + t.k0 + 8 * c)) = o; }
    LDS_WAIT(); asm volatile("" ::: "memory");
}
__device__ __forceinline__ void rms_row_to_bf16(int lane, const float* xrow, const float* w, bf16* orow) {
    const GAS f32x4* xr = (const GAS f32x4*)xrow + lane; const GAS f32x4* wr = (const GAS f32x4*)w + lane;
    f32x4 v[16]; float s = 0.f;
#pragma unroll
    for (int j = 0; j < 16; ++j) { v[j] = xr[64 * j]; s += (v[j].x * v[j].x + v[j].y * v[j].y) + (v[j].z * v[j].z + v[j].w * v[j].w); }
    const float rstd = 1.f / sqrtf(wave_sum(s) * (1.f / DM) + RMS_EPS);
    GAS unsigned long long* o8 = (GAS unsigned long long*)orow + lane;
#pragma unroll
    for (int j = 0; j < 16; ++j) { const f32x4 g = wr[64 * j];
        o8[64 * j] = (unsigned long long)pk2(v[j].x * rstd * g.x, v[j].y * rstd * g.y) | ((unsigned long long)pk2(v[j].z * rstd * g.z, v[j].w * rstd * g.w) << 32); }
}
__device__ __forceinline__ void p0_convert(Frame& F, const Args& A, int it0, int it1, int gw, int NGW) {
    LAS float* scr = (LAS float*)(F.lds + RING_OFF + F.wave * 16640);
    f32x4 va[16], vb[16];
    int it = it0 + gw; TItem ta, tb;
    if (it < it1) { ta = p0_item(A, it); p0_tload(ta, F.lane, va); }
    while (it < it1) {
        const int i1 = it + NGW; if (i1 < it1) { tb = p0_item(A, i1); p0_tload(tb, F.lane, vb); }
        p0_tstore(ta, F.lane, scr, va);
        if (i1 >= it1) break;
        const int i2 = i1 + NGW; if (i2 < it1) { ta = p0_item(A, i2); p0_tload(ta, F.lane, va); }
        p0_tstore(tb, F.lane, scr, vb);
        it = i2; }
}
__device__ __forceinline__ void p0_prologue(Frame& F, const Args& A) {
    unsigned char* ws = A.ws;
    const int gw = F.vcu * NWAVES + F.wave, NGW = F.G * NWAVES;
    p0_convert(F, A, 0, (F.G == 256) ? T_I_IN : T_NITEMS, gw, NGW);
    { GAS v4u* z = (GAS v4u*)(ws + WS_WIN + (size_t)NPROJ * DM * 2); const int nz = (LDP - NPROJ) * DM * 2 / 16;
      for (int i = gw * 64 + F.lane; i < nz; i += NGW * 64) z[i] = (v4u){0u, 0u, 0u, 0u}; }
    { float* rope = (float*)(ws + WS_ROPE);
      for (int i = gw * 64 + F.lane; i < SEQ * 8; i += NGW * 64) { const int pos = i >> 3, k = i & 7;
          const double inv = pow(500000.0, -(double)k / 8.0); const double ang = (double)pos * inv; rope[pos * 16 + k] = (float)cos(ang); rope[pos * 16 + 8 + k] = (float)sin(ang); } }
    bf16* H = (bf16*)(ws + WS_H);
    for (int m = gw; m < M; m += NGW) { const float* xr = m < NTOK_P ? A.in[IN_XP] + (size_t)m * DM : A.in[IN_XS] + (size_t)(m - NTOK_P) * DM;
        rms_row_to_bf16(F.lane, xr, A.in[IN_NMIX], H + (size_t)m * DM); }
}


struct RowInfo { int samp, b, t, pos; };
__device__ __forceinline__ RowInfo row_info(int row) { RowInfo r; if (row < NTOK_P) { r.samp = 0; r.b = row >> 13; r.t = row & (SEQ - 1); r.pos = r.t; } else { const int q = row - NTOK_P; r.samp = 1; r.b = q >> 5; r.t = q & 31; r.pos = PAST + r.t; } return r; }

__device__ __forceinline__ void nv_prep(const Args& A, int vb, int tid, bool write_kv) {
    const int row = vb, lane = tid & 63, w = tid >> 6;
    const RowInfo ri = row_info(row);
    unsigned char* ws = A.ws; const bf16* proj = (const bf16*)(ws + WS_PROJ); const bf16* pr = proj + (size_t)row * LDP;
    const float* rope = (const float*)(ws + WS_ROPE) + ri.pos * 16; float* kn = (float*)(ws + WS_KN) + (size_t)row * 512; float* bc = (float*)(ws + WS_X1B) + (size_t)row * 2048;
    float* out = A.out;
    for (int hh = 0; hh < 2; ++hh) { const int h = w + 4 * hh;
        const float kv = bf2f(pr[OFF_K + h * 64 + lane]);
        const float ss = wave_sum(kv * kv);
        const float kk = kv * (1.f / sqrtf(ss * (1.f / 64.f) + RMS_EPS)) * A.in[IN_KNW][lane];
        const float partner = __shfl_xor(kk, 8);
        float o = kk;
        if (lane < 16) { const float c = rope[lane & 7], s = rope[8 + (lane & 7)]; o = (lane < 8) ? kk * c - partner * s : kk * c + partner * s; }
        kn[h * 64 + lane] = o;
        const float vv = bf2f(pr[OFF_V + h * 64 + lane]);
        if (!write_kv) continue;
        if (!ri.samp) { if (ri.t >= SEQ - 128) { const size_t off = ((size_t)(ri.b * 128 + ri.t - (SEQ - 128)) * 8 + h) * 64 + lane; out[O_KP + off] = o; out[O_VP + off] = vv; } }
        else { const size_t off = ((size_t)(ri.b * 128 + 96 + ri.t) * 8 + h) * 64 + lane; out[O_KS + off] = o; out[O_VS + off] = vv; }
    }
    if (ri.samp && write_kv) {
        for (int i = tid; i < 3 * 512; i += 256) { const int j = ri.t * 3 + i / 512, e = i % 512; const size_t src = ((size_t)(ri.b * 128 + 32 + j)) * 512 + e, dst = ((size_t)(ri.b * 128 + j)) * 512 + e;
            out[O_KS + dst] = A.in[IN_CK][src]; out[O_VS + dst] = A.in[IN_CV][src]; }
    }
    for (int i = 0; i < 8; ++i) { const int c2 = tid * 8 + i, cc = 2048 + c2; float acc = A.in[IN_CONVB][cc];
        for (int j = 0; j < 4; ++j) { const int tt = ri.t - 3 + j; float v;
            if (tt >= 0) v = bf2f(proj[(size_t)(row - 3 + j) * LDP + OFF_B + c2]); else v = ri.samp ? A.in[IN_SCONV][((size_t)ri.b * 3 + (3 + tt)) * 4096 + cc] : 0.f;
            acc += A.in[IN_CONVW][j * 4096 + cc] * v; }
        bc[c2] = silu_f(acc); }
    const int tl = ri.samp ? DSEQ : SEQ;
    if (ri.t >= tl - 3) { float* dst = out + (ri.samp ? O_CS : O_CP) + ((size_t)ri.b * 3 + (ri.t - (tl - 3))) * 4096;
        for (int c = tid; c < 4096; c += 256) dst[c] = bf2f(pr[c < 2048 ? OFF_XS + c : OFF_B + (c - 2048)]); }
}

template <bool SAMPLE> __device__ __forceinline__ void nv_attn(const Args& A, int vb, int tid) {
    const int lane = tid & 63, g = tid >> 6;
    unsigned char* ws = A.ws; const bf16* proj = (const bf16*)(ws + WS_PROJ); const float* knb = (const float*)(ws + WS_KN); bf16* mix = (bf16*)(ws + WS_H);
    int b, c, kvh, row, pos; bool valid = true;
    if (!SAMPLE) { const int blk = vb; b = blk >> 10; c = (blk >> 3) & 127; kvh = blk & 7; row = b * SEQ + c * 64 + lane; pos = c * 64 + lane; }
    else { const int blk = vb; b = blk >> 3; c = 0; kvh = blk & 7; const int t = lane & 31; valid = lane < 32; row = NTOK_P + b * DSEQ + t; pos = PAST + t; }
    const int qh = kvh * 4 + g;
    float q[64]; float ss = 0.f;
    for (int d = 0; d < 64; ++d) { q[d] = bf2f(proj[(size_t)row * LDP + OFF_Q + qh * 64 + d]); ss += q[d] * q[d]; }
    const float rs = 1.f / sqrtf(ss * (1.f / 64.f) + RMS_EPS);
    for (int d = 0; d < 64; ++d) q[d] = q[d] * rs * A.in[IN_QNW][d];
    { const float* rope = (const float*)(ws + WS_ROPE) + pos * 16;
      for (int i = 0; i < 8; ++i) { const float cs = rope[i], sn = rope[8 + i], x1 = q[i], x2 = q[8 + i]; q[i] = x1 * cs - x2 * sn; q[8 + i] = x2 * cs + x1 * sn; } }
    for (int d = 0; d < 64; ++d) q[d] *= 0.125f;
    float m = A.in[IN_SINK][qh], l = 1.f; float o[64];
    for (int d = 0; d < 64; ++d) o[d] = 0.f;
    const int nk = SAMPLE ? 160 : 192;
    for (int kk = 0; kk < nk; ++kk) {
        const float* kp; const float* vpf = nullptr; const bf16* vpb = nullptr;
        if (!SAMPLE) { const int kt = c * 64 - 128 + kk; if (kt < 0) continue; const size_t kr = (size_t)b * SEQ + kt; kp = knb + kr * 512 + kvh * 64; vpb = proj + kr * LDP + OFF_V + kvh * 64; }
        else if (kk < 128) { const size_t off = ((size_t)(b * 128 + kk) * 8 + kvh) * 64; kp = A.in[IN_CK] + off; vpf = A.in[IN_CV] + off; }
        else { const size_t kr = (size_t)NTOK_P + b * DSEQ + (kk - 128); kp = knb + kr * 512 + kvh * 64; vpb = proj + kr * LDP + OFF_V + kvh * 64; }
        float s = 0.f;
        for (int d = 0; d < 64; ++d) s += q[d] * kp[d];
        const float mn = fmaxf(m, s), corr = __expf(m - mn), p = __expf(s - mn);
        l = l * corr + p; m = mn;
        if (vpf) { for (int d = 0; d < 64; ++d) o[d] = o[d] * corr + p * vpf[d]; }
        else { for (int d = 0; d < 64; ++d) o[d] = o[d] * corr + p * bf2f(vpb[d]); }
    }
    if (valid) { const float il = 1.f / l; bf16* dst = mix + (size_t)row * DM + qh * 64;
        for (int d = 0; d < 64; d += 2) *(unsigned*)(dst + d) = pk2(o[d] * il, o[d + 1] * il); }
}

__device__ __forceinline__ void nv_scan(const Args& A, int vb_, int Tloop, int tid, LAS float* sBp) {
    LAS float (*sB)[256] = (LAS float (*)[256])sBp;
    const bool live = vb_ >= 0; const int vb = live ? vb_ : 0;
    const int p = tid & 63, r = tid >> 6;
    const int seq = vb >> 3, g = vb & 7, h = g * 4 + r, ch = h * 64 + p;
    const bool samp = seq >= NB_P; const int b = samp ? seq - NB_P : seq; const int T = samp ? DSEQ : SEQ; const int row0 = samp ? NTOK_P + b * DSEQ : b * SEQ;
    unsigned char* ws = A.ws; const bf16* proj = (const bf16*)(ws + WS_PROJ); const float* bc = (const float*)(ws + WS_X1B); const float* dtr = (const float*)(ws + WS_DT);
    bf16* ybuf = (bf16*)(ws + WS_WIN);
    const float a = -__expf(A.in[IN_ALOG][h]), dtb = A.in[IN_DTB][h], D = A.in[IN_DSKIP][h];
    const float w0 = A.in[IN_CONVW][ch], w1 = A.in[IN_CONVW][4096 + ch], w2 = A.in[IN_CONVW][8192 + ch], w3 = A.in[IN_CONVW][12288 + ch], cb = A.in[IN_CONVB][ch];
    float x1 = 0.f, x2 = 0.f, x3 = 0.f; float st[128];
    if (samp) { x1 = A.in[IN_SCONV][((size_t)b * 3 + 0) * 4096 + ch]; x2 = A.in[IN_SCONV][((size_t)b * 3 + 1) * 4096 + ch]; x3 = A.in[IN_SCONV][((size_t)b * 3 + 2) * 4096 + ch];
        const float* s0 = A.in[IN_SSSM] + ((size_t)(b * 32 + h) * 64 + p) * 128;
        for (int n = 0; n < 128; ++n) st[n] = s0[n]; }
    else { for (int n = 0; n < 128; ++n) st[n] = 0.f; }
    for (int t0 = 0; t0 < Tloop; t0 += 16) {
        __syncthreads();
        for (int i = tid; i < 16 * 256; i += 256) { const int tt = i >> 8, j = i & 255; sB[tt][j] = bc[(size_t)(row0 + t0 + tt) * 2048 + (j < 128 ? g * 128 + j : 1024 + g * 128 + (j - 128))]; }
        __syncthreads();
        for (int tt = 0; tt < 16; ++tt) { const int row = row0 + t0 + tt;
            const float xr = bf2f(proj[(size_t)row * LDP + OFF_XS + ch]);
            const float xc = silu_f(cb + w0 * x1 + w1 * x2 + w2 * x3 + w3 * xr); x1 = x2; x2 = x3; x3 = xr;
            const float dtv = softplus_f(dtr[(size_t)row * 32 + h] + dtb), dA = __expf(dtv * a), xdt = xc * dtv;
            float y = 0.f;
#pragma unroll
            for (int n = 0; n < 128; ++n) { st[n] = st[n] * dA + xdt * sB[tt][n]; y += sB[tt][128 + n] * st[n]; }
            y += xc * D;
            if (live) ybuf[(size_t)row * 2048 + ch] = (bf16)f2bf(y); }
    }
    float* so = A.out + (samp ? O_SS : O_SP) + ((size_t)(b * 32 + h) * 64 + p) * 128;
    if (live) { for (int n = 0; n < 128; ++n) so[n] = st[n]; }
}

__device__ __forceinline__ void nv_gate(const Args& A, int vb, int tid) {
    const int row = vb;
    unsigned char* ws = A.ws; const bf16* proj = (const bf16*)(ws + WS_PROJ); const bf16* ybuf = (const bf16*)(ws + WS_WIN); bf16* mix = (bf16*)(ws + WS_H);
    float gv[8]; float ss = 0.f;
    for (int i = 0; i < 8; ++i) { const int c = tid * 8 + i; const float y = bf2f(ybuf[(size_t)row * 2048 + c]), z = bf2f(proj[(size_t)row * LDP + OFF_Z + c]); gv[i] = y * silu_f(z); ss += gv[i] * gv[i]; }
#pragma unroll
    for (int o = 1; o < 32; o <<= 1) ss += __shfl_xor(ss, o);
    const float rs = 1.f / sqrtf(ss * (1.f / 256.f) + RMS_EPS);
    for (int i = 0; i < 8; i += 2) { const int c = tid * 8 + i; *(unsigned*)(mix + (size_t)row * DM + 2048 + c) = pk2(gv[i] * rs * A.in[IN_SNW][c], gv[i + 1] * rs * A.in[IN_SNW][c + 1]); }
}

namespace mx {
typedef short v4i16 __attribute__((ext_vector_type(4)));
constexpr float LOG2E = 1.4426950408889634f;
__device__ __forceinline__ f32x4 mfma16(bf16x8 a, bf16x8 b, f32x4 c) { return __builtin_amdgcn_mfma_f32_16x16x32_bf16(a, b, c, 0, 0, 0); }
__device__ __forceinline__ bf16x8 ld_nat(LAS const unsigned char* img, int stride, int row0, int k0, int r16, int quad) {
    return *(LAS const bf16x8*)(img + (row0 + r16) * stride + (k0 + quad * 8) * 2);
}
__device__ __forceinline__ bf16x8 ld_trp(LAS const unsigned char* img, int stride, int krow0, int col0, int r16, int quad) {
    LAS const unsigned char* p = img + (krow0 + quad * 4 + (r16 >> 2)) * stride + (col0 + 4 * (r16 & 3)) * 2;
    const v4i16 lo = __builtin_amdgcn_ds_read_tr16_b64_v4i16((LAS v4i16*)p);
    const v4i16 hi = __builtin_amdgcn_ds_read_tr16_b64_v4i16((LAS v4i16*)(p + 16 * stride));
    return (bf16x8){lo[0], lo[1], lo[2], lo[3], hi[0], hi[1], hi[2], hi[3]};
}
typedef float f32x2_t __attribute__((ext_vector_type(2))); typedef __bf16 bf16x2_t __attribute__((ext_vector_type(2)));
__device__ __forceinline__ unsigned pkh(float lo, float hi) { const f32x2_t v = {lo, hi}; const bf16x2_t b = __builtin_convertvector(v, bf16x2_t); return __builtin_bit_cast(unsigned, b); }
__device__ __forceinline__ bf16x8 ld_trp_g(LAS const unsigned char* img, int stride, int krow0, int colbase, int r16, int quad, int t) {
    LAS const unsigned char* p = img + (krow0 + quad * 4 + (r16 >> 2)) * stride + (colbase + 16 * (r16 & 3) + 4 * t) * 2;
    const v4i16 lo = __builtin_amdgcn_ds_read_tr16_b64_v4i16((LAS v4i16*)p);
    const v4i16 hi = __builtin_amdgcn_ds_read_tr16_b64_v4i16((LAS v4i16*)(p + 16 * stride));
    return (bf16x8){lo[0], lo[1], lo[2], lo[3], hi[0], hi[1], hi[2], hi[3]};
}
__device__ __forceinline__ bf16x8 pack_p(const f32x4 lo, const f32x4 hi) {
    v4u w; w.x = pkh(lo[0], lo[1]); w.y = pkh(lo[2], lo[3]); w.z = pkh(hi[0], hi[1]); w.w = pkh(hi[2], hi[3]); return __builtin_bit_cast(bf16x8, w);
}
__device__ __forceinline__ void unpack8(const v4u w, float* x) { x[0] = bflo(w.x); x[1] = bfhi(w.x); x[2] = bflo(w.y); x[3] = bfhi(w.y); x[4] = bflo(w.z); x[5] = bfhi(w.z); x[6] = bflo(w.w); x[7] = bfhi(w.w); }
__device__ __forceinline__ v4u pack8(const float* x) { v4u w; w.x = pkh(x[0], x[1]); w.y = pkh(x[2], x[3]); w.z = pkh(x[4], x[5]); w.w = pkh(x[6], x[7]); return w; }

constexpr int AQ_OFF = 0, AK_OFF = 40960, AV_OFF = 40960 + 30720, A_STRIDE = 160;
struct AttnRegs { v4u q[4], k[4], v[3]; };
__device__ __forceinline__ void attn_load(const Args& A, int tid, int b, int c, int kvh, AttnRegs& R) {
    const int lane = tid & 63, w = __builtin_amdgcn_readfirstlane(tid >> 6);
    const bf16* proj = (const bf16*)(A.ws + WS_PROJ);
    const int vv = 32 * w + (lane & 31), hf = lane >> 5;
    { const int g = vv >> 6, tok = vv & 63; const v4u* src = (const v4u*)(proj + (size_t)(b * SEQ + c * 64 + tok) * LDP + OFF_Q + (kvh * 4 + g) * 64 + hf * 32);
#pragma unroll
      for (int j = 0; j < 4; ++j) R.q[j] = src[j]; }
    { const int vk = w < 6 ? vv : (lane & 31); int kt = c * 64 - 128 + vk; kt = kt < 0 ? 0 : kt; const v4u* src = (const v4u*)(proj + (size_t)(b * SEQ + kt) * LDP + OFF_K + kvh * 64 + hf * 32);
#pragma unroll
      for (int j = 0; j < 4; ++j) R.k[j] = src[j]; }
#pragma unroll
    for (int i = 0; i < 3; ++i) { const int id = tid + 512 * i, key = id >> 3, ch = id & 7; int kt = c * 64 - 128 + key; kt = kt < 0 ? 0 : kt;
        R.v[i] = *(const v4u*)(proj + (size_t)(b * SEQ + kt) * LDP + OFF_V + kvh * 64 + ch * 8); }
}
__device__ __forceinline__ void norm_rope_half(float* x, int hf, const float* nw, const float* rp, float scale) {
    float ss = 0.f;
#pragma unroll
    for (int i = 0; i < 32; ++i) ss += x[i] * x[i];
    ss += __shfl_xor(ss, 32);
    const float rs = 1.f / sqrtf(ss * (1.f / 64.f) + RMS_EPS);
#pragma unroll
    for (int i = 0; i < 32; ++i) x[i] = x[i] * rs * nw[hf * 32 + i];
    if (hf == 0) {
#pragma unroll
        for (int i = 0; i < 8; ++i) { const float cs = rp[i], sn = rp[8 + i], x1 = x[i], x2 = x[8 + i]; x[i] = x1 * cs - x2 * sn; x[8 + i] = x2 * cs + x1 * sn; } }
#pragma unroll
    for (int i = 0; i < 32; ++i) x[i] *= scale;
}
__device__ __forceinline__ void attn_stage(const Args& A, LAS unsigned char* lds, int tid, int b, int c, int kvh, const AttnRegs& R) {
    const int lane = tid & 63, w = __builtin_amdgcn_readfirstlane(tid >> 6);
    const float* rope = (const float*)(A.ws + WS_ROPE);
    LAS unsigned char* Qs = lds + AQ_OFF; LAS unsigned char* Ks = lds + AK_OFF; LAS unsigned char* Vs = lds + AV_OFF;
    float* out = A.out;
    const int v = 32 * w + (lane & 31), hf = lane >> 5;
    { const int tok = v & 63; float x[32];
#pragma unroll
      for (int j = 0; j < 4; ++j) unpack8(R.q[j], x + 8 * j);
      norm_rope_half(x, hf, A.in[IN_QNW], rope + (c * 64 + tok) * 16, 0.125f * LOG2E);
#pragma unroll
      for (int j = 0; j < 4; ++j) *(LAS v4u*)(Qs + v * A_STRIDE + hf * 64 + j * 16) = pack8(x + 8 * j); }
    if (w < 6) { const int kt = c * 64 - 128 + v; float x[32];
#pragma unroll
        for (int j = 0; j < 4; ++j) unpack8(R.k[j], x + 8 * j);
        norm_rope_half(x, hf, A.in[IN_KNW], rope + (kt < 0 ? 0 : kt) * 16, kt < 0 ? 0.f : 1.f);
#pragma unroll
        for (int j = 0; j < 4; ++j) *(LAS v4u*)(Ks + v * A_STRIDE + hf * 64 + j * 16) = pack8(x + 8 * j);
        if (c >= 126 && v >= 128) { float* dst = out + O_KP + ((size_t)(b * 128 + (c - 126) * 64 + (v - 128)) * 8 + kvh) * 64 + hf * 32;
#pragma unroll
            for (int j = 0; j < 8; ++j) *(f32x4*)(dst + 4 * j) = (f32x4){x[4 * j], x[4 * j + 1], x[4 * j + 2], x[4 * j + 3]}; } }
#pragma unroll
    for (int i = 0; i < 3; ++i) { const int id = tid + 512 * i, key = id >> 3, ch = id & 7; const int kt = c * 64 - 128 + key;
        v4u raw = R.v[i]; if (kt < 0) raw = (v4u){0u, 0u, 0u, 0u};
        *(LAS v4u*)(Vs + key * A_STRIDE + ch * 16) = raw;
        if (c >= 126 && key >= 128) { float x[8]; unpack8(raw, x); float* dst = out + O_VP + ((size_t)(b * 128 + (c - 126) * 64 + (key - 128)) * 8 + kvh) * 64 + ch * 8;
            *(f32x4*)(dst) = (f32x4){x[0], x[1], x[2], x[3]}; *(f32x4*)(dst + 4) = (f32x4){x[4], x[5], x[6], x[7]}; } }
}
__device__ __forceinline__ void attn_stage_sample(const Args& A, LAS unsigned char* lds, int tid, int b, int kvh) {
    const int lane = tid & 63, w = __builtin_amdgcn_readfirstlane(tid >> 6);
    const bf16* proj = (const bf16*)(A.ws + WS_PROJ); const float* rope = (const float*)(A.ws + WS_ROPE);
    LAS unsigned char* Qs = lds + AQ_OFF; LAS unsigned char* Ks = lds + AK_OFF; LAS unsigned char* Vs = lds + AV_OFF;
    float* out = A.out; const int qrow0 = NTOK_P + b * DSEQ;
    const int v = 32 * w + (lane & 31), hf = lane >> 5;
    { const int g = v >> 6, tok = v & 63; const bool ok = tok < DSEQ; float x[32];
      const v4u* src = (const v4u*)(proj + (size_t)(qrow0 + (ok ? tok : 0)) * LDP + OFF_Q + (kvh * 4 + g) * 64 + hf * 32);
#pragma unroll
      for (int j = 0; j < 4; ++j) unpack8(src[j], x + 8 * j);
      norm_rope_half(x, hf, A.in[IN_QNW], rope + (PAST + (ok ? tok : 0)) * 16, ok ? 0.125f * LOG2E : 0.f);
#pragma unroll
      for (int j = 0; j < 4; ++j) *(LAS v4u*)(Qs + v * A_STRIDE + hf * 64 + j * 16) = pack8(x + 8 * j); }
    if (w < 6) { float x[32];
        if (w < 4) { const f32x4* src = (const f32x4*)(A.in[IN_CK] + ((size_t)(b * 128 + v) * 8 + kvh) * 64 + hf * 32);
#pragma unroll
            for (int j = 0; j < 8; ++j) { const f32x4 t = src[j]; x[4 * j] = t[0]; x[4 * j + 1] = t[1]; x[4 * j + 2] = t[2]; x[4 * j + 3] = t[3]; } }
        else if (w == 4) { const v4u* src = (const v4u*)(proj + (size_t)(qrow0 + (v - 128)) * LDP + OFF_K + kvh * 64 + hf * 32);
#pragma unroll
            for (int j = 0; j < 4; ++j) unpack8(src[j], x + 8 * j);
            norm_rope_half(x, hf, A.in[IN_KNW], rope + (PAST + (v - 128)) * 16, 1.f); }
        else {
#pragma unroll
            for (int i = 0; i < 32; ++i) x[i] = 0.f; }
#pragma unroll
        for (int j = 0; j < 4; ++j) *(LAS v4u*)(Ks + v * A_STRIDE + hf * 64 + j * 16) = pack8(x + 8 * j);
        if (v >= 32 && v < 160) { float* dst = out + O_KS + ((size_t)(b * 128 + (v - 32)) * 8 + kvh) * 64 + hf * 32;
#pragma unroll
            for (int j = 0; j < 8; ++j) *(f32x4*)(dst + 4 * j) = (f32x4){x[4 * j], x[4 * j + 1], x[4 * j + 2], x[4 * j + 3]}; } }
#pragma unroll
    for (int i = 0; i < 3; ++i) { const int id = tid + 512 * i, key = id >> 3, ch = id & 7; float x[8];
        if (key < 128) { const f32x4* src = (const f32x4*)(A.in[IN_CV] + ((size_t)(b * 128 + key) * 8 + kvh) * 64 + ch * 8); const f32x4 t0 = src[0], t1 = src[1];
            x[0] = t0[0]; x[1] = t0[1]; x[2] = t0[2]; x[3] = t0[3]; x[4] = t1[0]; x[5] = t1[1]; x[6] = t1[2]; x[7] = t1[3]; }
        else if (key < 160) unpack8(*(const v4u*)(proj + (size_t)(qrow0 + (key - 128)) * LDP + OFF_V + kvh * 64 + ch * 8), x);
        else {
#pragma unroll
            for (int e = 0; e < 8; ++e) x[e] = 0.f; }
        *(LAS v4u*)(Vs + key * A_STRIDE + ch * 16) = pack8(x);
        if (key >= 32 && key < 160) { float* dst = out + O_VS + ((size_t)(b * 128 + (key - 32)) * 8 + kvh) * 64 + ch * 8;
            *(f32x4*)(dst) = (f32x4){x[0], x[1], x[2], x[3]}; *(f32x4*)(dst + 4) = (f32x4){x[4], x[5], x[6], x[7]}; } }
}
template <bool SAMPLE>
__device__ __forceinline__ void attn_compute(const Args& A, LAS unsigned char* lds, int tid, int b, int c, int kvh) {
    const int lane = tid & 63, w = __builtin_amdgcn_readfirstlane(tid >> 6), r16 = lane & 15, quad = lane >> 4;
    bf16* mix = (bf16*)(A.ws + WS_H);
    LAS const unsigned char* Qs = lds + AQ_OFF; LAS const unsigned char* Ks = lds + AK_OFF; LAS const unsigned char* Vs = lds + AV_OFF;
    const int qrow0 = SAMPLE ? NTOK_P + b * DSEQ : b * SEQ + c * 64;
    const int g = w >> 1, qh = kvh * 4 + g;
    const float sink2 = A.in[IN_SINK][qh] * LOG2E;
    const int kmin = SAMPLE ? 0 : (c >= 2 ? 0 : 128 - 64 * c), kmax = SAMPLE ? 160 : 192;
#pragma unroll
    for (int qt = 0; qt < 2; ++qt) {
        const bf16x8 q0 = ld_nat(Qs, A_STRIDE, 32 * w + 16 * qt, 0, r16, quad), q1 = ld_nat(Qs, A_STRIDE, 32 * w + 16 * qt, 32, r16, quad);
        f32x4 s[12];
#pragma unroll
        for (int kt = 0; kt < 12; ++kt) { const bf16x8 k0 = ld_nat(Ks, A_STRIDE, 16 * kt, 0, r16, quad), k1 = ld_nat(Ks, A_STRIDE, 16 * kt, 32, r16, quad);
            s[kt] = mfma16(k1, q1, mfma16(k0, q0, (f32x4){0.f, 0.f, 0.f, 0.f}));
            if ((kt & 3) == 3) asm volatile("" ::: "memory"); }
        float mx = sink2;
#pragma unroll
        for (int kt = 0; kt < 12; ++kt)
#pragma unroll
            for (int j = 0; j < 4; ++j) { const int key = 16 * kt + 4 * quad + j; const float v = (key >= kmin && key < kmax) ? s[kt][j] : -1e30f; s[kt][j] = v; mx = fmaxf(mx, v); }
        mx = fmaxf(mx, __shfl_xor(mx, 16)); mx = fmaxf(mx, __shfl_xor(mx, 32));
        float l = 0.f;
#pragma unroll
        for (int kt = 0; kt < 12; ++kt)
#pragma unroll
            for (int j = 0; j < 4; ++j) { const float p = __builtin_amdgcn_exp2f(s[kt][j] - mx); s[kt][j] = p; l += p; }
        l += __shfl_xor(l, 16); l += __shfl_xor(l, 32); l += __builtin_amdgcn_exp2f(sink2 - mx);
        f32x4 o[4];
#pragma unroll
        for (int dt = 0; dt < 4; ++dt) o[dt] = (f32x4){0.f, 0.f, 0.f, 0.f};
#pragma unroll
        for (int s2 = 0; s2 < 6; ++s2) { const bf16x8 pf = pack_p(s[2 * s2], s[2 * s2 + 1]);
#pragma unroll
            for (int dt = 0; dt < 4; ++dt) o[dt] = mfma16(ld_trp_g(Vs, A_STRIDE, 32 * s2, 0, r16, quad, dt), pf, o[dt]);
            if (s2 & 1) asm volatile("" ::: "memory"); }
        const int tok = (w & 1) * 32 + 16 * qt + r16; const float il = 1.f / l;
        if (!SAMPLE || tok < DSEQ) { bf16* dst = mix + (size_t)(qrow0 + tok) * DM + qh * 64 + 16 * quad;
            v4u w0, w1; w0.x = pkh(o[0][0] * il, o[0][1] * il); w0.y = pkh(o[0][2] * il, o[0][3] * il); w0.z = pkh(o[1][0] * il, o[1][1] * il); w0.w = pkh(o[1][2] * il, o[1][3] * il);
            w1.x = pkh(o[2][0] * il, o[2][1] * il); w1.y = pkh(o[2][2] * il, o[2][3] * il); w1.z = pkh(o[3][0] * il, o[3][1] * il); w1.w = pkh(o[3][2] * il, o[3][3] * il);
            *(v4u*)dst = w0; *(v4u*)(dst + 8) = w1; }
    }
}

constexpr int SX_OFF = 0, SXW_OFF = 34816, SB_OFF = 69632, SC_OFF = 88064, SDT_OFF = 106496, SAC_OFF = 107520, SPART_OFF = 108544;
constexpr int X_STRIDE = 544, BC_STRIDE = 288;
struct SsdRegs { v4u raw[11]; float dtr; };
__device__ __forceinline__ void ssd_cols(int cc, int g, int& pcol, int& cch) {
    if (cc < 32) { pcol = OFF_XS + g * 256 + cc * 8; cch = g * 256 + cc * 8; }
    else if (cc < 48) { pcol = OFF_B + g * 128 + (cc - 32) * 8; cch = 2048 + g * 128 + (cc - 32) * 8; }
    else { pcol = OFF_C + g * 128 + (cc - 48) * 8; cch = 3072 + g * 128 + (cc - 48) * 8; }
}
template <bool SAMPLE, bool WANT_C = true>
__device__ __forceinline__ void ssd_load(const Args& A, int tid, int b, int c, int g, SsdRegs& R) {
    const int lane = tid & 63, w = __builtin_amdgcn_readfirstlane(tid >> 6);
    const bf16* proj = (const bf16*)(A.ws + WS_PROJ); const float* dtr = (const float*)(A.ws + WS_DT);
    const int row0 = SAMPLE ? NTOK_P + b * DSEQ : b * SEQ + c * 64; constexpr int L = SAMPLE ? DSEQ : 64;
    int pcol, cch; ssd_cols(lane, g, pcol, cch);
#pragma unroll
    for (int j = 0; j < 11; ++j) { int lr = 8 * w - 3 + j;
        if (SAMPLE) lr = lr < 0 ? 0 : (lr >= L ? L - 1 : lr); else if (c == 0 && lr < 0) lr = 0;
        if (WANT_C || lane < 48) R.raw[j] = *(const v4u*)(proj + (size_t)(row0 + lr) * LDP + pcol); else R.raw[j] = (v4u){0u, 0u, 0u, 0u}; }
    { const int l = lane < L ? lane : L - 1; R.dtr = dtr[(size_t)(row0 + l) * 32 + g * 4 + (w & 3)]; }
}
template <bool SAMPLE, bool WANT_X, bool WANT_XW, bool WANT_C>
__device__ __forceinline__ void ssd_stage(const Args& A, LAS unsigned char* lds, int tid, int b, int c, int g, const SsdRegs& R) {
    const int lane = tid & 63, w = __builtin_amdgcn_readfirstlane(tid >> 6);
    LAS float* sdt = (LAS float*)(lds + SDT_OFF); LAS float* sac = (LAS float*)(lds + SAC_OFF);
    constexpr int L = SAMPLE ? DSEQ : 64;
    if (w < 4) { const int r = w, l = lane, h = g * 4 + r;
        const float dtv = (l < L) ? softplus_f(R.dtr + A.in[IN_DTB][h]) : 0.f;
        const float a = -__expf(A.in[IN_ALOG][h]);
        float cs = dtv * a;
#pragma unroll
        for (int o = 1; o < 64; o <<= 1) { const float t = __shfl_up(cs, o); if (lane >= o) cs += t; }
        sdt[l * 4 + r] = dtv; sac[l * 4 + r] = cs; }
    if (WANT_XW) __syncthreads();
    const int cc = lane, rb = w;
    int pcol, cch; ssd_cols(cc, g, pcol, cch);
    if (WANT_C || cc < 48) {
        float wg[4][8], bias[8], win[3][8];
#pragma unroll
        for (int j = 0; j < 4; ++j) { const f32x4 t0 = *(const f32x4*)(A.in[IN_CONVW] + j * 4096 + cch), t1 = *(const f32x4*)(A.in[IN_CONVW] + j * 4096 + cch + 4);
            wg[j][0] = t0[0]; wg[j][1] = t0[1]; wg[j][2] = t0[2]; wg[j][3] = t0[3]; wg[j][4] = t1[0]; wg[j][5] = t1[1]; wg[j][6] = t1[2]; wg[j][7] = t1[3]; }
        { const f32x4 t0 = *(const f32x4*)(A.in[IN_CONVB] + cch), t1 = *(const f32x4*)(A.in[IN_CONVB] + cch + 4);
          bias[0] = t0[0]; bias[1] = t0[1]; bias[2] = t0[2]; bias[3] = t0[3]; bias[4] = t1[0]; bias[5] = t1[1]; bias[6] = t1[2]; bias[7] = t1[3]; }
#pragma unroll
        for (int j = 0; j < 3; ++j) { const int lr = 8 * rb - 3 + j;
            unpack8(R.raw[j], win[j]);
            if (SAMPLE && lr < 0) { const float* sp = A.in[IN_SCONV] + ((size_t)b * 3 + (3 + lr)) * 4096 + cch; const f32x4 t0 = *(const f32x4*)sp, t1 = *(const f32x4*)(sp + 4);
                win[j][0] = t0[0]; win[j][1] = t0[1]; win[j][2] = t0[2]; win[j][3] = t0[3]; win[j][4] = t1[0]; win[j][5] = t1[1]; win[j][6] = t1[2]; win[j][7] = t1[3]; }
            const bool z = SAMPLE ? (lr >= L) : (lr < 0 && c == 0);
            if (z) {
#pragma unroll
                for (int e = 0; e < 8; ++e) win[j][e] = 0.f; } }
        const int r = (cc >> 3) & 3;
        const float alast = WANT_XW ? sac[63 * 4 + r] : 0.f;
#pragma unroll
        for (int i = 0; i < 8; ++i) { const int l = 8 * rb + i; float cur[8], val[8];
            unpack8(R.raw[3 + i], cur);
            if (SAMPLE && l >= L) {
#pragma unroll
                for (int e = 0; e < 8; ++e) cur[e] = 0.f; }
#pragma unroll
            for (int e = 0; e < 8; ++e) val[e] = silu_f(bias[e] + wg[0][e] * win[0][e] + wg[1][e] * win[1][e] + wg[2][e] * win[2][e] + wg[3][e] * cur[e]);
            if (cc < 32) {
                if (WANT_X) *(LAS v4u*)(lds + SX_OFF + l * X_STRIDE + cc * 16) = pack8(val);
                if (WANT_XW) { const float sc = __expf(alast - sac[l * 4 + r]) * sdt[l * 4 + r]; float xw[8];
#pragma unroll
                    for (int e = 0; e < 8; ++e) xw[e] = val[e] * sc;
                    *(LAS v4u*)(lds + SXW_OFF + l * X_STRIDE + cc * 16) = pack8(xw); }
            } else if (cc < 48) *(LAS v4u*)(lds + SB_OFF + l * BC_STRIDE + (cc - 32) * 16) = pack8(val);
            else *(LAS v4u*)(lds + SC_OFF + l * BC_STRIDE + (cc - 48) * 16) = pack8(val);
            if (SAMPLE ? (l >= DSEQ - 3 && l < DSEQ) : (c == 127 && l >= 61)) {
                float* dst = A.out + (SAMPLE ? O_CS : O_CP) + ((size_t)b * 3 + (l - (L - 3))) * 4096 + cch;
                *(f32x4*)dst = (f32x4){cur[0], cur[1], cur[2], cur[3]}; *(f32x4*)(dst + 4) = (f32x4){cur[4], cur[5], cur[6], cur[7]}; }
#pragma unroll
            for (int e = 0; e < 8; ++e) { win[0][e] = win[1][e]; win[1][e] = win[2][e]; win[2][e] = cur[e]; } }
    }
}
template <bool SAMPLE>
__device__ __forceinline__ void ssd_states(const Args& A, LAS unsigned char* lds, int tid, int b, int c, int g) {
    const int lane = tid & 63, w = __builtin_amdgcn_readfirstlane(tid >> 6), r16 = lane & 15, quad = lane >> 4;
    const int r = w >> 1, nh = w & 1, h = g * 4 + r;
    LAS const unsigned char* Bi = lds + SB_OFF; LAS const unsigned char* XWi = lds + SXW_OFF; LAS const float* sac = (LAS const float*)(lds + SAC_OFF);
    f32x4 acc[4][4];
#pragma unroll
    for (int nt = 0; nt < 4; ++nt)
#pragma unroll
        for (int pt = 0; pt < 4; ++pt) acc[nt][pt] = (f32x4){0.f, 0.f, 0.f, 0.f};
#pragma unroll
    for (int s2 = 0; s2 < 2; ++s2) { bf16x8 af[4], bf[4];
#pragma unroll
        for (int nt = 0; nt < 4; ++nt) af[nt] = ld_trp_g(Bi, BC_STRIDE, 32 * s2, nh * 64, r16, quad, nt);
#pragma unroll
        for (int pt = 0; pt < 4; ++pt) bf[pt] = ld_trp(XWi, X_STRIDE, 32 * s2, r * 64 + 16 * pt, r16, quad);
#pragma unroll
        for (int nt = 0; nt < 4; ++nt)
#pragma unroll
            for (int pt = 0; pt < 4; ++pt) acc[nt][pt] = mfma16(af[nt], bf[pt], acc[nt][pt]); }
    const float dec = __expf(sac[63 * 4 + r]);
    if (!SAMPLE) {
        bf16* st = (bf16*)(A.ws + WS_X1B) + ((size_t)((b * 128 + c) * 32 + h) * 64) * 128;
#pragma unroll
        for (int pt = 0; pt < 4; ++pt) { bf16* d = st + (size_t)(16 * pt + r16) * 128 + nh * 64 + 16 * quad;
            v4u w0, w1; w0.x = pkh(acc[0][pt][0], acc[0][pt][1]); w0.y = pkh(acc[0][pt][2], acc[0][pt][3]); w0.z = pkh(acc[1][pt][0], acc[1][pt][1]); w0.w = pkh(acc[1][pt][2], acc[1][pt][3]);
            w1.x = pkh(acc[2][pt][0], acc[2][pt][1]); w1.y = pkh(acc[2][pt][2], acc[2][pt][3]); w1.z = pkh(acc[3][pt][0], acc[3][pt][1]); w1.w = pkh(acc[3][pt][2], acc[3][pt][3]);
            *(v4u*)d = w0; *(v4u*)(d + 8) = w1; }
        if (nh == 0 && lane == 0) ((float*)(A.ws + WS_DECAY))[(b * 128 + c) * 32 + h] = dec;
    } else {
        const float* s0 = A.in[IN_SSSM] + ((size_t)(b * 32 + h) * 64) * 128; float* so = A.out + O_SS + ((size_t)(b * 32 + h) * 64) * 128;
#pragma unroll
        for (int nt = 0; nt < 4; ++nt)
#pragma unroll
            for (int pt = 0; pt < 4; ++pt) { const size_t off = (size_t)(16 * pt + r16) * 128 + nh * 64 + 16 * quad + 4 * nt;
                *(f32x4*)(so + off) = *(const f32x4*)(s0 + off) * dec + acc[nt][pt]; if (pt == 3 && (nt & 1)) asm volatile("" ::: "memory"); }
    }
}
template <bool SAMPLE>
__device__ __forceinline__ void ssd_output(const Args& A, LAS unsigned char* lds, int tid, int b, int c, int g) {
    const int lane = tid & 63, w = __builtin_amdgcn_readfirstlane(tid >> 6), r16 = lane & 15, quad = lane >> 4;
    const int r = w >> 1, lh = w & 1, h = g * 4 + r;
    unsigned char* ws = A.ws; const bf16* proj = (const bf16*)(ws + WS_PROJ); bf16* mix = (bf16*)(ws + WS_H);
    LAS const unsigned char* Xi = lds + SX_OFF; LAS const unsigned char* Bi = lds + SB_OFF; LAS const unsigned char* Ci = lds + SC_OFF;
    LAS const float* sdt = (LAS const float*)(lds + SDT_OFF); LAS const float* sac = (LAS const float*)(lds + SAC_OFF); LAS float* spart = (LAS float*)(lds + SPART_OFF);
    const int row0 = SAMPLE ? NTOK_P + b * DSEQ : b * SEQ + c * 64;
    v2u zreg[2][4];
#pragma unroll
    for (int lti = 0; lti < 2; ++lti) { const int l = 32 * lh + 16 * lti + r16; const int lz = (!SAMPLE || l < DSEQ) ? l : 0;
#pragma unroll
        for (int pt = 0; pt < 4; ++pt) zreg[lti][pt] = *(const v2u*)(proj + (size_t)(row0 + lz) * LDP + OFF_Z + h * 64 + 16 * quad + 4 * pt); }
    f32x4 gt[4][2];
#pragma unroll
    for (int st = 0; st < 4; ++st) { gt[st][0] = (f32x4){0.f, 0.f, 0.f, 0.f}; gt[st][1] = (f32x4){0.f, 0.f, 0.f, 0.f}; }
#pragma unroll
    for (int ks = 0; ks < 4; ++ks) { const bf16x8 c0 = ld_nat(Ci, BC_STRIDE, 32 * lh, 32 * ks, r16, quad), c1 = ld_nat(Ci, BC_STRIDE, 32 * lh + 16, 32 * ks, r16, quad);
#pragma unroll
        for (int st = 0; st < 4; ++st) { const bf16x8 bfr = ld_nat(Bi, BC_STRIDE, 16 * st, 32 * ks, r16, quad); gt[st][0] = mfma16(bfr, c0, gt[st][0]); gt[st][1] = mfma16(bfr, c1, gt[st][1]); } }
    float al[2];
#pragma unroll
    for (int lti = 0; lti < 2; ++lti) al[lti] = sac[(32 * lh + 16 * lti + r16) * 4 + r];
#pragma unroll
    for (int st = 0; st < 4; ++st)
#pragma unroll
        for (int j = 0; j < 4; ++j) { const int s = 16 * st + 4 * quad + j; const float as = sac[s * 4 + r], ds = sdt[s * 4 + r];
#pragma unroll
            for (int lti = 0; lti < 2; ++lti) { const int l = 32 * lh + 16 * lti + r16; gt[st][lti][j] = (s <= l) ? gt[st][lti][j] * __expf(al[lti] - as) * ds : 0.f; } }
    f32x4 ya[4][2];
#pragma unroll
    for (int pt = 0; pt < 4; ++pt) { ya[pt][0] = (f32x4){0.f, 0.f, 0.f, 0.f}; ya[pt][1] = (f32x4){0.f, 0.f, 0.f, 0.f}; }
#pragma unroll
    for (int s2 = 0; s2 < 2; ++s2) { const bf16x8 m0 = pack_p(gt[2 * s2][0], gt[2 * s2 + 1][0]), m1 = pack_p(gt[2 * s2][1], gt[2 * s2 + 1][1]);
#pragma unroll
        for (int pt = 0; pt < 4; ++pt) { const bf16x8 xa = ld_trp_g(Xi, X_STRIDE, 32 * s2, r * 64, r16, quad, pt); ya[pt][0] = mfma16(xa, m0, ya[pt][0]); ya[pt][1] = mfma16(xa, m1, ya[pt][1]); } }
    {
        f32x4 oa[4][2];
#pragma unroll
        for (int pt = 0; pt < 4; ++pt) { oa[pt][0] = (f32x4){0.f, 0.f, 0.f, 0.f}; oa[pt][1] = (f32x4){0.f, 0.f, 0.f, 0.f}; }
#pragma unroll
        for (int ks = 0; ks < 4; ++ks) { const bf16x8 c0 = ld_nat(Ci, BC_STRIDE, 32 * lh, 32 * ks, r16, quad), c1 = ld_nat(Ci, BC_STRIDE, 32 * lh + 16, 32 * ks, r16, quad);
#pragma unroll
            for (int pt = 0; pt < 4; ++pt) { bf16x8 pa;
                if (!SAMPLE) pa = *(const bf16x8*)((const bf16*)(ws + WS_X1B) + ((size_t)((b * 128 + c) * 32 + h) * 64 + 16 * (r16 >> 2) + 4 * pt + (r16 & 3)) * 128 + 32 * ks + 8 * quad);
                else { const float* sp = A.in[IN_SSSM] + ((size_t)(b * 32 + h) * 64 + 16 * (r16 >> 2) + 4 * pt + (r16 & 3)) * 128 + 32 * ks + 8 * quad; const f32x4 t0 = *(const f32x4*)sp, t1 = *(const f32x4*)(sp + 4);
                    v4u wv; wv.x = pkh(t0[0], t0[1]); wv.y = pkh(t0[2], t0[3]); wv.z = pkh(t1[0], t1[1]); wv.w = pkh(t1[2], t1[3]); pa = __builtin_bit_cast(bf16x8, wv); }
                oa[pt][0] = mfma16(pa, c0, oa[pt][0]); oa[pt][1] = mfma16(pa, c1, oa[pt][1]); }
            if (ks & 1) asm volatile("" ::: "memory"); }
#pragma unroll
        for (int lti = 0; lti < 2; ++lti) { const float el = __expf(al[lti]);
#pragma unroll
            for (int pt = 0; pt < 4; ++pt) ya[pt][lti] = ya[pt][lti] + oa[pt][lti] * el; }
    }
    const float D = A.in[IN_DSKIP][h];
    float ss[2];
#pragma unroll
    for (int lti = 0; lti < 2; ++lti) { const int l = 32 * lh + 16 * lti + r16; ss[lti] = 0.f;
#pragma unroll
        for (int pt = 0; pt < 4; ++pt) { const v2u xw = *(LAS const v2u*)(Xi + l * X_STRIDE + (r * 64 + 16 * quad + 4 * pt) * 2);
            const v2u zw = zreg[lti][pt];
            const float xv[4] = {bflo(xw.x), bfhi(xw.x), bflo(xw.y), bfhi(xw.y)}, zv[4] = {bflo(zw.x), bfhi(zw.x), bflo(zw.y), bfhi(zw.y)};
#pragma unroll
            for (int j = 0; j < 4; ++j) { const float y = ya[pt][lti][j] + xv[j] * D, gv = y * silu_f(zv[j]); ya[pt][lti][j] = gv; ss[lti] += gv * gv; } }
        ss[lti] += __shfl_xor(ss[lti], 16); ss[lti] += __shfl_xor(ss[lti], 32);
        if (quad == 0) spart[l * 4 + r] = ss[lti]; }
    __syncthreads();
#pragma unroll
    for (int lti = 0; lti < 2; ++lti) { const int l = 32 * lh + 16 * lti + r16;
        const f32x4 pr = *(LAS const f32x4*)(spart + l * 4); const float rs = 1.f / sqrtf(((pr[0] + pr[1]) + (pr[2] + pr[3])) * (1.f / 256.f) + RMS_EPS);
        if (!SAMPLE || l < DSEQ) {
            unsigned wv[8];
#pragma unroll
            for (int pt = 0; pt < 4; ++pt) { const f32x4 nw = *(const f32x4*)(A.in[IN_SNW] + h * 64 + 16 * quad + 4 * pt);
                wv[2 * pt] = pkh(ya[pt][lti][0] * rs * nw[0], ya[pt][lti][1] * rs * nw[1]); wv[2 * pt + 1] = pkh(ya[pt][lti][2] * rs * nw[2], ya[pt][lti][3] * rs * nw[3]); }
            bf16* d = mix + (size_t)(row0 + l) * DM + 2048 + h * 64 + 16 * quad;
            *(v4u*)d = (v4u){wv[0], wv[1], wv[2], wv[3]}; *(v4u*)(d + 8) = (v4u){wv[4], wv[5], wv[6], wv[7]}; } }
    __syncthreads();
}
template <bool DRY = false> __device__ __forceinline__ void ssd_pass(const Args& A, int gid) {
    const int n4 = gid & 31, p = (gid >> 5) & 63, h = (gid >> 11) & 31, b = gid >> 16;
    bf16* st = (bf16*)(A.ws + WS_X1B); const float* dec = (const float*)(A.ws + WS_DECAY);
    f32x4 run = (f32x4){0.f, 0.f, 0.f, 0.f};
    for (int c0 = 0; c0 < 128; c0 += 8) { v2u loc[8]; float d[8];
#pragma unroll
        for (int i = 0; i < 8; ++i) { const int c = c0 + i; loc[i] = *(const v2u*)(st + ((size_t)((b * 128 + c) * 32 + h) * 64 + p) * 128 + n4 * 4); d[i] = dec[(b * 128 + c) * 32 + h]; }
#pragma unroll
        for (int i = 0; i < 8; ++i) { const int c = c0 + i; v2u pv; pv.x = pkh(run[0], run[1]); pv.y = pkh(run[2], run[3]);
            *(v2u*)(st + ((size_t)((b * 128 + c) * 32 + h) * 64 + p) * 128 + n4 * 4) = DRY ? loc[i] : pv;
            run = run * d[i] + (f32x4){bflo(loc[i].x), bfhi(loc[i].x), bflo(loc[i].y), bfhi(loc[i].y)}; } }
    if (!DRY) *(f32x4*)(A.out + O_SP + ((size_t)(b * 32 + h) * 64 + p) * 128 + n4 * 4) = run;
    else if (run[0] == 12345.678f) *(f32x4*)(A.out + O_SP) = run;
}
}
#ifndef PROBE_DUP
#define PROBE_DUP -1
#endif
#define REP(k) for (int rep_ = 0; rep_ < ((PROBE_DUP == (k)) ? 2 : 1); ++rep_)
#ifndef DOWN_WGM
#define DOWN_WGM 8
#endif
#ifndef MIX_FAST_ATTN
#define MIX_FAST_ATTN 1
#endif
#ifndef MIX_FAST_SSD
#define MIX_FAST_SSD 1
#endif
__global__ void __launch_bounds__(NWAVES * 64, 2) mega_fwd(Args args) {
    extern __shared__ __attribute__((aligned(16))) unsigned char lds[];
    Frame F;
    F.lds = (LAS unsigned char*)lds;
    F.MISC = (volatile LAS unsigned*)(F.lds + MISC_OFF);
    F.tid = threadIdx.x; F.lane = F.tid & 63; F.wave = __builtin_amdgcn_readfirstlane(F.tid >> 6);
    F.G = gridDim.x; { const int bx = blockIdx.x; F.vcu = (F.G % 8 == 0) ? (bx % 8) * (F.G / 8) + bx / 8 : bx; }
    unsigned char* ws = args.ws;
    F.ctl = (gu32*)(ws + WS_CTL);
    for (int u = F.tid; u < (LDS_BYTES - LDSCTL_OFF) / 4; u += NWAVES * 64) ((LAS unsigned*)(F.lds + LDSCTL_OFF))[u] = 0u;
    __syncthreads();
#if defined(PROBE_SUB)
    const int sub_ = args.ph_lo >= 100 ? args.ph_lo - 100 : -1;
    const int lo = sub_ >= 0 ? PH_MIXA : args.ph_lo, hi = sub_ >= 0 ? PH_MIXA + 1 : args.ph_hi;
#define SUB(k) (sub_ < 0 || sub_ == (k))
#else
    const int lo = args.ph_lo, hi = args.ph_hi;
#define SUB(k) true
#endif
    const bool multi = (hi - lo) > 1;
    XcdBarrier bar; bar.bar = (unsigned*)(F.ctl + CW_BAR) + args.li * XCD_BAR_WORDS; bar.x = 0; bar.st = nullptr;
    if (multi) bar = xcd_barrier_post((unsigned*)(F.ctl + CW_BAR) + args.li * XCD_BAR_WORDS, F.MISC + 8);
#define IN(k) (lo <= (k) && (k) < hi)
#define SEAM(k) do { if (IN(k) && IN((k) + 1)) xcd_barrier(bar); } while (0)

    if (IN(PH_PRO)) { REP(PH_PRO) { p0_prologue(F, args); } SEAM(PH_PRO); }

    if (IN(PH_INPROJ)) {
        const pg8::Gemm g = pg8::gemm_rm((const bf16*)(ws + WS_H), (const bf16*)(ws + WS_WIN), M, LDP, DM, DM); pg8::StaticOrder S; S.init(M, LDP, F.G, (int)blockIdx.x);
        pg8::EpiProj E{(bf16*)(ws + WS_PROJ), LDP, (float*)(ws + WS_DT), OFF_DT / 256};
        if (F.G != 256) { pg8::gemm_phase<pg8::EpiProj, pg8::StaticOrder, PG8_ALIGN, PG8_SP2>(F.lds + RING_OFF, g, S, E); }
        else {
            constexpr int NR = (M / 256) * (LDP / 256) / 256 + 1;
            const int sr = 1 + ((int)blockIdx.x & 7);
            pg8::RangeOrder S1; S1.init(M, LDP, F.G, (int)blockIdx.x); S1.r0 = 0; S1.r1 = sr;
            pg8::gemm_phase<pg8::EpiProj, pg8::RangeOrder, PG8_ALIGN, PG8_SP2>(F.lds + RING_OFF, g, S1, E);
            __syncthreads();
            p0_convert(F, args, T_I_IN + T_I_OUT, T_NITEMS, (int)blockIdx.x * NWAVES + F.wave, F.G * NWAVES);
            { constexpr int NLIGHT = 256 - ((M / 256) * (LDP / 256) - (NR - 1) * 256);
              const int lc = (int)blockIdx.x - (256 - NLIGHT);
              if (lc >= 0) p0_convert(F, args, T_I_IN, T_I_IN + T_I_OUT, lc * NWAVES + F.wave, NLIGHT * NWAVES); }
            __syncthreads();
            pg8::RangeOrder S2; S2.init(M, LDP, F.G, (int)blockIdx.x); S2.r0 = sr; S2.r1 = NR;
            pg8::gemm_phase<pg8::EpiProj, pg8::RangeOrder, PG8_ALIGN, PG8_SP2>(F.lds + RING_OFF, g, S2, E);
        }
        SEAM(PH_INPROJ);
    }
    if (IN(PH_MIXA)) { REP(PH_MIXA) {
#if !MIX_FAST_SSD || !MIX_FAST_ATTN
        { const int vt = F.tid & 255, half = F.tid >> 8;
          for (int vb = (int)blockIdx.x * 2 + half; vb < M; vb += F.G * 2) nv_prep(args, vb, vt, !MIX_FAST_ATTN); }
#endif
#if MIX_FAST_ATTN
        { int mt = F.tid; asm volatile("" : "+v"(mt)); LAS unsigned char* L = F.lds + RING_OFF; constexpr int NU = NB_P * 128 * 8; mx::AttnRegs R;
          int u = (int)blockIdx.x; if (u < NU) mx::attn_load(args, mt, u >> 10, (u >> 3) & 127, u & 7, R);
          if (!SUB(0)) u = NU;
          while (u < NU) { const int un = u + F.G;
              mx::attn_stage(args, L, mt, u >> 10, (u >> 3) & 127, u & 7, R); __syncthreads();
              if (un < NU) mx::attn_load(args, mt, un >> 10, (un >> 3) & 127, un & 7, R);
              mx::attn_compute<false>(args, L, mt, u >> 10, (u >> 3) & 127, u & 7); __syncthreads(); u = un; }
          asm volatile("" : "+v"(mt));
          if (SUB(1)) for (int us = (int)blockIdx.x; us < NB_S * 8; us += F.G) { mx::attn_stage_sample(args, L, mt, us >> 3, us & 7); __syncthreads(); mx::attn_compute<true>(args, L, mt, us >> 3, 0, us & 7); __syncthreads(); } }
#endif
#if MIX_FAST_SSD
        { int mt = F.tid; asm volatile("" : "+v"(mt)); LAS unsigned char* L = F.lds + RING_OFF; constexpr int NU = NB_P * 128 * 8; mx::SsdRegs R;
          int u = (int)blockIdx.x; if (u < NU) mx::ssd_load<false, false>(args, mt, u >> 10, (u >> 3) & 127, u & 7, R);
          if (!SUB(2)) u = NU;
          while (u < NU) { const int un = u + F.G; const int b = u >> 10, c = (u >> 3) & 127, g = u & 7;
              mx::ssd_stage<false, false, true, false>(args, L, mt, b, c, g, R); __syncthreads();
              if (un < NU) mx::ssd_load<false, false>(args, mt, un >> 10, (un >> 3) & 127, un & 7, R);
              mx::ssd_states<false>(args, L, mt, b, c, g); __syncthreads(); u = un; }
          asm volatile("" : "+v"(mt));
          if (SUB(3)) for (int us = (int)blockIdx.x; us < NB_S * 8; us += F.G) { const int b = us >> 3, g = us & 7;
              mx::ssd_load<true>(args, mt, b, 0, g, R); mx::ssd_stage<true, true, true, true>(args, L, mt, b, 0, g, R); __syncthreads();
              mx::ssd_states<true>(args, L, mt, b, 0, g); mx::ssd_output<true>(args, L, mt, b, 0, g); } }
#endif
        }
        SEAM(PH_MIXA);
    }
    if (IN(PH_MIXB)) {
#if MIX_FAST_SSD
        for (int gid = (int)blockIdx.x * 512 + F.tid; gid < NB_P * 32 * 64 * 32; gid += F.G * 512) mx::ssd_pass<false>(args, gid);
#if defined(PROBE_MIXB)
        __syncthreads();
        for (int gid = (int)blockIdx.x * 512 + F.tid; gid < NB_P * 32 * 64 * 32; gid += F.G * 512) mx::ssd_pass<true>(args, gid);
#endif
#else
        { const int vt = F.tid & 255, half = F.tid >> 8;
          LAS float* sB = (LAS float*)(F.lds + RING_OFF + half * 16384);
          constexpr int NSCAN = (NB_P + NB_S) * 8;
          for (int i = (int)blockIdx.x; 2 * i < NSCAN; i += F.G) { const int vb = 2 * i + half; nv_scan(args, vb < NSCAN ? vb : -1, (2 * i < NB_P * 8) ? SEQ : DSEQ, vt, sB); } }
#endif
#if !MIX_FAST_ATTN
        { const int vt = F.tid & 255, half = F.tid >> 8;
          for (int vb = (int)blockIdx.x * 2 + half; vb < NB_P * 128 * 8; vb += F.G * 2) nv_attn<false>(args, vb, vt);
          for (int vb = (int)blockIdx.x * 2 + half; vb < NB_S * 8; vb += F.G * 2) nv_attn<true>(args, vb, vt); }
#endif
        SEAM(PH_MIXB);
    }
    if (IN(PH_MIXC)) { REP(PH_MIXC) {
#if MIX_FAST_SSD
        { int mt = F.tid; asm volatile("" : "+v"(mt)); LAS unsigned char* L = F.lds + RING_OFF; constexpr int NU = NB_P * 128 * 8; mx::SsdRegs R;
          int u = (int)blockIdx.x; if (u < NU) mx::ssd_load<false>(args, mt, u >> 10, (u >> 3) & 127, u & 7, R);
          while (u < NU) { const int un = u + F.G; const int b = u >> 10, c = (u >> 3) & 127, g = u & 7;
              mx::ssd_stage<false, true, false, true>(args, L, mt, b, c, g, R); __syncthreads();
              if (un < NU) mx::ssd_load<false>(args, mt, un >> 10, (un >> 3) & 127, un & 7, R);
              mx::ssd_output<false>(args, L, mt, b, c, g); u = un; } }
#else
        { const int vt = F.tid & 255, half = F.tid >> 8;
          for (int vb = (int)blockIdx.x * 2 + half; vb < M; vb += F.G * 2) nv_gate(args, vb, vt); }
#endif
        }
        SEAM(PH_MIXC);
    }
    if (IN(PH_OUT)) {
        const pg8::Gemm g = pg8::gemm_rm((const bf16*)(ws + WS_H), (const bf16*)(ws + WS_WOUT), M, DM, DM, DM);
        pg8::EpiOut E{args.in[IN_XP], args.in[IN_XS], args.out + O_Y, (bf16*)(ws + WS_X1B), (float*)(ws + WS_PART), NTOK_P};
        if (F.G != 256) { pg8::StaticOrder S; S.init(M, DM, F.G, (int)blockIdx.x); pg8::gemm_phase<pg8::EpiOut, pg8::StaticOrder, PG8_ALIGN, PG8_SP2>(F.lds + RING_OFF, g, S, E); }
        else {
            pg8::StaticOrder S; S.init(NTOK_P, DM, F.G, (int)blockIdx.x);
            pg8::gemm_phase<pg8::EpiOut, pg8::StaticOrder, PG8_ALIGN, PG8_SP2>(F.lds + RING_OFF, g, S, E);
            const int j = (int)blockIdx.x >> 2, q = (int)blockIdx.x & 3;
            const pg8::Gemm g2 = pg8::gemm_rm((const bf16*)(ws + WS_H) + q * (DM / 4), (const bf16*)(ws + WS_WOUT) + q * (DM / 4), M, DM, DM / 4, DM);
            pg8::PanelTail T{NTOK_P / 256 + (j >> 4), j & 15};
            pg8::EpiPart EP{(float*)(ws + WS_PROJ) + (size_t)blockIdx.x * 65536};
            pg8::gemm_phase<pg8::EpiPart, pg8::PanelTail, PG8_ALIGN, PG8_SP2>(F.lds + RING_OFF, g2, T, EP);
        }
        SEAM(PH_OUT);
    }
    if (IN(PH_RSTD)) {
        const float* part = (const float*)(ws + WS_PART); float* rstd = (float*)(ws + WS_RSTD);
        const int gw = F.vcu * NWAVES + F.wave, NGW = F.G * NWAVES;
        const int mlim = (F.G == 256) ? NTOK_P : M;
        for (int m = gw; m < mlim; m += NGW) { const float s = wave_sum(part[(size_t)m * 64 + F.lane]); if (F.lane == 0) rstd[m] = 1.f / sqrtf(s * (1.f / DM) + RMS_EPS); }
        if (F.G == 256) {
            const float* slabs = (const float*)(ws + WS_PROJ); bf16* xb = (bf16*)(ws + WS_X1B);
            for (int r = gw; r < NTOK_S; r += NGW) { const int pmr = r >> 8, rr = r & 255; float ss = 0.f;
#pragma unroll 4
                for (int pn = 0; pn < 16; ++pn) { const f32x4* s = (const f32x4*)(slabs + (size_t)(4 * (pmr * 16 + pn)) * 65536 + rr * 256) + F.lane;
                    const f32x4 v = *((const f32x4*)(args.in[IN_XS] + (size_t)r * DM + pn * 256) + F.lane) + ((s[0] + s[16384]) + (s[2 * 16384] + s[3 * 16384]));
                    ss += (v[0] * v[0] + v[1] * v[1]) + (v[2] * v[2] + v[3] * v[3]);
                    v2u w; w.x = pk2(v[0], v[1]); w.y = pk2(v[2], v[3]); *((v2u*)(xb + (size_t)(NTOK_P + r) * DM + pn * 256) + F.lane) = w; }
                ss = wave_sum(ss); if (F.lane == 0) rstd[NTOK_P + r] = 1.f / sqrtf(ss * (1.f / DM) + RMS_EPS); }
        }
        SEAM(PH_RSTD);
    }
    if (IN(PH_UP)) {
        const pg8::Gemm g = pg8::gemm_rm((const bf16*)(ws + WS_X1B), (const bf16*)(ws + WS_WUP), M, FF, DM, DM); pg8::StaticOrder S; S.init(M, FF, F.G, (int)blockIdx.x);
        pg8::EpiUp E{(bf16*)(ws + WS_U), FF, (const float*)(ws + WS_RSTD)};
        REP(PH_UP) { pg8::gemm_phase<pg8::EpiUp, pg8::StaticOrder, PG8_ALIGN, PG8_SP2>(F.lds + RING_OFF, g, S, E); }
#if defined(PROBE_SHADOW_UP)
        {
          struct ZeroOrder : pg8::StaticOrder { __device__ __forceinline__ bool next(int i, pg8::Unit& u) const { pg8::Unit t; const bool ok = pg8::StaticOrder::next(i, t); u.pm = PROBE_SHADOW_UP == 0 ? 0 : t.pm; u.pn = PROBE_SHADOW_UP == 0 ? 0 : t.pn; return ok; } };
          ZeroOrder Z; Z.init(M, FF, F.G, (int)blockIdx.x);
          pg8::ShEpi SE{pg8::EpiUp{PROBE_SHADOW_UP == 2 ? (bf16*)(ws + WS_KN) : (bf16*)(ws + WS_U), FF, (const float*)(ws + WS_RSTD)}};
          pg8::gemm_phase<pg8::ShEpi, ZeroOrder, PG8_ALIGN, PG8_SP2>(F.lds + RING_OFF, g, Z, SE); }
#endif
        SEAM(PH_UP);
    }
    if (IN(PH_DOWN)) {
        constexpr int NU = (M / 256) * (DM / 256), NFULL = NU / 256, NLEFT = NU - NFULL * 256;
        const bool split = (F.G == 256) && (NLEFT * 4 == 256);
        const pg8::Gemm g = pg8::gemm_blk((const bf16*)(ws + WS_U), (const bf16*)(ws + WS_WDN), M, DM, FF, FF);
        pg8::EpiDown E{args.out + O_Y, (const bf16*)(ws + WS_X1B)};
        if (!split) { pg8::StaticOrder S; S.init(M, DM, F.G, (int)blockIdx.x); pg8::gemm_phase<pg8::EpiDown, pg8::StaticOrder, PG8_ALIGN, PG8_SP2>(F.lds + RING_OFF, g, S, E); }
        else {
            pg8::HeadOrder S; S.init(M, DM, F.G, (int)blockIdx.x); S.nr = NFULL; S.wgm = DOWN_WGM;
            pg8::gemm_phase<pg8::EpiDown, pg8::HeadOrder, PG8_ALIGN, PG8_SP2>(F.lds + RING_OFF, g, S, E);
#if defined(PROBE_SHADOW_DOWN)
            { pg8::ShEpiD SD{pg8::EpiDown{(float*)(ws + WS_KN), (const bf16*)(ws + WS_X1B)}}; pg8::gemm_phase<pg8::ShEpiD, pg8::HeadOrder, PG8_ALIGN, PG8_SP2>(F.lds + RING_OFF, g, S, SD); }
#endif
            const int q = (int)blockIdx.x & 3;
            const pg8::Gemm g2 = pg8::gemm_blk((const bf16*)(ws + WS_U) + (size_t)q * (FF / 4 / 64) * 16384, (const bf16*)(ws + WS_WDN) + (size_t)q * (FF / 4 / 64) * 16384, M, DM, FF / 4, FF);
            pg8::TailOrder T; T.init(M, DM, 256, (int)blockIdx.x >> 2); T.round = NFULL; T.wgm = DOWN_WGM;
            pg8::EpiPart EP{(float*)(ws + WS_WUP) + (size_t)blockIdx.x * 65536};
            pg8::gemm_phase<pg8::EpiPart, pg8::TailOrder, PG8_ALIGN, PG8_SP2>(F.lds + RING_OFF, g2, T, EP);
        }
        SEAM(PH_DOWN);
    }
    if (IN(PH_DOWN2)) {
        constexpr int NU = (M / 256) * (DM / 256), NFULL = NU / 256, NLEFT = NU - NFULL * 256;
        if ((F.G == 256) && (NLEFT * 4 == 256)) {
            const float* slabs = (const float*)(ws + WS_WUP); float* out = args.out + O_Y;
            const int gw = (int)blockIdx.x * NWAVES + F.wave;
            for (int rr = gw; rr < NLEFT * 256; rr += F.G * NWAVES) { const int j = rr >> 8, r = rr & 255;
                pg8::StaticOrder T; T.init(M, DM, 256, j); T.wgm = DOWN_WGM; pg8::Unit u; T.next(NFULL, u);
                f32x4* o = (f32x4*)(out + (size_t)(u.pm * 256 + r) * DM + u.pn * 256) + F.lane;
                const v2u xw = *((const v2u*)((const bf16*)(ws + WS_X1B) + (size_t)(u.pm * 256 + r) * DM + u.pn * 256) + F.lane);
                const f32x4* s = (const f32x4*)(slabs + (size_t)(4 * j) * 65536 + r * 256) + F.lane;
                *o = (f32x4){bflo(xw.x), bfhi(xw.x), bflo(xw.y), bfhi(xw.y)} + ((s[0] + s[16384]) + (s[2 * 16384] + s[3 * 16384])); }
        }
    }
#undef IN
#undef SEAM
}

extern "C" void kernel_launch(void* const* d_in, const int* in_sizes, int n_in, void* d_out, int out_size, void* d_ws, size_t ws_size, hipStream_t stream) {
    static int grid = 0;
    if (grid == 0) {
        if (n_in != 21 || in_sizes[0] != NTOK_P * DM || (size_t)out_size != O_END || ws_size < WS_END) {
            fprintf(stderr, "kernel_launch: unexpected shapes: n_in %d in0 %d out %d ws %zu (need %zu)\n", n_in, n_in > 0 ? in_sizes[0] : -1, out_size, ws_size, (size_t)WS_END); grid = -1; return; }
        int dev = 0, cus = 0, per_cu = 0;
        if (hipGetDevice(&dev) != hipSuccess || hipDeviceGetAttribute(&cus, hipDeviceAttributeMultiprocessorCount, dev) != hipSuccess) { grid = -1; return; }
        if (hipFuncSetAttribute((const void*)mega_fwd, hipFuncAttributeMaxDynamicSharedMemorySize, LDS_BYTES) != hipSuccess) { fprintf(stderr, "kernel_launch: hipFuncSetAttribute failed\n"); grid = -1; return; }
        if (hipOccupancyMaxActiveBlocksPerMultiprocessor(&per_cu, (const void*)mega_fwd, NWAVES * 64, LDS_BYTES) != hipSuccess || per_cu < 1)
            fprintf(stderr, "kernel_launch: note: occupancy query reports %d workgroups per CU\n", per_cu);
        (void)hipGetLastError();
        grid = cus;
    }
    if (grid < 0) return;
    if (hipMemsetAsync((char*)d_ws + WS_CTL, 0, CTL_ZERO_BYTES, stream) != hipSuccess) return;
    Args a{};
    for (int i = 0; i < 21; ++i) a.in[i] = (const float*)d_in[i];
    a.out = (float*)d_out; a.ws = (unsigned char*)d_ws; int n_launch = 0;
#define MEGA(lo_, hi_) do { a.ph_lo = (lo_); a.ph_hi = (hi_); a.li = n_launch++; hipLaunchKernelGGL(mega_fwd, dim3(grid), dim3(NWAVES * 64), LDS_BYTES, stream, a); } while (0)
#if defined(PROBE_SUB)
    MEGA(PH_PRO, PH_MIXA + 1); MEGA(100 + PROBE_SUB, 100 + PROBE_SUB + 1); MEGA(PH_MIXA + 1, PH_N);
#elif defined(PROBE_SPLIT)
    MEGA(PH_PRO, PROBE_SPLIT + 1); MEGA(PROBE_SPLIT, PROBE_SPLIT + 1); if (PROBE_SPLIT + 1 < PH_N) MEGA(PROBE_SPLIT + 1, PH_N);
#else
    MEGA(PH_PRO, PH_N);
#endif
    const hipError_t le = hipPeekAtLastError();
    if (le != hipSuccess) fprintf(stderr, "kernel_launch: launch failed: %s\n", hipGetErrorName(le));
}
```

```cpp
#define DOWN_WGM 4
#define PG8_MMA_ORDER 7
#define UP_BAND 1
#define DOWN_BAND 1
#define DOWN_BAND16 1
#define OUT_BAND 1
#define IN_BAND 1
#include <hip/hip_runtime.h>
#include <cstdio>
#include <cstdint>
namespace pg8 {
#define PG8_LAS __attribute__((address_space(3)))
typedef unsigned short bf16_t;
typedef short bf16x8 __attribute__((ext_vector_type(8)));
typedef float f32x4 __attribute__((ext_vector_type(4)));
typedef unsigned u32x4 __attribute__((ext_vector_type(4)));
constexpr int BM = 256, BK = 64, HALF = 128, HTB = HALF * BK * 2  , STAGE_BYTES = 8 * HTB, NXCD = 8, WGM = 8;

__host__ __device__ __forceinline__ int lds_byte(int r, int c) { const int st = (r >> 4) * 2 + (c >> 5), rr = r & 15, cc = c & 31, ob = rr * 64 + cc * 2; return st * 1024 + (ob ^ (((ob >> 9) & 1) << 5)); }
__host__ __device__ __forceinline__ void stage_rc(int b, int& R, int& C) { const int st = b / 1024, sb = b % 1024, swz = sb ^ (((sb >> 9) & 1) << 5); R = (st >> 1) * 16 + swz / 64; C = (st & 1) * 32 + (swz % 64) / 2; }
__host__ __device__ __forceinline__ int perm32(int rho) { const int n = rho >> 4, i = rho & 15; return 8 * (i >> 2) + 4 * n + (i & 3); }

struct Unit { int pm, pn; };
struct Gemm { const bf16_t* A; const bf16_t* Bt; int M, N, K, ld, kstep; size_t tstep; };
__host__ __device__ __forceinline__ Gemm gemm_rm(const bf16_t* A, const bf16_t* Bt, int M, int N, int K, int Ktot) { return Gemm{A, Bt, M, N, K, Ktot, 128, (size_t)512 * Ktot}; }
__host__ __device__ __forceinline__ Gemm gemm_blk(const bf16_t* A, const bf16_t* Bt, int M, int N, int K, int Ktot) { return Gemm{A, Bt, M, N, K, 64, 32768, (size_t)512 * Ktot}; }
__host__ __device__ __forceinline__ size_t blk_off(int row, int col, int Ktot) { return ((size_t)(row >> 8) * (Ktot >> 6) + (col >> 6)) * 16384 + (size_t)(row & 255) * 64 + (col & 63); }

struct StaticOrder {
    int nM, nN, nwg, G, c, wgm = WGM;
    __host__ __device__ __forceinline__ void init(int M, int N, int G_, int c_) { nM = M / BM; nN = N / BM; nwg = nM * nN; G = G_; c = c_; }
    __host__ __device__ __forceinline__ bool next(int i, Unit& u) const {
        const long L = (long)i * G + c; if (L >= nwg) return false;
        int wgid = (int)L; { const int q = nwg / NXCD, r = nwg % NXCD, xcd = wgid % NXCD, off = wgid / NXCD; wgid = (xcd < r ? xcd * (q + 1) : r * (q + 1) + (xcd - r) * q) + off; }
        const int nig = wgm * nN, gid = wgid / nig, fm = gid * wgm, gsz = (nM - fm) < wgm ? (nM - fm) : wgm;
        u.pm = fm + ((wgid % nig) % gsz); u.pn = (wgid % nig) / gsz; return true;
    }
    __device__ __forceinline__ void a_ready(const Unit&) const {}
    __device__ __forceinline__ void done(const Unit&) const {}
};

typedef float f32x2_t __attribute__((ext_vector_type(2))); typedef __bf16 bf16x2_t __attribute__((ext_vector_type(2)));
__device__ __forceinline__ unsigned cvt_pk_bf16(float lo, float hi) { const f32x2_t v = {lo, hi}; const bf16x2_t b = __builtin_convertvector(v, bf16x2_t); return __builtin_bit_cast(unsigned, b); }
typedef unsigned u32x2 __attribute__((ext_vector_type(2)));

struct EpiProj {
    static constexpr bool PERM = true, AFTER_DRAIN = false;
    bf16_t* O; int ldc; float* dt; int dt_pn;
    __device__ __forceinline__ void operator()(const f32x4 (&acc)[2][2][4][2], const Unit& u, int wr, int wc, int fr, int fq) const {
        const int row0 = u.pm * BM + wr * 64 + fr; const int col0 = u.pn * BM + wc * 32 + 8 * fq;
#pragma unroll
        for (int ai = 0; ai < 2; ++ai)
#pragma unroll
            for (int m = 0; m < 4; ++m) { bf16_t* rowp = O + (size_t)(row0 + ai * HALF + m * 16) * ldc + col0;
#pragma unroll
                for (int bj = 0; bj < 2; ++bj) { const f32x4 v0 = acc[ai][bj][m][0], v1 = acc[ai][bj][m][1];
                    u32x4 w; w.x = cvt_pk_bf16(v0[0], v0[1]); w.y = cvt_pk_bf16(v0[2], v0[3]); w.z = cvt_pk_bf16(v1[0], v1[1]); w.w = cvt_pk_bf16(v1[2], v1[3]);
                    *(u32x4*)(rowp + bj * HALF) = w; } }
        if (u.pn == dt_pn && wc == 0) {
#pragma unroll
            for (int ai = 0; ai < 2; ++ai)
#pragma unroll
                for (int m = 0; m < 4; ++m) { float* dp = dt + (size_t)(row0 + ai * HALF + m * 16) * 32 + 8 * fq;
                    *(f32x4*)(dp) = acc[ai][0][m][0]; *(f32x4*)(dp + 4) = acc[ai][0][m][1]; }
        }
    }
};
struct EpiOut {
    static constexpr bool PERM = true, AFTER_DRAIN = false;
    const float* xp; const float* xs; float* out; bf16_t* xb; float* part; int np_rows;
    __device__ __forceinline__ void operator()(const f32x4 (&acc)[2][2][4][2], const Unit& u, int wr, int wc, int fr, int fq) const {
        const int col0 = u.pn * BM + wc * 32 + 8 * fq;
#pragma unroll
        for (int ai = 0; ai < 2; ++ai)
#pragma unroll
            for (int m = 0; m < 4; ++m) { const int row = u.pm * BM + ai * HALF + wr * 64 + m * 16 + fr;
                const float* xr = (row < np_rows) ? xp + (size_t)row * 4096 : xs + (size_t)(row - np_rows) * 4096;
                float ss = 0.f;
#pragma unroll
                for (int bj = 0; bj < 2; ++bj) { const int c = col0 + bj * HALF;
                    const f32x4 v0 = *(const f32x4*)(xr + c) + acc[ai][bj][m][0], v1 = *(const f32x4*)(xr + c + 4) + acc[ai][bj][m][1];
                    ss += ((v0[0] * v0[0] + v0[1] * v0[1]) + (v0[2] * v0[2] + v0[3] * v0[3])) + ((v1[0] * v1[0] + v1[1] * v1[1]) + (v1[2] * v1[2] + v1[3] * v1[3]));
                    u32x4 w; w.x = cvt_pk_bf16(v0[0], v0[1]); w.y = cvt_pk_bf16(v0[2], v0[3]); w.z = cvt_pk_bf16(v1[0], v1[1]); w.w = cvt_pk_bf16(v1[2], v1[3]);
                    *(u32x4*)(xb + (size_t)row * 4096 + c) = w; }
                ss += __shfl_xor(ss, 16); ss += __shfl_xor(ss, 32);
                if (fq == 0) part[(size_t)row * 64 + u.pn * 4 + wc] = ss; }
    }
};
struct EpiUp {
    static constexpr bool PERM = true, AFTER_DRAIN = false;
    bf16_t* O; int ldc; const float* rstd;
    __device__ __forceinline__ void operator()(const f32x4 (&acc)[2][2][4][2], const Unit& u, int wr, int wc, int fr, int fq) const {
        const int row0 = u.pm * BM + wr * 64 + fr; const int col0 = u.pn * BM + wc * 32 + 8 * fq;
#pragma unroll
        for (int ai = 0; ai < 2; ++ai)
#pragma unroll
            for (int m = 0; m < 4; ++m) { const int row = row0 + ai * HALF + m * 16; const float rs = rstd[row]; bf16_t* rowp = O + blk_off(row, col0, ldc);
#pragma unroll
                for (int bj = 0; bj < 2; ++bj) { f32x4 v0 = acc[ai][bj][m][0] * rs, v1 = acc[ai][bj][m][1] * rs;
#pragma unroll
                    for (int i = 0; i < 4; ++i) { const float a = v0[i] > 0.f ? v0[i] : 0.f, b = v1[i] > 0.f ? v1[i] : 0.f; v0[i] = a * a; v1[i] = b * b; }
                    u32x4 w; w.x = cvt_pk_bf16(v0[0], v0[1]); w.y = cvt_pk_bf16(v0[2], v0[3]); w.z = cvt_pk_bf16(v1[0], v1[1]); w.w = cvt_pk_bf16(v1[2], v1[3]);
                    *(u32x4*)(rowp + (size_t)bj * 2 * 16384) = w; } }
    }
};
struct EpiDown {
    static constexpr bool PERM = true, AFTER_DRAIN = false;
    float* out; const bf16_t* xb;
    __device__ __forceinline__ void operator()(const f32x4 (&acc)[2][2][4][2], const Unit& u, int wr, int wc, int fr, int fq) const {
        const int col0 = u.pn * BM + wc * 32 + 8 * fq;
#pragma unroll
        for (int ai = 0; ai < 2; ++ai)
#pragma unroll
            for (int m = 0; m < 4; ++m) { const size_t ro = (size_t)(u.pm * BM + ai * HALF + wr * 64 + m * 16 + fr) * 4096 + col0;
#pragma unroll
                for (int bj = 0; bj < 2; ++bj) { const u32x4 w = *(const u32x4*)(xb + ro + bj * HALF);
                    const f32x4 r0 = {__builtin_bit_cast(float, w.x << 16), __builtin_bit_cast(float, w.x & 0xffff0000u), __builtin_bit_cast(float, w.y << 16), __builtin_bit_cast(float, w.y & 0xffff0000u)};
                    const f32x4 r1 = {__builtin_bit_cast(float, w.z << 16), __builtin_bit_cast(float, w.z & 0xffff0000u), __builtin_bit_cast(float, w.w << 16), __builtin_bit_cast(float, w.w & 0xffff0000u)};
                    *(f32x4*)(out + ro + bj * HALF) = r0 + acc[ai][bj][m][0]; *(f32x4*)(out + ro + bj * HALF + 4) = r1 + acc[ai][bj][m][1]; } }
    }
};

struct EpiPart {
    static constexpr bool PERM = true, AFTER_DRAIN = false;
    bf16_t* slab;
    __device__ __forceinline__ void operator()(const f32x4 (&acc)[2][2][4][2], const Unit& u, int wr, int wc, int fr, int fq) const {
        const int col0 = wc * 32 + 8 * fq;
#pragma unroll
        for (int ai = 0; ai < 2; ++ai)
#pragma unroll
            for (int m = 0; m < 4; ++m) { bf16_t* rowp = slab + (size_t)(ai * HALF + wr * 64 + m * 16 + fr) * 256 + col0;
#pragma unroll
                for (int bj = 0; bj < 2; ++bj) { const f32x4 v0 = acc[ai][bj][m][0], v1 = acc[ai][bj][m][1];
                    u32x4 w; w.x = cvt_pk_bf16(v0[0], v0[1]); w.y = cvt_pk_bf16(v0[2], v0[3]); w.z = cvt_pk_bf16(v1[0], v1[1]); w.w = cvt_pk_bf16(v1[2], v1[3]);
                    *(u32x4*)(rowp + bj * HALF) = w; } }
    }
};
struct HeadOrder : StaticOrder { int nr; __device__ __forceinline__ bool next(int i, Unit& u) const { return i < nr && StaticOrder::next(i, u); } };
struct TailOrder : StaticOrder { int round; __device__ __forceinline__ bool next(int i, Unit& u) const { return i == 0 && StaticOrder::next(round, u); } };

struct PanelTail { int pm, pn; __device__ __forceinline__ bool next(int i, Unit& u) const { if (i) return false; u.pm = pm; u.pn = pn; return true; }
    __device__ __forceinline__ void a_ready(const Unit&) const {} __device__ __forceinline__ void done(const Unit&) const {} };
#if defined(PROBE_SHADOW_UP)
struct ShEpi { static constexpr bool PERM = true, AFTER_DRAIN = false; EpiUp e;
    __device__ __forceinline__ void operator()(const f32x4 (&acc)[2][2][4][2], const Unit& u, int wr, int wc, int fr, int fq) const { Unit z; z.pm = PROBE_SHADOW_UP == 2 ? 0 : u.pm; z.pn = PROBE_SHADOW_UP == 2 ? 0 : u.pn; e(acc, z, wr, wc, fr, fq); } };
#endif
#if defined(PROBE_SHADOW_DOWN)
struct ShEpiD { static constexpr bool PERM = false, AFTER_DRAIN = false; EpiDown e;
    __device__ __forceinline__ void operator()(const f32x4 (&acc)[2][2][4][2], const Unit& u, int wr, int wc, int fr, int fq) const { Unit z; z.pm = 0; z.pn = 0; e(acc, z, wr, wc, fr, fq); } };
#endif
struct RangeOrder : StaticOrder { int r0, r1; __device__ __forceinline__ bool next(int i, Unit& u) const { return (i + r0) < r1 && StaticOrder::next(i + r0, u); } };
struct BandOrder {
    int nN8, c; bool tail = true;
    __device__ __forceinline__ void init(int N, int c_) { nN8 = N / BM / 8; c = c_; }
    __device__ __forceinline__ bool next(int i, Unit& u) const {
        const int x = c & 7, j = c >> 3;
        if (i < 2 * nN8) { const int band = i / nN8, cr_ = i - band * nN8, cr = band ? nN8 - 1 - cr_ : cr_;
            u.pm = band * 32 + 4 * x + (j & 3); u.pn = cr * 8 + (j >> 2); return true; }
        const int k = i - 2 * nN8; if (!tail || k >= nN8 / 8 + (nN8 % 8 != 0)) return false;
        const int col = (k * 8 + x) * 8 + (j >> 2); if (col >= nN8 * 8) return false;
        u.pm = 64 + (j & 3); u.pn = col; return true;
    }
    __device__ __forceinline__ void a_ready(const Unit&) const {} __device__ __forceinline__ void done(const Unit&) const {}
};
struct BandIn {
    int c, r0, r1;
    __device__ __forceinline__ bool next(int i_, Unit& u) const {
        const int i = i_ + r0; if (i >= r1) return false;
        const int x = c & 7, j = c >> 3;
        if (i < 8) { const int band = i >> 2, cr = band ? 3 - (i & 3) : (i & 3); u.pm = band * 32 + 4 * x + (j & 3); u.pn = cr * 8 + (j >> 2); return true; }
        if (i == 8) { u.pm = 8 * x + (j & 7); u.pn = 32 + (j >> 3); return true; }
        if (i == 9) { if (c < 64) { u.pm = c; u.pn = 36; return true; } const int k = c - 64; if (k >= 148) return false; u.pm = 64 + (k & 3); u.pn = k >> 2; return true; }
        return false;
    }
    __device__ __forceinline__ void a_ready(const Unit&) const {} __device__ __forceinline__ void done(const Unit&) const {}
};
struct BandDown {
    int c;
    __device__ __forceinline__ bool next(int i, Unit& u) const {
        if (i >= 4) return false;
        const int x = c & 7, j = c >> 3;
        u.pm = 16 * i + 4 * (x >> 1) + (j & 3); u.pn = 8 * (x & 1) + (j >> 2); return true;
    }
    __device__ __forceinline__ void a_ready(const Unit&) const {} __device__ __forceinline__ void done(const Unit&) const {}
};

template <class Epi, class Sched, bool ALIGN_EPI = false, bool SP2 = false>
__device__ __forceinline__ void gemm_phase(PG8_LAS unsigned char* lds, const Gemm g, const Sched& S, const Epi& E) {
    int tid_ = threadIdx.x; asm volatile("" : "+v"(tid_));
    const int tid = tid_, wid = __builtin_amdgcn_readfirstlane(tid >> 6), lane = tid & 63, wr = wid >> 2, wc = wid & 3, fr = lane & 15, fq = lane >> 4;
    const int K = g.K, nt = K / BK, LD = g.ld;
    unsigned voffA[2], voffB[2];
#pragma unroll
    for (int i = 0; i < 2; ++i) { int R, C; stage_rc(tid * 16 + i * 8192, R, C); const int Rb = Epi::PERM ? ((R & ~31) + perm32(R & 31)) : R;
        voffA[i] = (unsigned)(R * LD + C) * 2u; voffB[i] = (unsigned)(Rb * LD + C) * 2u; }
    const size_t kstep = (size_t)g.kstep;
    const size_t hstep = (size_t)HALF * LD * 2;
    const size_t tstep = g.tstep;
    const unsigned ldsw = (unsigned)wid * 1024u;
    const int aoff = lds_byte(wr * 64 + fr, fq * 8), boff = lds_byte(wc * 32 + fr, fq * 8);
#define PG8_SA(b, h) (((b) * 2 + (h)) * HTB)
#define PG8_SB(b, h) ((4 + (b) * 2 + (h)) * HTB)
#define PG8_STAGE(bufoff, gbase, voff) do { _Pragma("unroll") for (int _i = 0; _i < 2; ++_i) \
        __builtin_amdgcn_global_load_lds((const unsigned*)((const char*)(gbase) + (voff)[_i]), (PG8_LAS unsigned*)(lds + (bufoff) + ldsw + _i * 8192), 16, 0, 0); } while (0)
#define PG8_LDA(dst, b, h) do { _Pragma("unroll") for (int m = 0; m < 4; ++m) _Pragma("unroll") for (int k = 0; k < 2; ++k) dst[m][k] = *(const PG8_LAS bf16x8*)(lds + PG8_SA(b, h) + aoff + m * 2048 + k * 1024); } while (0)
#define PG8_LDB(dst, b, h) do { _Pragma("unroll") for (int n = 0; n < 2; ++n) _Pragma("unroll") for (int k = 0; k < 2; ++k) dst[n][k] = *(const PG8_LAS bf16x8*)(lds + PG8_SB(b, h) + boff + n * 2048 + k * 1024); } while (0)
#ifndef PG8_MMA_ORDER
#define PG8_MMA_ORDER 0
#endif
#if PG8_MMA_ORDER == 0
#define PG8_MMA(ai, bj, At, Bt) do { __builtin_amdgcn_s_setprio(1); _Pragma("unroll") for (int m = 0; m < 4; ++m) _Pragma("unroll") for (int n = 0; n < 2; ++n) _Pragma("unroll") for (int k = 0; k < 2; ++k) \
        acc[ai][bj][m][n] = __builtin_amdgcn_mfma_f32_16x16x32_bf16(Bt[n][k], At[m][k], acc[ai][bj][m][n], 0, 0, 0); __builtin_amdgcn_s_setprio(0); } while (0)
#elif PG8_MMA_ORDER == 1
#define PG8_MMA(ai, bj, At, Bt) do { __builtin_amdgcn_s_setprio(1); _Pragma("unroll") for (int k = 0; k < 2; ++k) _Pragma("unroll") for (int m = 0; m < 4; ++m) _Pragma("unroll") for (int n = 0; n < 2; ++n) \
        acc[ai][bj][m][n] = __builtin_amdgcn_mfma_f32_16x16x32_bf16(Bt[n][k], At[m][k], acc[ai][bj][m][n], 0, 0, 0); __builtin_amdgcn_s_setprio(0); } while (0)
#elif PG8_MMA_ORDER == 3
#define PG8_MMA(ai, bj, At, Bt) do { __builtin_amdgcn_s_setprio(1); _Pragma("unroll") for (int m = 0; m < 4; ++m) _Pragma("unroll") for (int n_ = 0; n_ < 2; ++n_) _Pragma("unroll") for (int k_ = 0; k_ < 2; ++k_) { \
        const int n = (m & 1) ? 1 - n_ : n_, k = (n_ & 1) ? 1 - k_ : k_; \
        acc[ai][bj][m][n] = __builtin_amdgcn_mfma_f32_16x16x32_bf16(Bt[n][k], At[m][k], acc[ai][bj][m][n], 0, 0, 0); } __builtin_amdgcn_s_setprio(0); } while (0)
#elif PG8_MMA_ORDER == 4
#define PG8_MMA(ai, bj, At, Bt) do { __builtin_amdgcn_s_setprio(1); _Pragma("unroll") for (int m = 0; m < 4; ++m) _Pragma("unroll") for (int n = 0; n < 2; ++n) { _Pragma("unroll") for (int k = 0; k < 2; ++k) \
        acc[ai][bj][m][n] = __builtin_amdgcn_mfma_f32_16x16x32_bf16(Bt[n][k], At[m][k], acc[ai][bj][m][n], 0, 0, 0); __builtin_amdgcn_sched_barrier(0); } __builtin_amdgcn_s_setprio(0); } while (0)
#elif PG8_MMA_ORDER == 5 || PG8_MMA_ORDER == 7
#define PG8_MMA(ai, bj, At, Bt) do { __builtin_amdgcn_s_setprio(1); _Pragma("unroll") for (int m = 0; m < 4; ++m) _Pragma("unroll") for (int n_ = 0; n_ < 2; ++n_) _Pragma("unroll") for (int k_ = 0; k_ < 2; ++k_) { \
        const int n = (m & 1) ? 1 - n_ : n_, k = (n_ & 1) ? 1 - k_ : k_; \
        acc[ai][bj][m][n] = __builtin_amdgcn_mfma_f32_16x16x32_bf16(Bt[n][k], At[m][k], acc[ai][bj][m][n], 0, 0, 0); __builtin_amdgcn_sched_barrier(0); } __builtin_amdgcn_s_setprio(0); } while (0)
#else
#define PG8_MMA(ai, bj, At, Bt) do { __builtin_amdgcn_s_setprio(1); _Pragma("unroll") for (int k = 0; k < 2; ++k) _Pragma("unroll") for (int n = 0; n < 2; ++n) _Pragma("unroll") for (int m = 0; m < 4; ++m) \
        acc[ai][bj][m][n] = __builtin_amdgcn_mfma_f32_16x16x32_bf16(Bt[n][k], At[m][k], acc[ai][bj][m][n], 0, 0, 0); __builtin_amdgcn_s_setprio(0); } while (0)
#endif
#if PG8_MMA_ORDER == 7
#define PG8_MMA2(ai, At, Ba, Bb) do { __builtin_amdgcn_s_setprio(1); _Pragma("unroll") for (int m = 0; m < 4; ++m) _Pragma("unroll") for (int q_ = 0; q_ < 4; ++q_) _Pragma("unroll") for (int k_ = 0; k_ < 2; ++k_) { \
        const int q = (m & 1) ? 3 - q_ : q_, bj = q >> 1, n = q & 1, k = (q_ & 1) ? 1 - k_ : k_; \
        acc[ai][bj][m][n] = __builtin_amdgcn_mfma_f32_16x16x32_bf16(bj ? Bb[n][k] : Ba[n][k], At[m][k], acc[ai][bj][m][n], 0, 0, 0); __builtin_amdgcn_sched_barrier(0); } __builtin_amdgcn_s_setprio(0); } while (0)
#else
#define PG8_MMA2(ai, At, Ba, Bb) do { PG8_MMA(ai, 0, At, Ba); PG8_MMA(ai, 1, At, Bb); } while (0)
#endif
#define PG8_WAIT_V(n) asm volatile("s_waitcnt vmcnt(" #n ")" ::: "memory")
#define PG8_WAIT_L(n) asm volatile("s_waitcnt lgkmcnt(" #n ")" ::: "memory")
#define PG8_BAR __builtin_amdgcn_s_barrier()
#define PG8_SCHED __builtin_amdgcn_sched_barrier(0)
    Unit cur, nxt; int ui = 0;
    if (!S.next(0, cur)) return;
    f32x4 acc[2][2][4][2];
#pragma unroll
    for (int a = 0; a < 2; ++a)
#pragma unroll
        for (int b = 0; b < 2; ++b)
#pragma unroll
            for (int m = 0; m < 4; ++m)
#pragma unroll
                for (int n = 0; n < 2; ++n) acc[a][b][m][n] = (f32x4){0.f, 0.f, 0.f, 0.f};
    bf16x8 At[4][2], B0[2][2], B1[2][2];
    const char* cA = (const char*)g.A + (size_t)cur.pm * tstep; const char* cB = (const char*)g.Bt + (size_t)cur.pn * tstep;
    S.a_ready(cur);
    if constexpr (SP2) {
        PG8_STAGE(PG8_SB(0, 0), cB, voffB); PG8_STAGE(PG8_SB(0, 1), cB + hstep, voffB); PG8_STAGE(PG8_SA(0, 0), cA, voffA); PG8_STAGE(PG8_SA(0, 1), cA + hstep, voffA);
        if (wr == 1) PG8_BAR;
        PG8_WAIT_V(2); PG8_BAR;
        PG8_STAGE(PG8_SB(1, 0), cB + kstep, voffB); PG8_STAGE(PG8_SA(1, 0), cA + kstep, voffA); PG8_STAGE(PG8_SB(1, 1), cB + hstep + kstep, voffB);
        PG8_WAIT_V(6); PG8_BAR;
    } else {
        PG8_STAGE(PG8_SB(0, 0), cB, voffB); PG8_STAGE(PG8_SA(0, 0), cA, voffA); PG8_STAGE(PG8_SB(0, 1), cB + hstep, voffB); PG8_STAGE(PG8_SA(0, 1), cA + hstep, voffA);
        if (wr == 1) PG8_BAR;
        PG8_WAIT_V(4); PG8_BAR;
        PG8_STAGE(PG8_SB(1, 0), cB + kstep, voffB); PG8_STAGE(PG8_SA(1, 0), cA + kstep, voffA); PG8_STAGE(PG8_SB(1, 1), cB + hstep + kstep, voffB);
        PG8_WAIT_V(6); PG8_BAR;
    }
#if defined(PROBE_BND)
#define PB_STAMP(j) do { if (blockIdx.x == 0 && wid == 0 && *(volatile PG8_LAS unsigned*)(lds + PROBE_BND_OFF + 32) != 0u) { const unsigned c_ = (unsigned)__builtin_amdgcn_s_memtime(); \
        if (lane == 0) *(volatile PG8_LAS unsigned*)(lds + PROBE_BND_OFF + 128 + (ui * 3 + (j)) * 4) = c_; } } while (0)
#endif
    for (;;) {
        const bool has_next = S.next(ui + 1, nxt);
        const char* nA = has_next ? (const char*)g.A + (size_t)nxt.pm * tstep : cA; const char* nB = has_next ? (const char*)g.Bt + (size_t)nxt.pn * tstep : cB;
        for (int t = 0; t < nt; t += 2) {
            const bool last = (t == nt - 2);
            const char* a1 = cA + (size_t)(t + 1) * kstep;
            const char* a2 = last ? nA : cA + (size_t)(t + 2) * kstep; const char* b2 = last ? nB : cB + (size_t)(t + 2) * kstep;
            const char* a3 = a2 + kstep; const char* b3 = b2 + kstep;
            if (last && has_next) S.a_ready(nxt);
            if constexpr (SP2) {
            PG8_LDB(B0, 0, 0); PG8_LDB(B1, 0, 1); PG8_SCHED; PG8_LDA(At, 0, 0); PG8_STAGE(PG8_SA(1, 1), a1 + hstep, voffA);
            PG8_WAIT_V(8); PG8_WAIT_L(0); PG8_BAR; PG8_MMA2(0, At, B0, B1); PG8_BAR; PG8_SCHED;
            PG8_LDA(At, 0, 1); PG8_STAGE(PG8_SB(0, 0), b2, voffB); PG8_STAGE(PG8_SB(0, 1), b2 + hstep, voffB); PG8_STAGE(PG8_SA(0, 0), a2, voffA);
            PG8_WAIT_V(8); PG8_WAIT_L(0); PG8_BAR; PG8_MMA2(1, At, B0, B1); PG8_BAR; PG8_SCHED;
            PG8_LDB(B0, 1, 0); PG8_LDB(B1, 1, 1); PG8_SCHED; PG8_LDA(At, 1, 0); PG8_STAGE(PG8_SA(0, 1), a2 + hstep, voffA);
            PG8_WAIT_V(8); PG8_WAIT_L(0); PG8_BAR; PG8_MMA2(0, At, B0, B1); PG8_BAR; PG8_SCHED;
            PG8_LDA(At, 1, 1); PG8_STAGE(PG8_SB(1, 0), b3, voffB); PG8_STAGE(PG8_SB(1, 1), b3 + hstep, voffB); PG8_STAGE(PG8_SA(1, 0), a3, voffA);
            PG8_WAIT_V(8); PG8_WAIT_L(0); PG8_BAR; PG8_MMA2(1, At, B0, B1); PG8_BAR; PG8_SCHED;
            } else {
            PG8_LDB(B0, 0, 0); PG8_SCHED; PG8_LDA(At, 0, 0); PG8_STAGE(PG8_SA(1, 1), a1 + hstep, voffA);
            PG8_WAIT_L(8); PG8_BAR; PG8_WAIT_L(0); PG8_MMA(0, 0, At, B0); PG8_BAR; PG8_SCHED;
            PG8_LDB(B1, 0, 1); PG8_STAGE(PG8_SB(0, 0), b2, voffB);
            PG8_BAR; PG8_WAIT_L(0); PG8_MMA(0, 1, At, B1); PG8_BAR;
            PG8_LDA(At, 0, 1); PG8_STAGE(PG8_SA(0, 0), a2, voffA);
            PG8_BAR; PG8_WAIT_L(0); PG8_MMA(1, 0, At, B0); PG8_BAR; PG8_SCHED;
            PG8_STAGE(PG8_SB(0, 1), b2 + hstep, voffB);
            PG8_WAIT_V(6); PG8_BAR; PG8_MMA(1, 1, At, B1); PG8_BAR;
            PG8_LDB(B0, 1, 0); PG8_SCHED; PG8_LDA(At, 1, 0); PG8_STAGE(PG8_SA(0, 1), a2 + hstep, voffA);
            PG8_WAIT_L(8); PG8_BAR; PG8_WAIT_L(0); PG8_MMA(0, 0, At, B0); PG8_BAR; PG8_SCHED;
            PG8_LDB(B1, 1, 1); PG8_STAGE(PG8_SB(1, 0), b3, voffB);
            PG8_BAR; PG8_WAIT_L(0); PG8_MMA(0, 1, At, B1); PG8_BAR;
            PG8_LDA(At, 1, 1); PG8_STAGE(PG8_SA(1, 0), a3, voffA);
            PG8_BAR; PG8_WAIT_L(0); PG8_MMA(1, 0, At, B0); PG8_BAR; PG8_SCHED;
            PG8_STAGE(PG8_SB(1, 1), b3 + hstep, voffB);
            PG8_WAIT_V(6); PG8_BAR; PG8_MMA(1, 1, At, B1); PG8_BAR;
            }
#if defined(PROBE_BND)
            if (t == 0) PB_STAMP(0); else if (t == 2) PB_STAMP(1);
#endif
        }
#if defined(PROBE_BND)
        PB_STAMP(2);
#endif
        if constexpr (ALIGN_EPI) { if (wr == 0) PG8_BAR; }
        if constexpr (!Epi::AFTER_DRAIN) { E(acc, cur, wr, wc, fr, fq); S.done(cur); }
        if (!has_next) break;
#pragma unroll
        for (int a = 0; a < 2; ++a)
#pragma unroll
            for (int b = 0; b < 2; ++b)
#pragma unroll
                for (int m = 0; m < 4; ++m)
#pragma unroll
                    for (int n = 0; n < 2; ++n) acc[a][b][m][n] = (f32x4){0.f, 0.f, 0.f, 0.f};
        cur = nxt; cA = nA; cB = nB; ++ui;
        if constexpr (ALIGN_EPI) { if (wr == 1) PG8_BAR; }
    }
    PG8_WAIT_V(0);
    if constexpr (!ALIGN_EPI) { if (wr == 0) PG8_BAR; }
    PG8_BAR;
    if constexpr (Epi::AFTER_DRAIN) { E.fused(acc, cur, wr, wc, fr, fq, lds, wid, lane); S.done(cur); }
#undef PG8_SA
#undef PG8_SB
#undef PG8_STAGE
#undef PG8_LDA
#undef PG8_LDB
#undef PG8_MMA
#undef PG8_WAIT_V
#undef PG8_WAIT_L
#undef PG8_BAR
#undef PG8_SCHED
}
}
#ifndef PG8_SP2
#define PG8_SP2 true
#endif
#ifndef PG8_ALIGN
#define PG8_ALIGN true
#endif
constexpr int NWAVES = 8;
constexpr int DM = 4096, SEQ = 8192, NB_P = 2, NB_S = 32, DSEQ = 32, PAST = 1024;
constexpr int NTOK_P = NB_P * SEQ, NTOK_S = NB_S * DSEQ, M = NTOK_P + NTOK_S;
constexpr int NPROJ = 9248, LDP = 9472;
constexpr int OFF_Q = 0, OFF_K = 2048, OFF_V = 2560, OFF_XS = 3072, OFF_Z = 5120, OFF_B = 7168, OFF_C = 8192, OFF_DT = 9216;
constexpr int FF = 16384;
constexpr float RMS_EPS = 1e-6f;
constexpr size_t O_Y = 0, O_KP = (size_t)M * DM, O_VP = O_KP + 131072, O_CP = O_VP + 131072, O_SP = O_CP + 24576, O_KS = O_SP + 524288, O_VS = O_KS + 2097152,
                 O_CS = O_VS + 2097152, O_SS = O_CS + 393216, O_END = O_SS + 8388608;
constexpr size_t MiB = 1u << 20;
constexpr size_t WS_CTL = 0, CTL_ZERO_BYTES = 64 * 1024;
constexpr size_t WS_ROPE = 1 * MiB;
constexpr size_t WS_DT = 2 * MiB;
constexpr size_t WS_PART = 5 * MiB;
constexpr size_t WS_RSTD = 10 * MiB;
constexpr size_t WS_DECAY = 11 * MiB;
constexpr size_t WS_WUP = 16 * MiB;
constexpr size_t WS_WDN = 144 * MiB;
constexpr size_t WS_X1B = 272 * MiB;
constexpr size_t WS_WOUT = 408 * MiB;
constexpr size_t WS_U = 440 * MiB;
constexpr size_t WS_WIN = 440 * MiB;
constexpr size_t WS_H = 514 * MiB;
constexpr size_t WS_PROJ = 650 * MiB;
constexpr size_t WS_KN = 984 * MiB;
constexpr size_t WS_END = 1020 * MiB;
static_assert(WS_PROJ + (size_t)M * LDP * 2 <= WS_KN && WS_U + (size_t)M * FF * 2 <= WS_KN && WS_WIN + (size_t)LDP * DM * 2 <= WS_H && WS_H + (size_t)M * DM * 2 <= WS_PROJ, "ws map");
static_assert(WS_X1B + (size_t)M * DM * 2 <= WS_WOUT && WS_DT + (size_t)M * 32 * 4 <= WS_PART && WS_PART + (size_t)M * 64 * 4 <= WS_RSTD, "ws map 2");
constexpr int CW_TMO = 0, CW_CODE = 1, CW_BAR = 4096;
static_assert((CW_BAR + 3 * 3456) * 4 <= (int)CTL_ZERO_BYTES, "barrier regions inside the per-call memset");

constexpr int RING_OFF = 0, RING_BYTES = 133120;
constexpr int LDSCTL_OFF = RING_BYTES, MISC_OFF = LDSCTL_OFF + 320;
constexpr int LDS_BYTES = 147456;
static_assert(MISC_OFF + 128 <= LDS_BYTES, "LDS map");

#define GAS __attribute__((address_space(1)))
#define LAS __attribute__((address_space(3)))
typedef unsigned short bf16;
typedef unsigned v4u __attribute__((ext_vector_type(4)));
typedef unsigned v2u __attribute__((ext_vector_type(2)));
typedef float f32x4 __attribute__((ext_vector_type(4)));
typedef short bf16x8 __attribute__((ext_vector_type(8)));
typedef GAS unsigned gu32;
#define RLX_AGENT __ATOMIC_RELAXED, __HIP_MEMORY_SCOPE_AGENT
#define LDS_WAIT() asm volatile("s_waitcnt lgkmcnt(0)" ::: "memory")
#define VM_WAIT() asm volatile("s_waitcnt vmcnt(0)" ::: "memory")
__device__ __forceinline__ unsigned f2bf(float f) { unsigned u = __builtin_bit_cast(unsigned, f); return (u + 0x7fffu + ((u >> 16) & 1u)) >> 16; }
typedef float f32x2_g __attribute__((ext_vector_type(2))); typedef __bf16 bf16x2_g __attribute__((ext_vector_type(2)));
__device__ __forceinline__ unsigned pk2(float lo, float hi) { const f32x2_g v = {lo, hi}; const bf16x2_g b = __builtin_convertvector(v, bf16x2_g); return __builtin_bit_cast(unsigned, b); }
__device__ __forceinline__ float bf2f(unsigned short b) { return __builtin_bit_cast(float, (unsigned)b << 16); }
__device__ __forceinline__ float bflo(unsigned w) { return __builtin_bit_cast(float, w << 16); }
__device__ __forceinline__ float bfhi(unsigned w) { return __builtin_bit_cast(float, w & 0xffff0000u); }
__device__ __forceinline__ float silu_f(float v) { return v * __builtin_amdgcn_rcpf(1.f + __expf(-v)); }
__device__ __forceinline__ float softplus_f(float v) { return v > 20.f ? v : log1pf(__expf(v)); }

#define XB_TMO      128
#define XB_XCNT(j)  (256  + 64 * (j))
#define XB_XSUB(j)  (1280 + 64 * (j))
#define XB_XGEN(j)  (2304 + 64 * (j))
#define XB_TOP      3328
#define XB_TOPGEN   3392
#define XCD_BAR_WORDS 3456
#define XB_SPIN_CAP (1u << 18)

__device__ __forceinline__ unsigned xb_ld(unsigned* p)              { return __hip_atomic_load(p, __ATOMIC_RELAXED, __HIP_MEMORY_SCOPE_AGENT); }
__device__ __forceinline__ unsigned xb_add(unsigned* p, unsigned v) { return __hip_atomic_fetch_add(p, v, __ATOMIC_RELAXED, __HIP_MEMORY_SCOPE_AGENT); }
__device__ __forceinline__ unsigned xb_xcc_id() { return (unsigned)__builtin_amdgcn_s_getreg((3 << 11) | 20) & 0xFu; }
#define XB_SPIN(cond, bar) do { unsigned _sp = 0; while (cond) { __builtin_amdgcn_s_sleep(1); \
    if ((++_sp & 255u) == 0u) { if (xb_ld(&(bar)[XB_TMO])) break; if (_sp > XB_SPIN_CAP) { atomicAdd(&(bar)[XB_TMO], 1u); break; } } } } while (0)

struct XcdBarrier {
    unsigned* bar; unsigned x;
    volatile LAS unsigned* st;
};

__device__ __forceinline__ XcdBarrier xcd_barrier_post(unsigned* bar, volatile LAS unsigned* st) {
    XcdBarrier b; b.bar = bar; b.x = xb_xcc_id(); b.st = st;
    if (threadIdx.x == 0) (void)xb_add(&bar[XB_XCNT(b.x)], 1u);
    return b;
}
__device__ __forceinline__ void xcd_barrier_complete(unsigned* bar, unsigned x, unsigned& nloc, unsigned& nx) {
    const unsigned G = gridDim.x * gridDim.y * gridDim.z;
    unsigned sum, cnt, mine, sp = 0u;
    for (;;) {
        sum = 0u; cnt = 0u; mine = 0u;
#pragma unroll
        for (unsigned j = 0; j < 16; ++j) { const unsigned c = xb_ld(&bar[XB_XCNT(j)]); sum += c; cnt += (c > 0u) ? 1u : 0u; mine = (j == x) ? c : mine; }
        if (sum == G) break;
        __builtin_amdgcn_s_sleep(1);
        if ((++sp & 255u) == 0u) { if (xb_ld(&bar[XB_TMO])) break; if (sp > XB_SPIN_CAP) { atomicAdd(&bar[XB_TMO], 1u); break; } }
    }
    nloc = mine > 0u ? mine : 1u; nx = cnt > 0u ? cnt : 1u;
}

__device__ __forceinline__ void xcd_barrier(const XcdBarrier& b) {
    asm volatile("s_waitcnt vmcnt(0)" ::: "memory");
    __syncthreads();
    if (threadIdx.x == 0) {
        unsigned* bar = b.bar;
        __builtin_amdgcn_s_waitcnt(0);
        unsigned nloc = b.st[0], nx = b.st[1];
        if (nloc == 0u) { xcd_barrier_complete(bar, b.x, nloc, nx); b.st[0] = nloc; b.st[1] = nx; }
        const unsigned old = xb_add(&bar[XB_XSUB(b.x)], 1u);
        const unsigned gen = old / nloc;
        if (old + 1u == (gen + 1u) * nloc) {
            __builtin_amdgcn_fence(__ATOMIC_RELEASE, "agent");
            asm volatile("s_waitcnt vmcnt(0)" ::: "memory");
            const unsigned og = xb_add(&bar[XB_TOP], 1u);
            const unsigned tg = og / nx;
            if (og + 1u == (tg + 1u) * nx) xb_add(&bar[XB_TOPGEN], 1u);
            else XB_SPIN(xb_ld(&bar[XB_TOPGEN]) == tg, bar);
            __builtin_amdgcn_fence(__ATOMIC_ACQUIRE, "agent");
            xb_add(&bar[XB_XGEN(b.x)], 1u);
            asm volatile("s_waitcnt vmcnt(0)" ::: "memory");
        } else {
            XB_SPIN(xb_ld(&bar[XB_XGEN(b.x)]) == gen, bar);
            __builtin_amdgcn_fence(__ATOMIC_ACQUIRE, "agent");
            asm volatile("s_waitcnt vmcnt(0)" ::: "memory");
        }
    }
    __syncthreads();
}

struct Args {
    const float* in[21]; float* out; unsigned char* ws; int ph_lo, ph_hi, li, pad;
};
enum { IN_XP = 0, IN_XS, IN_CK, IN_CV, IN_SCONV, IN_SSSM, IN_NMIX, IN_WIN, IN_QNW, IN_KNW, IN_SINK, IN_CONVW, IN_CONVB, IN_DTB, IN_ALOG, IN_DSKIP, IN_SNW, IN_WOUT, IN_NFFN, IN_WUP, IN_WDN };
enum { PH_PRO = 0, PH_INPROJ = 1, PH_MIXA = 2, PH_MIXB = 3, PH_MIXC = 4, PH_OUT = 5, PH_RSTD = 6, PH_UP = 7, PH_DOWN = 8, PH_DOWN2 = 9, PH_N = 10 };

struct Frame {
    LAS unsigned char* lds;
    volatile LAS unsigned* MISC;
    gu32* ctl;
    int tid, lane, wave;
    int vcu, G;
};
__device__ __forceinline__ float wave_sum(float v) {
#pragma unroll
    for (int o = 1; o < 64; o <<= 1) v += __shfl_xor(v, o);
    return v;
}
struct TItem { const float* W; bf16* WT; const float* kscale; int K, N, k0, n0, ncols, blocked; };
constexpr int T_NB_IN = (NPROJ + 63) / 64;
constexpr int T_I_IN = (DM / 64) * T_NB_IN, T_I_OUT = (DM / 64) * (DM / 64), T_I_UP = (DM / 64) * (FF / 64), T_I_DN = (FF / 64) * (DM / 64);
constexpr int T_NITEMS = T_I_IN + T_I_OUT + T_I_UP + T_I_DN;
__device__ __forceinline__ TItem p0_item(const Args& A, int it) {
    unsigned char* ws = A.ws;
    constexpr int NB_IN = T_NB_IN;
    constexpr int I_IN = T_I_IN, I_OUT = T_I_OUT, I_UP = T_I_UP;
    TItem t; int r = it;
    if (r < I_IN) { const int kb = r / NB_IN, nb = r % NB_IN; t = TItem{A.in[IN_WIN], (bf16*)(ws + WS_WIN), nullptr, DM, NPROJ, 64 * kb, 64 * nb, (nb == NB_IN - 1) ? NPROJ - 64 * (NB_IN - 1) : 64, 0}; return t; } r -= I_IN;
    if (r < I_OUT) { t = TItem{A.in[IN_WOUT], (bf16*)(ws + WS_WOUT), nullptr, DM, DM, 64 * (r / (DM / 64)), 64 * (r % (DM / 64)), 64, 0}; return t; } r -= I_OUT;
    if (r < I_UP) { t = TItem{A.in[IN_WUP], (bf16*)(ws + WS_WUP), A.in[IN_NFFN], DM, FF, 64 * (r / (FF / 64)), 64 * (r % (FF / 64)), 64, 0}; return t; } r -= I_UP;
    t = TItem{A.in[IN_WDN], (bf16*)(ws + WS_WDN), nullptr, FF, DM, 64 * (r / (DM / 64)), 64 * (r % (DM / 64)), 64, 1}; return t;
}
__device__ __forceinline__ void p0_tload(const TItem& t, int lane, f32x4 (&v)[16]) {
    const int kr = lane >> 4, c4 = (lane & 15) * 4; const bool lok = c4 < t.ncols;
#pragma unroll
    for (int i = 0; i < 16; ++i) v[i] = lok ? __builtin_nontemporal_load((const GAS f32x4*)(t.W + (size_t)(t.k0 + 4 * i + kr) * t.N + t.n0 + c4)) : (f32x4){0.f, 0.f, 0.f, 0.f};
}
__device__ __forceinline__ void p0_tstore(const TItem& t, int lane, LAS float* scr, f32x4 (&v)[16]) {
    const int kr = lane >> 4, c4 = (lane & 15) * 4;
    if (t.kscale) {
#pragma unroll
        for (int i = 0; i < 16; ++i) v[i] = v[i] * t.kscale[t.k0 + 4 * i + kr]; }
#pragma unroll
    for (int i = 0; i < 16; ++i) { LAS float* d = scr + (4 * i + kr) * 65 + c4; d[0] = v[i][0]; d[1] = v[i][1]; d[2] = v[i][2]; d[3] = v[i][3]; }
    LDS_WAIT(); asm volatile("" ::: "memory");
    const int c = lane & 7;
#pragma unroll
    for (int j = 0; j < 8; ++j) { const int n = (lane >> 3) + 8 * j; const LAS float* s = scr + (8 * c) * 65 + n;
        v4u o; o.x = pk2(s[0 * 65], s[1 * 65]); o.y = pk2(s[2 * 65], s[3 * 65]); o.z = pk2(s[4 * 65], s[5 * 65]); o.w = pk2(s[6 * 65], s[7 * 65]);
        if (n < t.ncols) *(GAS v4u*)(t.WT + (t.blocked ? pg8::blk_off(t.n0 + n, t.k0 + 8 * c, t.K) : (size_t)(t.n0 + n) * t.K + t.k0 + 8 * c)) = o; }
    LDS_WAIT(); asm volatile("" ::: "memory");
}
__device__ __forceinline__ void rms_row_to_bf16(int lane, const float* xrow, const float* w, bf16* orow) {
    const GAS f32x4* xr = (const GAS f32x4*)xrow + lane; const GAS f32x4* wr = (const GAS f32x4*)w + lane;
    f32x4 v[16]; float s = 0.f;
#pragma unroll
    for (int j = 0; j < 16; ++j) { v[j] = xr[64 * j]; s += (v[j].x * v[j].x + v[j].y * v[j].y) + (v[j].z * v[j].z + v[j].w * v[j].w); }
    const float rstd = 1.f / sqrtf(wave_sum(s) * (1.f / DM) + RMS_EPS);
    GAS unsigned long long* o8 = (GAS unsigned long long*)orow + lane;
#pragma unroll
    for (int j = 0; j < 16; ++j) { const f32x4 g = wr[64 * j];
        o8[64 * j] = (unsigned long long)pk2(v[j].x * rstd * g.x, v[j].y * rstd * g.y) | ((unsigned long long)pk2(v[j].z * rstd * g.z, v[j].w * rstd * g.w) << 32); }
}
__device__ __forceinline__ void p0_convert(Frame& F, const Args& A, int it0, int it1, int gw, int NGW) {
    LAS float* scr = (LAS float*)(F.lds + RING_OFF + F.wave * 16640);
    f32x4 va[16], vb[16];
    int it = it0 + gw; TItem ta, tb;
    if (it < it1) { ta = p0_item(A, it); p0_tload(ta, F.lane, va); }
    while (it < it1) {
        const int i1 = it + NGW; if (i1 < it1) { tb = p0_item(A, i1); p0_tload(tb, F.lane, vb); }
        p0_tstore(ta, F.lane, scr, va);
        if (i1 >= it1) break;
        const int i2 = i1 + NGW; if (i2 < it1) { ta = p0_item(A, i2); p0_tload(ta, F.lane, va); }
        p0_tstore(tb, F.lane, scr, vb);
        it = i2; }
}
__device__ __forceinline__ void p0_prologue(Frame& F, const Args& A) {
    unsigned char* ws = A.ws;
    const int gw = F.vcu * NWAVES + F.wave, NGW = F.G * NWAVES;
    p0_convert(F, A, 0, (F.G == 256) ? T_I_IN : T_NITEMS, gw, NGW);
    { GAS v4u* z = (GAS v4u*)(ws + WS_WIN + (size_t)NPROJ * DM * 2); const int nz = (LDP - NPROJ) * DM * 2 / 16;
      for (int i = gw * 64 + F.lane; i < nz; i += NGW * 64) z[i] = (v4u){0u, 0u, 0u, 0u}; }
    { float* rope = (float*)(ws + WS_ROPE);
      for (int i = gw * 64 + F.lane; i < SEQ * 8; i += NGW * 64) { const int pos = i >> 3, k = i & 7;
          const double inv = k == 0 ? 0x1.0000000000000p+0 : k == 1 ? 0x1.8d275e352b568p-3 : k == 2 ? 0x1.3411901f5fa45p-5 : k == 3 ? 0x1.ddee9c8c0aceep-8 : k == 4 ? 0x1.72ba43fff3717p-10 : k == 5 ? 0x1.1f91ef20d667dp-12 : k == 6 ? 0x1.be2188e4aa32fp-15 : 0x1.5a0f4e49b7c16p-17;
          const double ang = (double)pos * inv, nn = __builtin_rint(ang * 0x1.45f306dc9c883p-3);
          const float red = (float)__builtin_fma(-nn, 0x1.1a62633145c07p-52, __builtin_fma(-nn, 0x1.921fb54442d18p+2, ang));
          rope[pos * 16 + k] = __builtin_cosf(red); rope[pos * 16 + 8 + k] = __builtin_sinf(red); } }
    bf16* H = (bf16*)(ws + WS_H);
    for (int m = gw; m < M; m += NGW) { const float* xr = m < NTOK_P ? A.in[IN_XP] + (size_t)m * DM : A.in[IN_XS] + (size_t)(m - NTOK_P) * DM;
        rms_row_to_bf16(F.lane, xr, A.in[IN_NMIX], H + (size_t)m * DM); }
}


struct RowInfo { int samp, b, t, pos; };
__device__ __forceinline__ RowInfo row_info(int row) { RowInfo r; if (row < NTOK_P) { r.samp = 0; r.b = row >> 13; r.t = row & (SEQ - 1); r.pos = r.t; } else { const int q = row - NTOK_P; r.samp = 1; r.b = q >> 5; r.t = q & 31; r.pos = PAST + r.t; } return r; }

__device__ __forceinline__ void nv_prep(const Args& A, int vb, int tid, bool write_kv) {
    const int row = vb, lane = tid & 63, w = tid >> 6;
    const RowInfo ri = row_info(row);
    unsigned char* ws = A.ws; const bf16* proj = (const bf16*)(ws + WS_PROJ); const bf16* pr = proj + (size_t)row * LDP;
    const float* rope = (const float*)(ws + WS_ROPE) + ri.pos * 16; float* kn = (float*)(ws + WS_KN) + (size_t)row * 512; float* bc = (float*)(ws + WS_X1B) + (size_t)row * 2048;
    float* out = A.out;
    for (int hh = 0; hh < 2; ++hh) { const int h = w + 4 * hh;
        const float kv = bf2f(pr[OFF_K + h * 64 + lane]);
        const float ss = wave_sum(kv * kv);
        const float kk = kv * (1.f / sqrtf(ss * (1.f / 64.f) + RMS_EPS)) * A.in[IN_KNW][lane];
        const float partner = __shfl_xor(kk, 8);
        float o = kk;
        if (lane < 16) { const float c = rope[lane & 7], s = rope[8 + (lane & 7)]; o = (lane < 8) ? kk * c - partner * s : kk * c + partner * s; }
        kn[h * 64 + lane] = o;
        const float vv = bf2f(pr[OFF_V + h * 64 + lane]);
        if (!write_kv) continue;
        if (!ri.samp) { if (ri.t >= SEQ - 128) { const size_t off = ((size_t)(ri.b * 128 + ri.t - (SEQ - 128)) * 8 + h) * 64 + lane; out[O_KP + off] = o; out[O_VP + off] = vv; } }
        else { const size_t off = ((size_t)(ri.b * 128 + 96 + ri.t) * 8 + h) * 64 + lane; out[O_KS + off] = o; out[O_VS + off] = vv; }
    }
    if (ri.samp && write_kv) {
        for (int i = tid; i < 3 * 512; i += 256) { const int j = ri.t * 3 + i / 512, e = i % 512; const size_t src = ((size_t)(ri.b * 128 + 32 + j)) * 512 + e, dst = ((size_t)(ri.b * 128 + j)) * 512 + e;
            out[O_KS + dst] = A.in[IN_CK][src]; out[O_VS + dst] = A.in[IN_CV][src]; }
    }
    for (int i = 0; i < 8; ++i) { const int c2 = tid * 8 + i, cc = 2048 + c2; float acc = A.in[IN_CONVB][cc];
        for (int j = 0; j < 4; ++j) { const int tt = ri.t - 3 + j; float v;
            if (tt >= 0) v = bf2f(proj[(size_t)(row - 3 + j) * LDP + OFF_B + c2]); else v = ri.samp ? A.in[IN_SCONV][((size_t)ri.b * 3 + (3 + tt)) * 4096 + cc] : 0.f;
            acc += A.in[IN_CONVW][j * 4096 + cc] * v; }
        bc[c2] = silu_f(acc); }
    const int tl = ri.samp ? DSEQ : SEQ;
    if (ri.t >= tl - 3) { float* dst = out + (ri.samp ? O_CS : O_CP) + ((size_t)ri.b * 3 + (ri.t - (tl - 3))) * 4096;
        for (int c = tid; c < 4096; c += 256) dst[c] = bf2f(pr[c < 2048 ? OFF_XS + c : OFF_B + (c - 2048)]); }
}

template <bool SAMPLE> __device__ __forceinline__ void nv_attn(const Args& A, int vb, int tid) {
    const int lane = tid & 63, g = tid >> 6;
    unsigned char* ws = A.ws; const bf16* proj = (const bf16*)(ws + WS_PROJ); const float* knb = (const float*)(ws + WS_KN); bf16* mix = (bf16*)(ws + WS_H);
    int b, c, kvh, row, pos; bool valid = true;
    if (!SAMPLE) { const int blk = vb; b = blk >> 10; c = (blk >> 3) & 127; kvh = blk & 7; row = b * SEQ + c * 64 + lane; pos = c * 64 + lane; }
    else { const int blk = vb; b = blk >> 3; c = 0; kvh = blk & 7; const int t = lane & 31; valid = lane < 32; row = NTOK_P + b * DSEQ + t; pos = PAST + t; }
    const int qh = kvh * 4 + g;
    float q[64]; float ss = 0.f;
    for (int d = 0; d < 64; ++d) { q[d] = bf2f(proj[(size_t)row * LDP + OFF_Q + qh * 64 + d]); ss += q[d] * q[d]; }
    const float rs = 1.f / sqrtf(ss * (1.f / 64.f) + RMS_EPS);
    for (int d = 0; d < 64; ++d) q[d] = q[d] * rs * A.in[IN_QNW][d];
    { const float* rope = (const float*)(ws + WS_ROPE) + pos * 16;
      for (int i = 0; i < 8; ++i) { const float cs = rope[i], sn = rope[8 + i], x1 = q[i], x2 = q[8 + i]; q[i] = x1 * cs - x2 * sn; q[8 + i] = x2 * cs + x1 * sn; } }
    for (int d = 0; d < 64; ++d) q[d] *= 0.125f;
    float m = A.in[IN_SINK][qh], l = 1.f; float o[64];
    for (int d = 0; d < 64; ++d) o[d] = 0.f;
    const int nk = SAMPLE ? 160 : 192;
    for (int kk = 0; kk < nk; ++kk) {
        const float* kp; const float* vpf = nullptr; const bf16* vpb = nullptr;
        if (!SAMPLE) { const int kt = c * 64 - 128 + kk; if (kt < 0) continue; const size_t kr = (size_t)b * SEQ + kt; kp = knb + kr * 512 + kvh * 64; vpb = proj + kr * LDP + OFF_V + kvh * 64; }
        else if (kk < 128) { const size_t off = ((size_t)(b * 128 + kk) * 8 + kvh) * 64; kp = A.in[IN_CK] + off; vpf = A.in[IN_CV] + off; }
        else { const size_t kr = (size_t)NTOK_P + b * DSEQ + (kk - 128); kp = knb + kr * 512 + kvh * 64; vpb = proj + kr * LDP + OFF_V + kvh * 64; }
        float s = 0.f;
        for (int d = 0; d < 64; ++d) s += q[d] * kp[d];
        const float mn = fmaxf(m, s), corr = __expf(m - mn), p = __expf(s - mn);
        l = l * corr + p; m = mn;
        if (vpf) { for (int d = 0; d < 64; ++d) o[d] = o[d] * corr + p * vpf[d]; }
        else { for (int d = 0; d < 64; ++d) o[d] = o[d] * corr + p * bf2f(vpb[d]); }
    }
    if (valid) { const float il = 1.f / l; bf16* dst = mix + (size_t)row * DM + qh * 64;
        for (int d = 0; d < 64; d += 2) *(unsigned*)(dst + d) = pk2(o[d] * il, o[d + 1] * il); }
}

__device__ __forceinline__ void nv_scan(const Args& A, int vb_, int Tloop, int tid, LAS float* sBp) {
    LAS float (*sB)[256] = (LAS float (*)[256])sBp;
    const bool live = vb_ >= 0; const int vb = live ? vb_ : 0;
    const int p = tid & 63, r = tid >> 6;
    const int seq = vb >> 3, g = vb & 7, h = g * 4 + r, ch = h * 64 + p;
    const bool samp = seq >= NB_P; const int b = samp ? seq - NB_P : seq; const int T = samp ? DSEQ : SEQ; const int row0 = samp ? NTOK_P + b * DSEQ : b * SEQ;
    unsigned char* ws = A.ws; const bf16* proj = (const bf16*)(ws + WS_PROJ); const float* bc = (const float*)(ws + WS_X1B); const float* dtr = (const float*)(ws + WS_DT);
    bf16* ybuf = (bf16*)(ws + WS_WIN);
    const float a = -__expf(A.in[IN_ALOG][h]), dtb = A.in[IN_DTB][h], D = A.in[IN_DSKIP][h];
    const float w0 = A.in[IN_CONVW][ch], w1 = A.in[IN_CONVW][4096 + ch], w2 = A.in[IN_CONVW][8192 + ch], w3 = A.in[IN_CONVW][12288 + ch], cb = A.in[IN_CONVB][ch];
    float x1 = 0.f, x2 = 0.f, x3 = 0.f; float st[128];
    if (samp) { x1 = A.in[IN_SCONV][((size_t)b * 3 + 0) * 4096 + ch]; x2 = A.in[IN_SCONV][((size_t)b * 3 + 1) * 4096 + ch]; x3 = A.in[IN_SCONV][((size_t)b * 3 + 2) * 4096 + ch];
        const float* s0 = A.in[IN_SSSM] + ((size_t)(b * 32 + h) * 64 + p) * 128;
        for (int n = 0; n < 128; ++n) st[n] = s0[n]; }
    else { for (int n = 0; n < 128; ++n) st[n] = 0.f; }
    for (int t0 = 0; t0 < Tloop; t0 += 16) {
        __syncthreads();
        for (int i = tid; i < 16 * 256; i += 256) { const int tt = i >> 8, j = i & 255; sB[tt][j] = bc[(size_t)(row0 + t0 + tt) * 2048 + (j < 128 ? g * 128 + j : 1024 + g * 128 + (j - 128))]; }
        __syncthreads();
        for (int tt = 0; tt < 16; ++tt) { const int row = row0 + t0 + tt;
            const float xr = bf2f(proj[(size_t)row * LDP + OFF_XS + ch]);
            const float xc = silu_f(cb + w0 * x1 + w1 * x2 + w2 * x3 + w3 * xr); x1 = x2; x2 = x3; x3 = xr;
            const float dtv = softplus_f(dtr[(size_t)row * 32 + h] + dtb), dA = __expf(dtv * a), xdt = xc * dtv;
            float y = 0.f;
#pragma unroll
            for (int n = 0; n < 128; ++n) { st[n] = st[n] * dA + xdt * sB[tt][n]; y += sB[tt][128 + n] * st[n]; }
            y += xc * D;
            if (live) ybuf[(size_t)row * 2048 + ch] = (bf16)f2bf(y); }
    }
    float* so = A.out + (samp ? O_SS : O_SP) + ((size_t)(b * 32 + h) * 64 + p) * 128;
    if (live) { for (int n = 0; n < 128; ++n) so[n] = st[n]; }
}

__device__ __forceinline__ void nv_gate(const Args& A, int vb, int tid) {
    const int row = vb;
    unsigned char* ws = A.ws; const bf16* proj = (const bf16*)(ws + WS_PROJ); const bf16* ybuf = (const bf16*)(ws + WS_WIN); bf16* mix = (bf16*)(ws + WS_H);
    float gv[8]; float ss = 0.f;
    for (int i = 0; i < 8; ++i) { const int c = tid * 8 + i; const float y = bf2f(ybuf[(size_t)row * 2048 + c]), z = bf2f(proj[(size_t)row * LDP + OFF_Z + c]); gv[i] = y * silu_f(z); ss += gv[i] * gv[i]; }
#pragma unroll
    for (int o = 1; o < 32; o <<= 1) ss += __shfl_xor(ss, o);
    const float rs = 1.f / sqrtf(ss * (1.f / 256.f) + RMS_EPS);
    for (int i = 0; i < 8; i += 2) { const int c = tid * 8 + i; *(unsigned*)(mix + (size_t)row * DM + 2048 + c) = pk2(gv[i] * rs * A.in[IN_SNW][c], gv[i + 1] * rs * A.in[IN_SNW][c + 1]); }
}

namespace mx {
#if defined(PROBE_SEG)
#define MXS(k) do { if (blockIdx.x == 0 && tid == 0) { volatile LAS unsigned* m_ = (volatile LAS unsigned*)(lds + MISC_OFF) + 200; const unsigned t_ = (unsigned)__builtin_amdgcn_s_memrealtime(); m_[1 + (k)] += t_ - m_[0]; m_[0] = t_; } } while (0)
#else
#define MXS(k) do { } while (0)
#endif
typedef short v4i16 __attribute__((ext_vector_type(4)));
constexpr float LOG2E = 1.4426950408889634f;
__device__ __forceinline__ f32x4 mfma16(bf16x8 a, bf16x8 b, f32x4 c) { return __builtin_amdgcn_mfma_f32_16x16x32_bf16(a, b, c, 0, 0, 0); }
__device__ __forceinline__ bf16x8 ld_nat(LAS const unsigned char* img, int stride, int row0, int k0, int r16, int quad) {
    return *(LAS const bf16x8*)(img + (row0 + r16) * stride + (k0 + quad * 8) * 2);
}
__device__ __forceinline__ bf16x8 ld_trp(LAS const unsigned char* img, int stride, int krow0, int col0, int r16, int quad) {
    LAS const unsigned char* p = img + (krow0 + quad * 4 + (r16 >> 2)) * stride + (col0 + 4 * (r16 & 3)) * 2;
    const v4i16 lo = __builtin_amdgcn_ds_read_tr16_b64_v4i16((LAS v4i16*)p);
    const v4i16 hi = __builtin_amdgcn_ds_read_tr16_b64_v4i16((LAS v4i16*)(p + 16 * stride));
    return (bf16x8){lo[0], lo[1], lo[2], lo[3], hi[0], hi[1], hi[2], hi[3]};
}
typedef float f32x2_t __attribute__((ext_vector_type(2))); typedef __bf16 bf16x2_t __attribute__((ext_vector_type(2)));
__device__ __forceinline__ unsigned pkh(float lo, float hi) { const f32x2_t v = {lo, hi}; const bf16x2_t b = __builtin_convertvector(v, bf16x2_t); return __builtin_bit_cast(unsigned, b); }
__device__ __forceinline__ bf16x8 ld_trp_g(LAS const unsigned char* img, int stride, int krow0, int colbase, int r16, int quad, int t) {
    LAS const unsigned char* p = img + (krow0 + quad * 4 + (r16 >> 2)) * stride + (colbase + 16 * (r16 & 3) + 4 * t) * 2;
    const v4i16 lo = __builtin_amdgcn_ds_read_tr16_b64_v4i16((LAS v4i16*)p);
    const v4i16 hi = __builtin_amdgcn_ds_read_tr16_b64_v4i16((LAS v4i16*)(p + 16 * stride));
    return (bf16x8){lo[0], lo[1], lo[2], lo[3], hi[0], hi[1], hi[2], hi[3]};
}
__device__ __forceinline__ bf16x8 pack_p(const f32x4 lo, const f32x4 hi) {
    v4u w; w.x = pkh(lo[0], lo[1]); w.y = pkh(lo[2], lo[3]); w.z = pkh(hi[0], hi[1]); w.w = pkh(hi[2], hi[3]); return __builtin_bit_cast(bf16x8, w);
}
__device__ __forceinline__ void unpack8(const v4u w, float* x) { x[0] = bflo(w.x); x[1] = bfhi(w.x); x[2] = bflo(w.y); x[3] = bfhi(w.y); x[4] = bflo(w.z); x[5] = bfhi(w.z); x[6] = bflo(w.w); x[7] = bfhi(w.w); }
__device__ __forceinline__ v4u pack8(const float* x) { v4u w; w.x = pkh(x[0], x[1]); w.y = pkh(x[2], x[3]); w.z = pkh(x[4], x[5]); w.w = pkh(x[6], x[7]); return w; }

constexpr int AQ_OFF = 0, AK_OFF = 40960, AV_OFF = 40960 + 30720, A_STRIDE = 160;
struct AttnRegs { v4u q[4], k[4], v[3]; };
__device__ __forceinline__ void attn_load(const Args& A, int tid, int b, int c, int kvh, AttnRegs& R) {
    const int lane = tid & 63, w = __builtin_amdgcn_readfirstlane(tid >> 6);
    const bf16* proj = (const bf16*)(A.ws + WS_PROJ);
    const int vv = 32 * w + (lane & 31), hf = lane >> 5;
    { const int g = vv >> 6, tok = vv & 63; const v4u* src = (const v4u*)(proj + (size_t)(b * SEQ + c * 64 + tok) * LDP + OFF_Q + (kvh * 4 + g) * 64 + hf * 32);
#pragma unroll
      for (int j = 0; j < 4; ++j) R.q[j] = src[j]; }
    { const int vk = w < 6 ? vv : (lane & 31); int kt = c * 64 - 128 + vk; kt = kt < 0 ? 0 : kt; const v4u* src = (const v4u*)(proj + (size_t)(b * SEQ + kt) * LDP + OFF_K + kvh * 64 + hf * 32);
#pragma unroll
      for (int j = 0; j < 4; ++j) R.k[j] = src[j]; }
#pragma unroll
    for (int i = 0; i < 3; ++i) { const int id = tid + 512 * i, key = id >> 3, ch = id & 7; int kt = c * 64 - 128 + key; kt = kt < 0 ? 0 : kt;
        R.v[i] = *(const v4u*)(proj + (size_t)(b * SEQ + kt) * LDP + OFF_V + kvh * 64 + ch * 8); }
}
__device__ __forceinline__ void norm_rope_half(float* x, int hf, const float* nw, const float* rp, float scale) {
    float ss = 0.f;
#pragma unroll
    for (int i = 0; i < 32; ++i) ss += x[i] * x[i];
    ss += __shfl_xor(ss, 32);
    const float rs = scale / sqrtf(ss * (1.f / 64.f) + RMS_EPS);
#pragma unroll
    for (int i = 0; i < 8; ++i) { const f32x4 w4 = *(const f32x4*)(nw + hf * 32 + 4 * i);
        x[4 * i] = x[4 * i] * rs * w4[0]; x[4 * i + 1] = x[4 * i + 1] * rs * w4[1]; x[4 * i + 2] = x[4 * i + 2] * rs * w4[2]; x[4 * i + 3] = x[4 * i + 3] * rs * w4[3]; }
    if (hf == 0) {
#pragma unroll
        for (int i = 0; i < 8; ++i) { const float cs = rp[i], sn = rp[8 + i], x1 = x[i], x2 = x[8 + i]; x[i] = x1 * cs - x2 * sn; x[8 + i] = x2 * cs + x1 * sn; } }
}
__device__ __forceinline__ void attn_stage(const Args& A, LAS unsigned char* lds, int tid, int b, int c, int kvh, const AttnRegs& R) {
    const int lane = tid & 63, w = __builtin_amdgcn_readfirstlane(tid >> 6);
    const float* rope = (const float*)(A.ws + WS_ROPE);
    LAS unsigned char* Qs = lds + AQ_OFF; LAS unsigned char* Ks = lds + AK_OFF; LAS unsigned char* Vs = lds + AV_OFF;
    float* out = A.out;
    const int v = 32 * w + (lane & 31), hf = lane >> 5;
    { const int tok = v & 63; float x[32];
#pragma unroll
      for (int j = 0; j < 4; ++j) unpack8(R.q[j], x + 8 * j);
      norm_rope_half(x, hf, A.in[IN_QNW], rope + (c * 64 + tok) * 16, 0.125f * LOG2E);
#pragma unroll
      for (int j = 0; j < 4; ++j) *(LAS v4u*)(Qs + v * A_STRIDE + hf * 64 + j * 16) = pack8(x + 8 * j); }
    if (w < 6) { const int kt = c * 64 - 128 + v; float x[32];
#pragma unroll
        for (int j = 0; j < 4; ++j) unpack8(R.k[j], x + 8 * j);
        norm_rope_half(x, hf, A.in[IN_KNW], rope + (kt < 0 ? 0 : kt) * 16, kt < 0 ? 0.f : 1.f);
#pragma unroll
        for (int j = 0; j < 4; ++j) *(LAS v4u*)(Ks + v * A_STRIDE + hf * 64 + j * 16) = pack8(x + 8 * j);
        if (c >= 126 && v >= 128) { float* dst = out + O_KP + ((size_t)(b * 128 + (c - 126) * 64 + (v - 128)) * 8 + kvh) * 64 + hf * 32;
#pragma unroll
            for (int j = 0; j < 8; ++j) *(f32x4*)(dst + 4 * j) = (f32x4){x[4 * j], x[4 * j + 1], x[4 * j + 2], x[4 * j + 3]}; } }
#pragma unroll
    for (int i = 0; i < 3; ++i) { const int id = tid + 512 * i, key = id >> 3, ch = id & 7; const int kt = c * 64 - 128 + key;
        v4u raw = R.v[i]; if (kt < 0) raw = (v4u){0u, 0u, 0u, 0u};
        *(LAS v4u*)(Vs + key * A_STRIDE + ch * 16) = raw;
        if (c >= 126 && key >= 128) { float x[8]; unpack8(raw, x); float* dst = out + O_VP + ((size_t)(b * 128 + (c - 126) * 64 + (key - 128)) * 8 + kvh) * 64 + ch * 8;
            *(f32x4*)(dst) = (f32x4){x[0], x[1], x[2], x[3]}; *(f32x4*)(dst + 4) = (f32x4){x[4], x[5], x[6], x[7]}; } }
}
__device__ __forceinline__ void attn_stage_sample(const Args& A, LAS unsigned char* lds, int tid, int b, int kvh) {
    const int lane = tid & 63, w = __builtin_amdgcn_readfirstlane(tid >> 6);
    const bf16* proj = (const bf16*)(A.ws + WS_PROJ); const float* rope = (const float*)(A.ws + WS_ROPE);
    LAS unsigned char* Qs = lds + AQ_OFF; LAS unsigned char* Ks = lds + AK_OFF; LAS unsigned char* Vs = lds + AV_OFF;
    float* out = A.out; const int qrow0 = NTOK_P + b * DSEQ;
    const int v = 32 * w + (lane & 31), hf = lane >> 5;
    { const int g = v >> 6, tok = v & 63; const bool ok = tok < DSEQ; float x[32];
      const v4u* src = (const v4u*)(proj + (size_t)(qrow0 + (ok ? tok : 0)) * LDP + OFF_Q + (kvh * 4 + g) * 64 + hf * 32);
#pragma unroll
      for (int j = 0; j < 4; ++j) unpack8(src[j], x + 8 * j);
      norm_rope_half(x, hf, A.in[IN_QNW], rope + (PAST + (ok ? tok : 0)) * 16, ok ? 0.125f * LOG2E : 0.f);
#pragma unroll
      for (int j = 0; j < 4; ++j) *(LAS v4u*)(Qs + v * A_STRIDE + hf * 64 + j * 16) = pack8(x + 8 * j); }
    if (w < 6) { float x[32];
        if (w < 4) { const f32x4* src = (const f32x4*)(A.in[IN_CK] + ((size_t)(b * 128 + v) * 8 + kvh) * 64 + hf * 32);
#pragma unroll
            for (int j = 0; j < 8; ++j) { const f32x4 t = src[j]; x[4 * j] = t[0]; x[4 * j + 1] = t[1]; x[4 * j + 2] = t[2]; x[4 * j + 3] = t[3]; } }
        else if (w == 4) { const v4u* src = (const v4u*)(proj + (size_t)(qrow0 + (v - 128)) * LDP + OFF_K + kvh * 64 + hf * 32);
#pragma unroll
            for (int j = 0; j < 4; ++j) unpack8(src[j], x + 8 * j);
            norm_rope_half(x, hf, A.in[IN_KNW], rope + (PAST + (v - 128)) * 16, 1.f); }
        else {
#pragma unroll
            for (int i = 0; i < 32; ++i) x[i] = 0.f; }
#pragma unroll
        for (int j = 0; j < 4; ++j) *(LAS v4u*)(Ks + v * A_STRIDE + hf * 64 + j * 16) = pack8(x + 8 * j);
        if (v >= 32 && v < 160) { float* dst = out + O_KS + ((size_t)(b * 128 + (v - 32)) * 8 + kvh) * 64 + hf * 32;
#pragma unroll
            for (int j = 0; j < 8; ++j) *(f32x4*)(dst + 4 * j) = (f32x4){x[4 * j], x[4 * j + 1], x[4 * j + 2], x[4 * j + 3]}; } }
#pragma unroll
    for (int i = 0; i < 3; ++i) { const int id = tid + 512 * i, key = id >> 3, ch = id & 7; float x[8];
        if (key < 128) { const f32x4* src = (const f32x4*)(A.in[IN_CV] + ((size_t)(b * 128 + key) * 8 + kvh) * 64 + ch * 8); const f32x4 t0 = src[0], t1 = src[1];
            x[0] = t0[0]; x[1] = t0[1]; x[2] = t0[2]; x[3] = t0[3]; x[4] = t1[0]; x[5] = t1[1]; x[6] = t1[2]; x[7] = t1[3]; }
        else if (key < 160) unpack8(*(const v4u*)(proj + (size_t)(qrow0 + (key - 128)) * LDP + OFF_V + kvh * 64 + ch * 8), x);
        else {
#pragma unroll
            for (int e = 0; e < 8; ++e) x[e] = 0.f; }
        *(LAS v4u*)(Vs + key * A_STRIDE + ch * 16) = pack8(x);
        if (key >= 32 && key < 160) { float* dst = out + O_VS + ((size_t)(b * 128 + (key - 32)) * 8 + kvh) * 64 + ch * 8;
            *(f32x4*)(dst) = (f32x4){x[0], x[1], x[2], x[3]}; *(f32x4*)(dst + 4) = (f32x4){x[4], x[5], x[6], x[7]}; } }
}
template <bool SAMPLE>
__device__ __forceinline__ void attn_compute(const Args& A, LAS unsigned char* lds, int tid, int b, int c, int kvh) {
    const int lane = tid & 63, w = __builtin_amdgcn_readfirstlane(tid >> 6), r16 = lane & 15, quad = lane >> 4;
    bf16* mix = (bf16*)(A.ws + WS_H);
    LAS const unsigned char* Qs = lds + AQ_OFF; LAS const unsigned char* Ks = lds + AK_OFF; LAS const unsigned char* Vs = lds + AV_OFF;
    const int qrow0 = SAMPLE ? NTOK_P + b * DSEQ : b * SEQ + c * 64;
    const int g = w >> 1, qh = kvh * 4 + g;
    const float sink2 = A.in[IN_SINK][qh] * LOG2E;
    const int kmin = SAMPLE ? 0 : (c >= 2 ? 0 : 128 - 64 * c), kmax = SAMPLE ? 160 : 192;
#pragma unroll
    for (int qt = 0; qt < 2; ++qt) {
        const bf16x8 q0 = ld_nat(Qs, A_STRIDE, 32 * w + 16 * qt, 0, r16, quad), q1 = ld_nat(Qs, A_STRIDE, 32 * w + 16 * qt, 32, r16, quad);
        f32x4 s[12];
#pragma unroll
        for (int kt = 0; kt < 12; ++kt) { const bf16x8 k0 = ld_nat(Ks, A_STRIDE, 16 * kt, 0, r16, quad), k1 = ld_nat(Ks, A_STRIDE, 16 * kt, 32, r16, quad);
            s[kt] = mfma16(k1, q1, mfma16(k0, q0, (f32x4){0.f, 0.f, 0.f, 0.f}));
            if ((kt & 3) == 3) asm volatile("" ::: "memory"); }
        float mx = sink2;
        if (kmin > 0 || kmax < 192) {
#pragma unroll
            for (int kt = 0; kt < 12; ++kt)
#pragma unroll
                for (int j = 0; j < 4; ++j) { const int key = 16 * kt + 4 * quad + j; s[kt][j] = (key >= kmin && key < kmax) ? s[kt][j] : -1e30f; } }
#pragma unroll
        for (int kt = 0; kt < 12; ++kt) mx = fmaxf(fmaxf(mx, fmaxf(s[kt][0], s[kt][1])), fmaxf(s[kt][2], s[kt][3]));
        mx = fmaxf(mx, __shfl_xor(mx, 16)); mx = fmaxf(mx, __shfl_xor(mx, 32));
        float l = 0.f;
#pragma unroll
        for (int kt = 0; kt < 12; ++kt)
#pragma unroll
            for (int j = 0; j < 4; ++j) { const float p = __builtin_amdgcn_exp2f(s[kt][j] - mx); s[kt][j] = p; l += p; }
        l += __shfl_xor(l, 16); l += __shfl_xor(l, 32); l += __builtin_amdgcn_exp2f(sink2 - mx);
        f32x4 o[4];
#pragma unroll
        for (int dt = 0; dt < 4; ++dt) o[dt] = (f32x4){0.f, 0.f, 0.f, 0.f};
#pragma unroll
        for (int s2 = 0; s2 < 6; ++s2) { const bf16x8 pf = pack_p(s[2 * s2], s[2 * s2 + 1]);
#pragma unroll
            for (int dt = 0; dt < 4; ++dt) o[dt] = mfma16(ld_trp_g(Vs, A_STRIDE, 32 * s2, 0, r16, quad, dt), pf, o[dt]);
            if (s2 & 1) asm volatile("" ::: "memory"); }
        const int tok = (w & 1) * 32 + 16 * qt + r16; const float il = 1.f / l;
        if (!SAMPLE || tok < DSEQ) { bf16* dst = mix + (size_t)(qrow0 + tok) * DM + qh * 64 + 16 * quad;
            v4u w0, w1; w0.x = pkh(o[0][0] * il, o[0][1] * il); w0.y = pkh(o[0][2] * il, o[0][3] * il); w0.z = pkh(o[1][0] * il, o[1][1] * il); w0.w = pkh(o[1][2] * il, o[1][3] * il);
            w1.x = pkh(o[2][0] * il, o[2][1] * il); w1.y = pkh(o[2][2] * il, o[2][3] * il); w1.z = pkh(o[3][0] * il, o[3][1] * il); w1.w = pkh(o[3][2] * il, o[3][3] * il);
            *(v4u*)dst = w0; *(v4u*)(dst + 8) = w1; }
    }
}

constexpr int SX_OFF = 0, SXW_OFF = 34816, SB_OFF = 69632, SC_OFF = 88064, SDT_OFF = 106496, SAC_OFF = 107520, SPART_OFF = 108544;
constexpr int X_STRIDE = 544, BC_STRIDE = 288;
struct SsdRegs { v4u raw[11]; float dtr; };
__device__ __forceinline__ void ssd_cols(int cc, int g, int& pcol, int& cch) {
    if (cc < 32) { pcol = OFF_XS + g * 256 + cc * 8; cch = g * 256 + cc * 8; }
    else if (cc < 48) { pcol = OFF_B + g * 128 + (cc - 32) * 8; cch = 2048 + g * 128 + (cc - 32) * 8; }
    else { pcol = OFF_C + g * 128 + (cc - 48) * 8; cch = 3072 + g * 128 + (cc - 48) * 8; }
}
template <bool SAMPLE, bool WANT_C = true>
__device__ __forceinline__ void ssd_load(const Args& A, int tid, int b, int c, int g, SsdRegs& R) {
    const int lane = tid & 63, w = __builtin_amdgcn_readfirstlane(tid >> 6);
    const bf16* proj = (const bf16*)(A.ws + WS_PROJ); const float* dtr = (const float*)(A.ws + WS_DT);
    const int row0 = SAMPLE ? NTOK_P + b * DSEQ : b * SEQ + c * 64; constexpr int L = SAMPLE ? DSEQ : 64;
    int pcol, cch; ssd_cols(lane, g, pcol, cch);
#pragma unroll
    for (int j = 0; j < 11; ++j) { int lr = 8 * w - 3 + j;
        if (SAMPLE) lr = lr < 0 ? 0 : (lr >= L ? L - 1 : lr); else if (c == 0 && lr < 0) lr = 0;
        if (WANT_C || lane < 48) R.raw[j] = *(const v4u*)(proj + (size_t)(row0 + lr) * LDP + pcol); else R.raw[j] = (v4u){0u, 0u, 0u, 0u}; }
    { const int l = lane < L ? lane : L - 1; R.dtr = dtr[(size_t)(row0 + l) * 32 + g * 4 + (w & 3)]; }
}
template <bool SAMPLE, bool WANT_X, bool WANT_XW, bool WANT_C>
__device__ __forceinline__ void ssd_stage(const Args& A, LAS unsigned char* lds, int tid, int b, int c, int g, const SsdRegs& R) {
    const int lane = tid & 63, w = __builtin_amdgcn_readfirstlane(tid >> 6);
    LAS float* sdt = (LAS float*)(lds + SDT_OFF); LAS float* sac = (LAS float*)(lds + SAC_OFF);
    constexpr int L = SAMPLE ? DSEQ : 64;
    if (w < 4) { const int r = w, l = lane, h = g * 4 + r;
        const float dtv = (l < L) ? softplus_f(R.dtr + A.in[IN_DTB][h]) : 0.f;
        const float a = -__expf(A.in[IN_ALOG][h]);
        float cs = dtv * a;
#pragma unroll
        for (int o = 1; o < 64; o <<= 1) { const float t = __shfl_up(cs, o); if (lane >= o) cs += t; }
        sdt[l * 4 + r] = dtv; sac[l * 4 + r] = cs; }
    if (WANT_XW) __syncthreads();
    const int cc = lane, rb = w;
    int pcol, cch; ssd_cols(cc, g, pcol, cch);
    if (WANT_C || cc < 48) {
        float wg[4][8], bias[8], win[3][8];
#pragma unroll
        for (int j = 0; j < 4; ++j) { const f32x4 t0 = *(const f32x4*)(A.in[IN_CONVW] + j * 4096 + cch), t1 = *(const f32x4*)(A.in[IN_CONVW] + j * 4096 + cch + 4);
            wg[j][0] = t0[0]; wg[j][1] = t0[1]; wg[j][2] = t0[2]; wg[j][3] = t0[3]; wg[j][4] = t1[0]; wg[j][5] = t1[1]; wg[j][6] = t1[2]; wg[j][7] = t1[3]; }
        { const f32x4 t0 = *(const f32x4*)(A.in[IN_CONVB] + cch), t1 = *(const f32x4*)(A.in[IN_CONVB] + cch + 4);
          bias[0] = t0[0]; bias[1] = t0[1]; bias[2] = t0[2]; bias[3] = t0[3]; bias[4] = t1[0]; bias[5] = t1[1]; bias[6] = t1[2]; bias[7] = t1[3]; }
#pragma unroll
        for (int j = 0; j < 3; ++j) { const int lr = 8 * rb - 3 + j;
            unpack8(R.raw[j], win[j]);
            if (SAMPLE && lr < 0) { const float* sp = A.in[IN_SCONV] + ((size_t)b * 3 + (3 + lr)) * 4096 + cch; const f32x4 t0 = *(const f32x4*)sp, t1 = *(const f32x4*)(sp + 4);
                win[j][0] = t0[0]; win[j][1] = t0[1]; win[j][2] = t0[2]; win[j][3] = t0[3]; win[j][4] = t1[0]; win[j][5] = t1[1]; win[j][6] = t1[2]; win[j][7] = t1[3]; }
            const bool z = SAMPLE ? (lr >= L) : (lr < 0 && c == 0);
            if (z) {
#pragma unroll
                for (int e = 0; e < 8; ++e) win[j][e] = 0.f; } }
        const int r = (cc >> 3) & 3;
        const float alast = WANT_XW ? sac[63 * 4 + r] : 0.f;
#pragma unroll
        for (int i = 0; i < 8; ++i) { const int l = 8 * rb + i; float cur[8], val[8];
            unpack8(R.raw[3 + i], cur);
            if (SAMPLE && l >= L) {
#pragma unroll
                for (int e = 0; e < 8; ++e) cur[e] = 0.f; }
#pragma unroll
            for (int e = 0; e < 8; ++e) val[e] = silu_f(bias[e] + wg[0][e] * win[0][e] + wg[1][e] * win[1][e] + wg[2][e] * win[2][e] + wg[3][e] * cur[e]);
            if (cc < 32) {
                if (WANT_X) *(LAS v4u*)(lds + SX_OFF + l * X_STRIDE + cc * 16) = pack8(val);
                if (WANT_XW) { const float sc = __expf(alast - sac[l * 4 + r]) * sdt[l * 4 + r]; float xw[8];
#pragma unroll
                    for (int e = 0; e < 8; ++e) xw[e] = val[e] * sc;
                    *(LAS v4u*)(lds + SXW_OFF + l * X_STRIDE + cc * 16) = pack8(xw); }
            } else if (cc < 48) *(LAS v4u*)(lds + SB_OFF + l * BC_STRIDE + (cc - 32) * 16) = pack8(val);
            else *(LAS v4u*)(lds + SC_OFF + l * BC_STRIDE + (cc - 48) * 16) = pack8(val);
            if (SAMPLE ? (l >= DSEQ - 3 && l < DSEQ) : (c == 127 && l >= 61)) {
                float* dst = A.out + (SAMPLE ? O_CS : O_CP) + ((size_t)b * 3 + (l - (L - 3))) * 4096 + cch;
                *(f32x4*)dst = (f32x4){cur[0], cur[1], cur[2], cur[3]}; *(f32x4*)(dst + 4) = (f32x4){cur[4], cur[5], cur[6], cur[7]}; }
#pragma unroll
            for (int e = 0; e < 8; ++e) { win[0][e] = win[1][e]; win[1][e] = win[2][e]; win[2][e] = cur[e]; } }
    }
}
template <bool SAMPLE>
__device__ __forceinline__ void ssd_states(const Args& A, LAS unsigned char* lds, int tid, int b, int c, int g) {
    const int lane = tid & 63, w = __builtin_amdgcn_readfirstlane(tid >> 6), r16 = lane & 15, quad = lane >> 4;
    const int r = w >> 1, nh = w & 1, h = g * 4 + r;
    LAS const unsigned char* Bi = lds + SB_OFF; LAS const unsigned char* XWi = lds + SXW_OFF; LAS const float* sac = (LAS const float*)(lds + SAC_OFF);
    f32x4 acc[4][4];
    f32x4 s0v[4][4];
    if (SAMPLE) { const float* s0 = A.in[IN_SSSM] + ((size_t)(b * 32 + h) * 64) * 128;
#pragma unroll
        for (int nt = 0; nt < 4; ++nt)
#pragma unroll
            for (int pt = 0; pt < 4; ++pt) s0v[nt][pt] = *(const f32x4*)(s0 + (size_t)(16 * pt + r16) * 128 + nh * 64 + 16 * quad + 4 * nt);
        asm volatile("" ::: "memory"); }
#pragma unroll
    for (int nt = 0; nt < 4; ++nt)
#pragma unroll
        for (int pt = 0; pt < 4; ++pt) acc[nt][pt] = (f32x4){0.f, 0.f, 0.f, 0.f};
#pragma unroll
    for (int s2 = 0; s2 < 2; ++s2) { bf16x8 af[4], bf[4];
#pragma unroll
        for (int nt = 0; nt < 4; ++nt) af[nt] = ld_trp_g(Bi, BC_STRIDE, 32 * s2, nh * 64, r16, quad, nt);
#pragma unroll
        for (int pt = 0; pt < 4; ++pt) bf[pt] = ld_trp(XWi, X_STRIDE, 32 * s2, r * 64 + 16 * pt, r16, quad);
#pragma unroll
        for (int nt = 0; nt < 4; ++nt)
#pragma unroll
            for (int pt = 0; pt < 4; ++pt) acc[nt][pt] = mfma16(af[nt], bf[pt], acc[nt][pt]); }
    const float dec = __expf(sac[63 * 4 + r]);
    if (!SAMPLE) {
        bf16* st = (bf16*)(A.ws + WS_X1B) + ((size_t)((b * 128 + c) * 32 + h) * 64) * 128;
#pragma unroll
        for (int pt = 0; pt < 4; ++pt) { bf16* d = st + (size_t)(16 * pt + r16) * 128 + nh * 64 + 16 * quad;
            v4u w0, w1; w0.x = pkh(acc[0][pt][0], acc[0][pt][1]); w0.y = pkh(acc[0][pt][2], acc[0][pt][3]); w0.z = pkh(acc[1][pt][0], acc[1][pt][1]); w0.w = pkh(acc[1][pt][2], acc[1][pt][3]);
            w1.x = pkh(acc[2][pt][0], acc[2][pt][1]); w1.y = pkh(acc[2][pt][2], acc[2][pt][3]); w1.z = pkh(acc[3][pt][0], acc[3][pt][1]); w1.w = pkh(acc[3][pt][2], acc[3][pt][3]);
            *(v4u*)d = w0; *(v4u*)(d + 8) = w1; }
        if (nh == 0 && lane == 0) ((float*)(A.ws + WS_DECAY))[(b * 128 + c) * 32 + h] = dec;
    } else {
        float* so = A.out + O_SS + ((size_t)(b * 32 + h) * 64) * 128;
        asm volatile("" ::: "memory");
#pragma unroll
        for (int nt = 0; nt < 4; ++nt)
#pragma unroll
            for (int pt = 0; pt < 4; ++pt) { const size_t off = (size_t)(16 * pt + r16) * 128 + nh * 64 + 16 * quad + 4 * nt;
                *(f32x4*)(so + off) = s0v[nt][pt] * dec + acc[nt][pt]; }
    }
}
template <bool SAMPLE>
__device__ __forceinline__ void ssd_output(const Args& A, LAS unsigned char* lds, int tid, int b, int c, int g, int un = -1, SsdRegs* Rn = nullptr) {
    const int lane = tid & 63, w = __builtin_amdgcn_readfirstlane(tid >> 6), r16 = lane & 15, quad = lane >> 4;
    const int r = w >> 1, lh = w & 1, h = g * 4 + r;
    unsigned char* ws = A.ws; const bf16* proj = (const bf16*)(ws + WS_PROJ); bf16* mix = (bf16*)(ws + WS_H);
    LAS const unsigned char* Xi = lds + SX_OFF; LAS const unsigned char* Bi = lds + SB_OFF; LAS const unsigned char* Ci = lds + SC_OFF;
    LAS const float* sdt = (LAS const float*)(lds + SDT_OFF); LAS const float* sac = (LAS const float*)(lds + SAC_OFF); LAS float* spart = (LAS float*)(lds + SPART_OFF);
    const int row0 = SAMPLE ? NTOK_P + b * DSEQ : b * SEQ + c * 64;
    v2u zreg[2][4];
#pragma unroll
    for (int lti = 0; lti < 2; ++lti) { const int l = 32 * lh + 16 * lti + r16; const int lz = (!SAMPLE || l < DSEQ) ? l : 0;
#pragma unroll
        for (int pt = 0; pt < 4; ++pt) zreg[lti][pt] = *(const v2u*)(proj + (size_t)(row0 + lz) * LDP + OFF_Z + h * 64 + 16 * quad + 4 * pt); }
    bf16x8 pst[2][4];
    if (!SAMPLE) { asm volatile("" ::: "memory");
#pragma unroll
        for (int ks = 0; ks < 2; ++ks)
#pragma unroll
            for (int pt = 0; pt < 4; ++pt) pst[ks][pt] = *(const bf16x8*)((const bf16*)(ws + WS_X1B) + ((size_t)((b * 128 + c) * 32 + h) * 64 + 16 * (r16 >> 2) + 4 * pt + (r16 & 3)) * 128 + 32 * ks + 8 * quad);
        asm volatile("" ::: "memory"); }
    f32x4 gt[4][2];
#pragma unroll
    for (int st = 0; st < 4; ++st) { gt[st][0] = (f32x4){0.f, 0.f, 0.f, 0.f}; gt[st][1] = (f32x4){0.f, 0.f, 0.f, 0.f}; }
#pragma unroll
    for (int ks = 0; ks < 4; ++ks) { const bf16x8 c0 = ld_nat(Ci, BC_STRIDE, 32 * lh, 32 * ks, r16, quad), c1 = ld_nat(Ci, BC_STRIDE, 32 * lh + 16, 32 * ks, r16, quad);
#pragma unroll
        for (int st = 0; st < 4; ++st) { const bf16x8 bfr = ld_nat(Bi, BC_STRIDE, 16 * st, 32 * ks, r16, quad); gt[st][0] = mfma16(bfr, c0, gt[st][0]); gt[st][1] = mfma16(bfr, c1, gt[st][1]); } }
    float al[2];
#pragma unroll
    for (int lti = 0; lti < 2; ++lti) al[lti] = sac[(32 * lh + 16 * lti + r16) * 4 + r];
#pragma unroll
    for (int st = 0; st < 4; ++st)
#pragma unroll
        for (int j = 0; j < 4; ++j) { const int s = 16 * st + 4 * quad + j; const float as = sac[s * 4 + r], ds = sdt[s * 4 + r];
#pragma unroll
            for (int lti = 0; lti < 2; ++lti) { const int l = 32 * lh + 16 * lti + r16; gt[st][lti][j] = (s <= l) ? gt[st][lti][j] * __expf(al[lti] - as) * ds : 0.f; } }
    f32x4 ya[4][2];
#pragma unroll
    for (int pt = 0; pt < 4; ++pt) { ya[pt][0] = (f32x4){0.f, 0.f, 0.f, 0.f}; ya[pt][1] = (f32x4){0.f, 0.f, 0.f, 0.f}; }
#pragma unroll
    for (int s2 = 0; s2 < 2; ++s2) { const bf16x8 m0 = pack_p(gt[2 * s2][0], gt[2 * s2 + 1][0]), m1 = pack_p(gt[2 * s2][1], gt[2 * s2 + 1][1]);
#pragma unroll
        for (int pt = 0; pt < 4; ++pt) { const bf16x8 xa = ld_trp_g(Xi, X_STRIDE, 32 * s2, r * 64, r16, quad, pt); ya[pt][0] = mfma16(xa, m0, ya[pt][0]); ya[pt][1] = mfma16(xa, m1, ya[pt][1]); } }
    if (!SAMPLE) MXS(1);
    bf16x8 pst2[2][4];
    if (!SAMPLE) { asm volatile("" ::: "memory");
#pragma unroll
        for (int ks = 2; ks < 4; ++ks)
#pragma unroll
            for (int pt = 0; pt < 4; ++pt) pst2[ks - 2][pt] = *(const bf16x8*)((const bf16*)(ws + WS_X1B) + ((size_t)((b * 128 + c) * 32 + h) * 64 + 16 * (r16 >> 2) + 4 * pt + (r16 & 3)) * 128 + 32 * ks + 8 * quad);
        asm volatile("" ::: "memory"); }
    if (!SAMPLE) { asm volatile("" ::: "memory"); if (un >= 0) ssd_load<false>(A, tid, un >> 10, (un >> 3) & 127, un & 7, *Rn); asm volatile("" ::: "memory"); }
    {
        f32x4 oa[4][2];
#pragma unroll
        for (int pt = 0; pt < 4; ++pt) { oa[pt][0] = (f32x4){0.f, 0.f, 0.f, 0.f}; oa[pt][1] = (f32x4){0.f, 0.f, 0.f, 0.f}; }
#pragma unroll
        for (int ks = 0; ks < 4; ++ks) { const bf16x8 c0 = ld_nat(Ci, BC_STRIDE, 32 * lh, 32 * ks, r16, quad), c1 = ld_nat(Ci, BC_STRIDE, 32 * lh + 16, 32 * ks, r16, quad);
#pragma unroll
            for (int pt = 0; pt < 4; ++pt) { bf16x8 pa;
                if (!SAMPLE) { if (ks < 2) pa = pst[ks][pt]; else pa = pst2[ks - 2][pt]; }
                else { const float* sp = A.in[IN_SSSM] + ((size_t)(b * 32 + h) * 64 + 16 * (r16 >> 2) + 4 * pt + (r16 & 3)) * 128 + 32 * ks + 8 * quad; const f32x4 t0 = *(const f32x4*)sp, t1 = *(const f32x4*)(sp + 4);
                    v4u wv; wv.x = pkh(t0[0], t0[1]); wv.y = pkh(t0[2], t0[3]); wv.z = pkh(t1[0], t1[1]); wv.w = pkh(t1[2], t1[3]); pa = __builtin_bit_cast(bf16x8, wv); }
                oa[pt][0] = mfma16(pa, c0, oa[pt][0]); oa[pt][1] = mfma16(pa, c1, oa[pt][1]); }
            if (ks & 1) asm volatile("" ::: "memory"); }
#pragma unroll
        for (int lti = 0; lti < 2; ++lti) { const float el = __expf(al[lti]);
#pragma unroll
            for (int pt = 0; pt < 4; ++pt) ya[pt][lti] = ya[pt][lti] + oa[pt][lti] * el; }
    }
    const float D = A.in[IN_DSKIP][h];
    float ss[2];
#pragma unroll
    for (int lti = 0; lti < 2; ++lti) { const int l = 32 * lh + 16 * lti + r16; ss[lti] = 0.f;
#pragma unroll
        for (int pt = 0; pt < 4; ++pt) { const v2u xw = *(LAS const v2u*)(Xi + l * X_STRIDE + (r * 64 + 16 * quad + 4 * pt) * 2);
            const v2u zw = zreg[lti][pt];
            const float xv[4] = {bflo(xw.x), bfhi(xw.x), bflo(xw.y), bfhi(xw.y)}, zv[4] = {bflo(zw.x), bfhi(zw.x), bflo(zw.y), bfhi(zw.y)};
#pragma unroll
            for (int j = 0; j < 4; ++j) { const float y = ya[pt][lti][j] + xv[j] * D, gv = y * silu_f(zv[j]); ya[pt][lti][j] = gv; ss[lti] += gv * gv; } }
        ss[lti] += __shfl_xor(ss[lti], 16); ss[lti] += __shfl_xor(ss[lti], 32);
        if (quad == 0) spart[l * 4 + r] = ss[lti]; }
    __syncthreads();
    if (!SAMPLE) MXS(2);
#pragma unroll
    for (int lti = 0; lti < 2; ++lti) { const int l = 32 * lh + 16 * lti + r16;
        const f32x4 pr = *(LAS const f32x4*)(spart + l * 4); const float rs = 1.f / sqrtf(((pr[0] + pr[1]) + (pr[2] + pr[3])) * (1.f / 256.f) + RMS_EPS);
        if (!SAMPLE || l < DSEQ) {
            unsigned wv[8];
#pragma unroll
            for (int pt = 0; pt < 4; ++pt) { const f32x4 nw = *(const f32x4*)(A.in[IN_SNW] + h * 64 + 16 * quad + 4 * pt);
                wv[2 * pt] = pkh(ya[pt][lti][0] * rs * nw[0], ya[pt][lti][1] * rs * nw[1]); wv[2 * pt + 1] = pkh(ya[pt][lti][2] * rs * nw[2], ya[pt][lti][3] * rs * nw[3]); }
            bf16* d = mix + (size_t)(row0 + l) * DM + 2048 + h * 64 + 16 * quad;
            *(v4u*)d = (v4u){wv[0], wv[1], wv[2], wv[3]}; *(v4u*)(d + 8) = (v4u){wv[4], wv[5], wv[6], wv[7]}; } }
    __syncthreads();
}
template <bool DRY = false> __device__ __forceinline__ void ssd_pass(const Args& A, int gid) {
    const int n4 = gid & 31, p = (gid >> 5) & 63, h = (gid >> 11) & 31, b = gid >> 16;
    bf16* st = (bf16*)(A.ws + WS_X1B); const float* dec = (const float*)(A.ws + WS_DECAY);
    f32x4 run = (f32x4){0.f, 0.f, 0.f, 0.f};
    for (int c0 = 0; c0 < 128; c0 += 8) { v2u loc[8]; float d[8];
#pragma unroll
        for (int i = 0; i < 8; ++i) { const int c = c0 + i; loc[i] = *(const v2u*)(st + ((size_t)((b * 128 + c) * 32 + h) * 64 + p) * 128 + n4 * 4); d[i] = dec[(b * 128 + c) * 32 + h]; }
#pragma unroll
        for (int i = 0; i < 8; ++i) { const int c = c0 + i; v2u pv; pv.x = pkh(run[0], run[1]); pv.y = pkh(run[2], run[3]);
            *(v2u*)(st + ((size_t)((b * 128 + c) * 32 + h) * 64 + p) * 128 + n4 * 4) = DRY ? loc[i] : pv;
            run = run * d[i] + (f32x4){bflo(loc[i].x), bfhi(loc[i].x), bflo(loc[i].y), bfhi(loc[i].y)}; } }
    if (!DRY) *(f32x4*)(A.out + O_SP + ((size_t)(b * 32 + h) * 64 + p) * 128 + n4 * 4) = run;
    else if (run[0] == 12345.678f) *(f32x4*)(A.out + O_SP) = run;
}
}
#ifndef PROBE_DUP
#define PROBE_DUP -1
#endif
#define REP(k) for (int rep_ = 0; rep_ < ((PROBE_DUP == (k)) ? 2 : 1); ++rep_)
#ifndef IN_WGM
#define IN_WGM 8
#endif
#ifndef OUT_WGM
#define OUT_WGM 8
#endif
#ifndef DOWN_WGM
#define DOWN_WGM 8
#endif
#ifndef MIX_FAST_ATTN
#define MIX_FAST_ATTN 1
#endif
#ifndef MIX_FAST_SSD
#define MIX_FAST_SSD 1
#endif
#if defined(PROBE_CLK)
__device__ __forceinline__ void clk_mark(volatile LAS unsigned* m, int slot) {
    const unsigned long long c = __builtin_amdgcn_s_memtime(), r = __builtin_amdgcn_s_memrealtime();
    m[64 + slot * 4 + 0] = (unsigned)c; m[64 + slot * 4 + 1] = (unsigned)(c >> 32); m[64 + slot * 4 + 2] = (unsigned)r; m[64 + slot * 4 + 3] = (unsigned)(r >> 32);
}
#define CLK_MARK(k, slot) do { if (PROBE_CLK == (k) && blockIdx.x == 0 && F.tid == 0) clk_mark(F.MISC, slot); } while (0)
#else
#define CLK_MARK(k, slot) do { } while (0)
#endif
#if defined(PROBE_PH)
#define PH_STAMP(slot) do { if (blockIdx.x == 0 && F.tid == 0) F.MISC[160 + (slot)] = (unsigned)__builtin_amdgcn_s_memrealtime(); } while (0)
#else
#define PH_STAMP(slot) do { } while (0)
#endif
__global__ void __launch_bounds__(NWAVES * 64, 2) mega_fwd(Args args) {
    extern __shared__ __attribute__((aligned(16))) unsigned char lds[];
    Frame F;
    F.lds = (LAS unsigned char*)lds;
    F.MISC = (volatile LAS unsigned*)(F.lds + MISC_OFF);
    F.tid = threadIdx.x; F.lane = F.tid & 63; F.wave = __builtin_amdgcn_readfirstlane(F.tid >> 6);
    F.G = gridDim.x; { const int bx = blockIdx.x; F.vcu = (F.G % 8 == 0) ? (bx % 8) * (F.G / 8) + bx / 8 : bx; }
    unsigned char* ws = args.ws;
    F.ctl = (gu32*)(ws + WS_CTL);
    for (int u = F.tid; u < (LDS_BYTES - LDSCTL_OFF) / 4; u += NWAVES * 64) ((LAS unsigned*)(F.lds + LDSCTL_OFF))[u] = 0u;
    __syncthreads();
#if defined(PROBE_SUB)
    const int sub_ = args.ph_lo >= 100 ? args.ph_lo - 100 : -1;
    const int lo = sub_ >= 0 ? PH_MIXA : args.ph_lo, hi = sub_ >= 0 ? PH_MIXA + 1 : args.ph_hi;
#define SUB(k) (sub_ < 0 || sub_ == (k))
#else
    const int lo = args.ph_lo, hi = args.ph_hi;
#define SUB(k) true
#endif
    const bool multi = (hi - lo) > 1;
    XcdBarrier bar; bar.bar = (unsigned*)(F.ctl + CW_BAR) + args.li * XCD_BAR_WORDS; bar.x = 0; bar.st = nullptr;
    if (multi) bar = xcd_barrier_post((unsigned*)(F.ctl + CW_BAR) + args.li * XCD_BAR_WORDS, F.MISC + 8);
#define IN(k) (lo <= (k) && (k) < hi)
#define SEAM(k) do { if (IN(k) && IN((k) + 1)) xcd_barrier(bar); } while (0)

    PH_STAMP(PH_PRO);
    if (IN(PH_PRO)) { REP(PH_PRO) { p0_prologue(F, args); } SEAM(PH_PRO); }

    PH_STAMP(PH_INPROJ);
    if (IN(PH_INPROJ)) { CLK_MARK(PH_INPROJ, 0);
        const pg8::Gemm g = pg8::gemm_rm((const bf16*)(ws + WS_H), (const bf16*)(ws + WS_WIN), M, LDP, DM, DM); pg8::StaticOrder S; S.init(M, LDP, F.G, (int)blockIdx.x);
        pg8::EpiProj E{(bf16*)(ws + WS_PROJ), LDP, (float*)(ws + WS_DT), OFF_DT / 256};
        if (F.G != 256) { pg8::gemm_phase<pg8::EpiProj, pg8::StaticOrder, PG8_ALIGN, PG8_SP2>(F.lds + RING_OFF, g, S, E); }
        else {
            constexpr int NR = (M / 256) * (LDP / 256) / 256 + 1;
            const int sr = 1 + ((int)blockIdx.x & 7);
#if defined(IN_BAND)
            { pg8::BandIn S1{(int)blockIdx.x, 0, sr}; pg8::gemm_phase<pg8::EpiProj, pg8::BandIn, PG8_ALIGN, PG8_SP2>(F.lds + RING_OFF, g, S1, E); }
#else
            pg8::RangeOrder S1; S1.init(M, LDP, F.G, (int)blockIdx.x); S1.r0 = 0; S1.r1 = sr; S1.wgm = IN_WGM;
            pg8::gemm_phase<pg8::EpiProj, pg8::RangeOrder, PG8_ALIGN, PG8_SP2>(F.lds + RING_OFF, g, S1, E);
#endif
            __syncthreads();
            PH_STAMP(20);
            p0_convert(F, args, T_I_IN + T_I_OUT, T_NITEMS, (int)blockIdx.x * NWAVES + F.wave, F.G * NWAVES);
            { constexpr int NLIGHT = 256 - ((M / 256) * (LDP / 256) - (NR - 1) * 256);
              const int lc = (int)blockIdx.x - (256 - NLIGHT);
              if (lc >= 0) p0_convert(F, args, T_I_IN, T_I_IN + T_I_OUT, lc * NWAVES + F.wave, NLIGHT * NWAVES); }
            __syncthreads();
            PH_STAMP(21);
#if defined(IN_BAND)
            { pg8::BandIn S2{(int)blockIdx.x, sr, NR}; pg8::gemm_phase<pg8::EpiProj, pg8::BandIn, PG8_ALIGN, PG8_SP2>(F.lds + RING_OFF, g, S2, E); }
#else
            pg8::RangeOrder S2; S2.init(M, LDP, F.G, (int)blockIdx.x); S2.r0 = sr; S2.r1 = NR; S2.wgm = IN_WGM;
            pg8::gemm_phase<pg8::EpiProj, pg8::RangeOrder, PG8_ALIGN, PG8_SP2>(F.lds + RING_OFF, g, S2, E);
#endif
        }
        CLK_MARK(PH_INPROJ, 1);
        SEAM(PH_INPROJ);
    }
    PH_STAMP(PH_MIXA);
    if (IN(PH_MIXA)) { REP(PH_MIXA) {
#if !MIX_FAST_SSD || !MIX_FAST_ATTN
        { const int vt = F.tid & 255, half = F.tid >> 8;
          for (int vb = (int)blockIdx.x * 2 + half; vb < M; vb += F.G * 2) nv_prep(args, vb, vt, !MIX_FAST_ATTN); }
#endif
#if MIX_FAST_ATTN
        { int mt = F.tid; asm volatile("" : "+v"(mt)); LAS unsigned char* L = F.lds + RING_OFF; constexpr int NU = NB_P * 128 * 8; mx::AttnRegs R;
          int u = (int)blockIdx.x; if (u < NU) mx::attn_load(args, mt, u >> 10, (u >> 3) & 127, u & 7, R);
          if (!SUB(0)) u = NU;
          while (u < NU) { const int un = u + F.G;
              mx::attn_stage(args, L, mt, u >> 10, (u >> 3) & 127, u & 7, R); __syncthreads();
              if (un < NU) mx::attn_load(args, mt, un >> 10, (un >> 3) & 127, un & 7, R);
              mx::attn_compute<false>(args, L, mt, u >> 10, (u >> 3) & 127, u & 7); __syncthreads(); u = un; }
          asm volatile("" : "+v"(mt)); PH_STAMP(16);
          if (SUB(1)) for (int us = (int)blockIdx.x; us < NB_S * 8; us += F.G) { mx::attn_stage_sample(args, L, mt, us >> 3, us & 7); __syncthreads(); mx::attn_compute<true>(args, L, mt, us >> 3, 0, us & 7); __syncthreads(); } }
#endif
#if MIX_FAST_SSD
        PH_STAMP(17);
        { int mt = F.tid; asm volatile("" : "+v"(mt)); LAS unsigned char* L = F.lds + RING_OFF; constexpr int NU = NB_P * 128 * 8; mx::SsdRegs R;
          int u = (int)blockIdx.x; if (u < NU) mx::ssd_load<false, false>(args, mt, u >> 10, (u >> 3) & 127, u & 7, R);
          if (!SUB(2)) u = NU;
          while (u < NU) { const int un = u + F.G; const int b = u >> 10, c = (u >> 3) & 127, g = u & 7;
              mx::ssd_stage<false, false, true, false>(args, L, mt, b, c, g, R); __syncthreads();
              if (un < NU) mx::ssd_load<false, false>(args, mt, un >> 10, (un >> 3) & 127, un & 7, R);
              mx::ssd_states<false>(args, L, mt, b, c, g); __syncthreads(); u = un; }
          asm volatile("" : "+v"(mt)); PH_STAMP(18);
          if (SUB(3)) for (int us = (int)blockIdx.x; us < NB_S * 8; us += F.G) { const int b = us >> 3, g = us & 7;
              mx::ssd_load<true>(args, mt, b, 0, g, R); mx::ssd_stage<true, true, true, true>(args, L, mt, b, 0, g, R); __syncthreads();
              mx::ssd_states<true>(args, L, mt, b, 0, g); mx::ssd_output<true>(args, L, mt, b, 0, g); } }
#endif
        }
        SEAM(PH_MIXA);
    }
    PH_STAMP(PH_MIXB);
    if (IN(PH_MIXB)) {
#if MIX_FAST_SSD
        for (int gid = (int)blockIdx.x * 512 + F.tid; gid < NB_P * 32 * 64 * 32; gid += F.G * 512) mx::ssd_pass<false>(args, gid);
#if defined(PROBE_MIXB)
        __syncthreads();
        for (int gid = (int)blockIdx.x * 512 + F.tid; gid < NB_P * 32 * 64 * 32; gid += F.G * 512) mx::ssd_pass<true>(args, gid);
#endif
#else
        { const int vt = F.tid & 255, half = F.tid >> 8;
          LAS float* sB = (LAS float*)(F.lds + RING_OFF + half * 16384);
          constexpr int NSCAN = (NB_P + NB_S) * 8;
          for (int i = (int)blockIdx.x; 2 * i < NSCAN; i += F.G) { const int vb = 2 * i + half; nv_scan(args, vb < NSCAN ? vb : -1, (2 * i < NB_P * 8) ? SEQ : DSEQ, vt, sB); } }
#endif
#if !MIX_FAST_ATTN
        { const int vt = F.tid & 255, half = F.tid >> 8;
          for (int vb = (int)blockIdx.x * 2 + half; vb < NB_P * 128 * 8; vb += F.G * 2) nv_attn<false>(args, vb, vt);
          for (int vb = (int)blockIdx.x * 2 + half; vb < NB_S * 8; vb += F.G * 2) nv_attn<true>(args, vb, vt); }
#endif
        SEAM(PH_MIXB);
    }
    PH_STAMP(PH_MIXC);
    if (IN(PH_MIXC)) { REP(PH_MIXC) {
#if MIX_FAST_SSD
        { int mt = F.tid; asm volatile("" : "+v"(mt)); LAS unsigned char* L = F.lds + RING_OFF; constexpr int NU = NB_P * 128 * 8; mx::SsdRegs R;
          int u = (int)blockIdx.x; if (u < NU) mx::ssd_load<false>(args, mt, u >> 10, (u >> 3) & 127, u & 7, R);
          while (u < NU) { const int un = u + F.G; const int b = u >> 10, c = (u >> 3) & 127, g = u & 7;
#if defined(PROBE_SEG)
              { LAS unsigned char* lds = L; const int tid = F.tid; if (blockIdx.x == 0 && tid == 0) ((volatile LAS unsigned*)(lds + MISC_OFF))[200] = (unsigned)__builtin_amdgcn_s_memrealtime(); }
#endif
              mx::ssd_stage<false, true, false, true>(args, L, mt, b, c, g, R); __syncthreads();
#if defined(PROBE_SEG)
              { LAS unsigned char* lds = L; const int tid = F.tid; MXS(0); }
#endif
              mx::ssd_output<false>(args, L, mt, b, c, g, un < NU ? un : -1, &R);
#if defined(PROBE_SEG)
              { LAS unsigned char* lds = L; const int tid = F.tid; MXS(3); }
#endif
              u = un; } }
#else
        { const int vt = F.tid & 255, half = F.tid >> 8;
          for (int vb = (int)blockIdx.x * 2 + half; vb < M; vb += F.G * 2) nv_gate(args, vb, vt); }
#endif
        }
        SEAM(PH_MIXC);
    }
    PH_STAMP(PH_OUT);
    if (IN(PH_OUT)) { CLK_MARK(PH_OUT, 0);
        const pg8::Gemm g = pg8::gemm_rm((const bf16*)(ws + WS_H), (const bf16*)(ws + WS_WOUT), M, DM, DM, DM);
        pg8::EpiOut E{args.in[IN_XP], args.in[IN_XS], args.out + O_Y, (bf16*)(ws + WS_X1B), (float*)(ws + WS_PART), NTOK_P};
        if (F.G != 256) { pg8::StaticOrder S; S.init(M, DM, F.G, (int)blockIdx.x); pg8::gemm_phase<pg8::EpiOut, pg8::StaticOrder, PG8_ALIGN, PG8_SP2>(F.lds + RING_OFF, g, S, E); }
        else {
#if defined(OUT_BAND)
            { pg8::BandOrder Bo; Bo.init(DM, (int)blockIdx.x); Bo.tail = false; pg8::gemm_phase<pg8::EpiOut, pg8::BandOrder, PG8_ALIGN, PG8_SP2>(F.lds + RING_OFF, g, Bo, E); }
#else
            { pg8::StaticOrder S; S.init(NTOK_P, DM, F.G, (int)blockIdx.x); S.wgm = OUT_WGM;
              pg8::gemm_phase<pg8::EpiOut, pg8::StaticOrder, PG8_ALIGN, PG8_SP2>(F.lds + RING_OFF, g, S, E); }
#endif
            PH_STAMP(22);
            const int j = (int)blockIdx.x >> 2, q = (int)blockIdx.x & 3;
            const pg8::Gemm g2 = pg8::gemm_rm((const bf16*)(ws + WS_H) + q * (DM / 4), (const bf16*)(ws + WS_WOUT) + q * (DM / 4), M, DM, DM / 4, DM);
            pg8::PanelTail T{NTOK_P / 256 + (j >> 4), j & 15};
            pg8::EpiPart EP{(bf16*)(ws + WS_PROJ) + (size_t)blockIdx.x * 65536};
            pg8::gemm_phase<pg8::EpiPart, pg8::PanelTail, PG8_ALIGN, PG8_SP2>(F.lds + RING_OFF, g2, T, EP);
        }
        CLK_MARK(PH_OUT, 1);
        SEAM(PH_OUT);
    }
    PH_STAMP(PH_RSTD);
    if (IN(PH_RSTD)) {
        const float* part = (const float*)(ws + WS_PART); float* rstd = (float*)(ws + WS_RSTD);
        const int gw = F.vcu * NWAVES + F.wave, NGW = F.G * NWAVES;
        const int mlim = (F.G == 256) ? NTOK_P : M;
        for (int m0 = gw; m0 < mlim; m0 += 8 * NGW) { float pv[8];
#pragma unroll
            for (int k = 0; k < 8; ++k) { const int m = m0 + k * NGW; pv[k] = part[(size_t)(m < mlim ? m : m0) * 64 + F.lane]; }
#pragma unroll
            for (int k = 0; k < 8; ++k) { const int m = m0 + k * NGW; const float s = wave_sum(pv[k]); if (F.lane == 0 && m < mlim) rstd[m] = 1.f / sqrtf(s * (1.f / DM) + RMS_EPS); } }
        if (F.G == 256) {
            const bf16* slabs = (const bf16*)(ws + WS_PROJ); bf16* xb = (bf16*)(ws + WS_X1B);
            for (int r = gw; r < NTOK_S; r += NGW) { const int pmr = r >> 8, rr = r & 255; float ss = 0.f;
#pragma unroll
              for (int ph = 0; ph < 2; ++ph) { v2u sv[8][4]; f32x4 xv[8];
#pragma unroll
                for (int i = 0; i < 8; ++i) { const int pn = 8 * ph + i; const v2u* s = (const v2u*)(slabs + (size_t)(4 * (pmr * 16 + pn)) * 65536 + rr * 256) + F.lane;
                    sv[i][0] = s[0]; sv[i][1] = s[16384]; sv[i][2] = s[2 * 16384]; sv[i][3] = s[3 * 16384]; xv[i] = *((const f32x4*)(args.in[IN_XS] + (size_t)r * DM + pn * 256) + F.lane); }
                asm volatile("" ::: "memory");
#pragma unroll
                for (int i = 0; i < 8; ++i) { const int pn = 8 * ph + i; const v2u s0 = sv[i][0], s1 = sv[i][1], s2 = sv[i][2], s3 = sv[i][3];
                    const f32x4 ps = ((f32x4){bflo(s0.x), bfhi(s0.x), bflo(s0.y), bfhi(s0.y)} + (f32x4){bflo(s1.x), bfhi(s1.x), bflo(s1.y), bfhi(s1.y)}) + ((f32x4){bflo(s2.x), bfhi(s2.x), bflo(s2.y), bfhi(s2.y)} + (f32x4){bflo(s3.x), bfhi(s3.x), bflo(s3.y), bfhi(s3.y)});
                    const f32x4 v = xv[i] + ps;
                    ss += (v[0] * v[0] + v[1] * v[1]) + (v[2] * v[2] + v[3] * v[3]);
                    v2u w; w.x = pk2(v[0], v[1]); w.y = pk2(v[2], v[3]); *((v2u*)(xb + (size_t)(NTOK_P + r) * DM + pn * 256) + F.lane) = w; } }
                ss = wave_sum(ss); if (F.lane == 0) rstd[NTOK_P + r] = 1.f / sqrtf(ss * (1.f / DM) + RMS_EPS); }
        }
        SEAM(PH_RSTD);
    }
    PH_STAMP(PH_UP);
    if (IN(PH_UP)) { CLK_MARK(PH_UP, 0);
#if defined(PROBE_BND)
        if (F.tid == 0) { F.MISC[72] = 0u; F.MISC[80] = 1u; } __syncthreads();
#endif
        const pg8::Gemm g = pg8::gemm_rm((const bf16*)(ws + WS_X1B), (const bf16*)(ws + WS_WUP), M, FF, DM, DM); pg8::StaticOrder S; S.init(M, FF, F.G, (int)blockIdx.x);
#if defined(UP_WGM)
        S.wgm = UP_WGM;
#endif
        pg8::EpiUp E{(bf16*)(ws + WS_U), FF, (const float*)(ws + WS_RSTD)};
#if defined(UP_BAND)
        if (F.G == 256 && M == 68 * 256) { pg8::BandOrder Bo; Bo.init(FF, (int)blockIdx.x); pg8::gemm_phase<pg8::EpiUp, pg8::BandOrder, PG8_ALIGN, PG8_SP2>(F.lds + RING_OFF, g, Bo, E); }
        else
#endif
        REP(PH_UP) { pg8::gemm_phase<pg8::EpiUp, pg8::StaticOrder, PG8_ALIGN, PG8_SP2>(F.lds + RING_OFF, g, S, E); }
#if defined(PROBE_SHADOW_UP)
        {
          struct ZeroOrder : pg8::StaticOrder { __device__ __forceinline__ bool next(int i, pg8::Unit& u) const { pg8::Unit t; const bool ok = pg8::StaticOrder::next(i, t); u.pm = PROBE_SHADOW_UP == 0 ? 0 : t.pm; u.pn = PROBE_SHADOW_UP == 0 ? 0 : t.pn; return ok; } };
          ZeroOrder Z; Z.init(M, FF, F.G, (int)blockIdx.x);
          pg8::ShEpi SE{pg8::EpiUp{PROBE_SHADOW_UP == 2 ? (bf16*)(ws + WS_KN) : (bf16*)(ws + WS_U), FF, (const float*)(ws + WS_RSTD)}};
          pg8::gemm_phase<pg8::ShEpi, ZeroOrder, PG8_ALIGN, PG8_SP2>(F.lds + RING_OFF, g, Z, SE); }
#endif
        CLK_MARK(PH_UP, 1);
#if defined(PROBE_BND)
        __syncthreads(); if (F.tid == 0) F.MISC[80] = 0u;
#endif
        SEAM(PH_UP);
    }
    PH_STAMP(PH_DOWN);
    if (IN(PH_DOWN)) { CLK_MARK(PH_DOWN, 0);
        constexpr int NU = (M / 256) * (DM / 256), NFULL = NU / 256, NLEFT = NU - NFULL * 256;
        const bool split = (F.G == 256) && (NLEFT * 4 == 256);
        const pg8::Gemm g = pg8::gemm_blk((const bf16*)(ws + WS_U), (const bf16*)(ws + WS_WDN), M, DM, FF, FF);
        pg8::EpiDown E{args.out + O_Y, (const bf16*)(ws + WS_X1B)};
        if (!split) { pg8::StaticOrder S; S.init(M, DM, F.G, (int)blockIdx.x); pg8::gemm_phase<pg8::EpiDown, pg8::StaticOrder, PG8_ALIGN, PG8_SP2>(F.lds + RING_OFF, g, S, E); }
        else {
#if defined(DOWN_BAND)
#if defined(DOWN_BAND16)
            { pg8::BandDown Bo{(int)blockIdx.x}; pg8::gemm_phase<pg8::EpiDown, pg8::BandDown, PG8_ALIGN, PG8_SP2>(F.lds + RING_OFF, g, Bo, E); }
#else
            { pg8::BandOrder Bo; Bo.init(DM, (int)blockIdx.x); Bo.tail = false; pg8::gemm_phase<pg8::EpiDown, pg8::BandOrder, PG8_ALIGN, PG8_SP2>(F.lds + RING_OFF, g, Bo, E); }
#endif
#else
            pg8::HeadOrder S; S.init(M, DM, F.G, (int)blockIdx.x); S.nr = NFULL; S.wgm = DOWN_WGM;
            pg8::gemm_phase<pg8::EpiDown, pg8::HeadOrder, PG8_ALIGN, PG8_SP2>(F.lds + RING_OFF, g, S, E);
#endif
#if defined(PROBE_SHADOW_DOWN)
            { pg8::ShEpiD SD{pg8::EpiDown{(float*)(ws + WS_KN), (const bf16*)(ws + WS_X1B)}}; pg8::gemm_phase<pg8::ShEpiD, pg8::HeadOrder, PG8_ALIGN, PG8_SP2>(F.lds + RING_OFF, g, S, SD); }
#endif
            const int q = (int)blockIdx.x & 3;
            const pg8::Gemm g2 = pg8::gemm_blk((const bf16*)(ws + WS_U) + (size_t)q * (FF / 4 / 64) * 16384, (const bf16*)(ws + WS_WDN) + (size_t)q * (FF / 4 / 64) * 16384, M, DM, FF / 4, FF);
            pg8::EpiPart EP{(bf16*)(ws + WS_WUP) + (size_t)blockIdx.x * 65536};
#if defined(DOWN_BAND)
            { const int j = (int)blockIdx.x >> 2; pg8::PanelTail T{64 + (j & 3), j >> 2}; pg8::gemm_phase<pg8::EpiPart, pg8::PanelTail, PG8_ALIGN, PG8_SP2>(F.lds + RING_OFF, g2, T, EP); }
#else
            pg8::TailOrder T; T.init(M, DM, 256, (int)blockIdx.x >> 2); T.round = NFULL; T.wgm = DOWN_WGM;
            pg8::gemm_phase<pg8::EpiPart, pg8::TailOrder, PG8_ALIGN, PG8_SP2>(F.lds + RING_OFF, g2, T, EP);
#endif
        }
        CLK_MARK(PH_DOWN, 1);
        SEAM(PH_DOWN);
    }
    PH_STAMP(PH_DOWN2);
    if (IN(PH_DOWN2)) {
        constexpr int NU = (M / 256) * (DM / 256), NFULL = NU / 256, NLEFT = NU - NFULL * 256;
        if ((F.G == 256) && (NLEFT * 4 == 256)) {
            const bf16* slabs = (const bf16*)(ws + WS_WUP); float* out = args.out + O_Y;
            const int gw = (int)blockIdx.x * NWAVES + F.wave;
            for (int rr = gw; rr < NLEFT * 256; rr += F.G * NWAVES) { const int j = rr >> 8, r = rr & 255;
#if defined(DOWN_BAND)
                pg8::Unit u; u.pm = 64 + (j & 3); u.pn = j >> 2;
#else
                pg8::StaticOrder T; T.init(M, DM, 256, j); T.wgm = DOWN_WGM; pg8::Unit u; T.next(NFULL, u);
#endif
                f32x4* o = (f32x4*)(out + (size_t)(u.pm * 256 + r) * DM + u.pn * 256) + F.lane;
                const v2u xw = *((const v2u*)((const bf16*)(ws + WS_X1B) + (size_t)(u.pm * 256 + r) * DM + u.pn * 256) + F.lane);
                const v2u* s = (const v2u*)(slabs + (size_t)(4 * j) * 65536 + r * 256) + F.lane;
                const v2u s0 = s[0], s1 = s[16384], s2 = s[2 * 16384], s3 = s[3 * 16384];
                const f32x4 ps = ((f32x4){bflo(s0.x), bfhi(s0.x), bflo(s0.y), bfhi(s0.y)} + (f32x4){bflo(s1.x), bfhi(s1.x), bflo(s1.y), bfhi(s1.y)}) + ((f32x4){bflo(s2.x), bfhi(s2.x), bflo(s2.y), bfhi(s2.y)} + (f32x4){bflo(s3.x), bfhi(s3.x), bflo(s3.y), bfhi(s3.y)});
                *o = (f32x4){bflo(xw.x), bfhi(xw.x), bflo(xw.y), bfhi(xw.y)} + ps; }
        }
    }
    PH_STAMP(PH_N);
#if defined(PROBE_SEG)
    if (blockIdx.x == 0 && F.tid == 0) {
        const unsigned d = F.MISC[200 + 1 + (PROBE_SEG)];
        const unsigned long long t0 = __builtin_amdgcn_s_memrealtime(), wait = (unsigned long long)d * (PROBE_MUL);
        while (__builtin_amdgcn_s_memrealtime() - t0 < wait) __builtin_amdgcn_s_sleep(8);
    }
#endif
#if defined(PROBE_PH)
    if (blockIdx.x == 0 && F.tid == 0) {
        const unsigned d = F.MISC[160 + (PROBE_PH_B)] - F.MISC[160 + (PROBE_PH_A)];
        const unsigned long long t0 = __builtin_amdgcn_s_memrealtime(), wait = (unsigned long long)d * (PROBE_MUL);
        while (__builtin_amdgcn_s_memrealtime() - t0 < wait) __builtin_amdgcn_s_sleep(8);
    }
#endif
#if defined(PROBE_BND)
    if (blockIdx.x == 0 && F.tid == 0) {
        unsigned sum = 0;
        for (int u = 1; u < 17; ++u) sum += (F.MISC[72 + 32 + u * 3 + 0] - F.MISC[72 + 32 + (u - 1) * 3 + 2]) - (F.MISC[72 + 32 + u * 3 + 1] - F.MISC[72 + 32 + u * 3 + 0]);
        const unsigned long long t0 = __builtin_amdgcn_s_memrealtime(), wait = (unsigned long long)sum * 100ull / 336ull;
        while (__builtin_amdgcn_s_memrealtime() - t0 < wait) __builtin_amdgcn_s_sleep(8);
    }
#endif
#if defined(PROBE_CLK)
    if (blockIdx.x == 0 && F.tid == 0) {
        const unsigned long long c0 = F.MISC[64] | ((unsigned long long)F.MISC[65] << 32), r0 = F.MISC[66] | ((unsigned long long)F.MISC[67] << 32);
        const unsigned long long c1 = F.MISC[68] | ((unsigned long long)F.MISC[69] << 32), r1 = F.MISC[70] | ((unsigned long long)F.MISC[71] << 32);
        const unsigned long long mhz = (c1 - c0) * 100ull / (r1 - r0 + 1);
        const unsigned long long t0 = __builtin_amdgcn_s_memrealtime(), wait = mhz * 50ull;
        while (__builtin_amdgcn_s_memrealtime() - t0 < wait) __builtin_amdgcn_s_sleep(8);
    }
#endif
#undef IN
#undef SEAM
}

extern "C" void kernel_launch(void* const* d_in, const int* in_sizes, int n_in, void* d_out, int out_size, void* d_ws, size_t ws_size, hipStream_t stream) {
    static int grid = 0;
    if (grid == 0) {
        if (n_in != 21 || in_sizes[0] != NTOK_P * DM || (size_t)out_size != O_END || ws_size < WS_END) {
            fprintf(stderr, "kernel_launch: unexpected shapes: n_in %d in0 %d out %d ws %zu (need %zu)\n", n_in, n_in > 0 ? in_sizes[0] : -1, out_size, ws_size, (size_t)WS_END); grid = -1; return; }
        int dev = 0, cus = 0, per_cu = 0;
        if (hipGetDevice(&dev) != hipSuccess || hipDeviceGetAttribute(&cus, hipDeviceAttributeMultiprocessorCount, dev) != hipSuccess) { grid = -1; return; }
        if (hipFuncSetAttribute((const void*)mega_fwd, hipFuncAttributeMaxDynamicSharedMemorySize, LDS_BYTES) != hipSuccess) { fprintf(stderr, "kernel_launch: hipFuncSetAttribute failed\n"); grid = -1; return; }
        if (hipOccupancyMaxActiveBlocksPerMultiprocessor(&per_cu, (const void*)mega_fwd, NWAVES * 64, LDS_BYTES) != hipSuccess || per_cu < 1)
            fprintf(stderr, "kernel_launch: note: occupancy query reports %d workgroups per CU\n", per_cu);
        (void)hipGetLastError();
        grid = cus;
    }
    if (grid < 0) return;
    if (hipMemsetAsync((char*)d_ws + WS_CTL, 0, CTL_ZERO_BYTES, stream) != hipSuccess) return;
    Args a{};
    for (int i = 0; i < 21; ++i) a.in[i] = (const float*)d_in[i];
    a.out = (float*)d_out; a.ws = (unsigned char*)d_ws; int n_launch = 0;
#define MEGA(lo_, hi_) do { a.ph_lo = (lo_); a.ph_hi = (hi_); a.li = n_launch++; hipLaunchKernelGGL(mega_fwd, dim3(grid), dim3(NWAVES * 64), LDS_BYTES, stream, a); } while (0)
#if defined(PROBE_SUB)
    MEGA(PH_PRO, PH_MIXA + 1); MEGA(100 + PROBE_SUB, 100 + PROBE_SUB + 1); MEGA(PH_MIXA + 1, PH_N);
#elif defined(PROBE_SPLIT)
    MEGA(PH_PRO, PROBE_SPLIT + 1); MEGA(PROBE_SPLIT, PROBE_SPLIT + 1); if (PROBE_SPLIT + 1 < PH_N) MEGA(PROBE_SPLIT + 1, PH_N);
#else
    MEGA(PH_PRO, PH_N);
#endif
    const hipError_t le = hipPeekAtLastError();
    if (le != hipSuccess) fprintf(stderr, "kernel_launch: launch failed: %s\n", hipGetErrorName(le));
}
```

```cpp
#define DOWN_WGM 4
#define PG8_MMA_ORDER 7
#define UP_BAND 1
#define DOWN_BAND 1
#define DOWN_BAND16 1
#define OUT_BAND 1
#define IN_BAND 1
#define X1B_BLK 1
#include <hip/hip_runtime.h>
#include <cstdio>
#include <cstdint>
namespace pg8 {
#define PG8_LAS __attribute__((address_space(3)))
typedef unsigned short bf16_t;
typedef short bf16x8 __attribute__((ext_vector_type(8)));
typedef float f32x4 __attribute__((ext_vector_type(4)));
typedef unsigned u32x4 __attribute__((ext_vector_type(4)));
constexpr int BM = 256, BK = 64, HALF = 128, HTB = HALF * BK * 2  , STAGE_BYTES = 8 * HTB, NXCD = 8, WGM = 8;

__host__ __device__ __forceinline__ int lds_byte(int r, int c) { const int st = (r >> 4) * 2 + (c >> 5), rr = r & 15, cc = c & 31, ob = rr * 64 + cc * 2; return st * 1024 + (ob ^ (((ob >> 9) & 1) << 5)); }
__host__ __device__ __forceinline__ void stage_rc(int b, int& R, int& C) { const int st = b / 1024, sb = b % 1024, swz = sb ^ (((sb >> 9) & 1) << 5); R = (st >> 1) * 16 + swz / 64; C = (st & 1) * 32 + (swz % 64) / 2; }
__host__ __device__ __forceinline__ int perm32(int rho) { const int n = rho >> 4, i = rho & 15; return 8 * (i >> 2) + 4 * n + (i & 3); }

struct Unit { int pm, pn; };
struct Gemm { const bf16_t* A; const bf16_t* Bt; int M, N, K, ld, kstep; size_t tstep; };
__host__ __device__ __forceinline__ Gemm gemm_rm(const bf16_t* A, const bf16_t* Bt, int M, int N, int K, int Ktot) { return Gemm{A, Bt, M, N, K, Ktot, 128, (size_t)512 * Ktot}; }
__host__ __device__ __forceinline__ Gemm gemm_blk(const bf16_t* A, const bf16_t* Bt, int M, int N, int K, int Ktot) { return Gemm{A, Bt, M, N, K, 64, 32768, (size_t)512 * Ktot}; }
__host__ __device__ __forceinline__ size_t blk_off(int row, int col, int Ktot) { return ((size_t)(row >> 8) * (Ktot >> 6) + (col >> 6)) * 16384 + (size_t)(row & 255) * 64 + (col & 63); }

struct StaticOrder {
    int nM, nN, nwg, G, c, wgm = WGM;
    __host__ __device__ __forceinline__ void init(int M, int N, int G_, int c_) { nM = M / BM; nN = N / BM; nwg = nM * nN; G = G_; c = c_; }
    __host__ __device__ __forceinline__ bool next(int i, Unit& u) const {
        const long L = (long)i * G + c; if (L >= nwg) return false;
        int wgid = (int)L; { const int q = nwg / NXCD, r = nwg % NXCD, xcd = wgid % NXCD, off = wgid / NXCD; wgid = (xcd < r ? xcd * (q + 1) : r * (q + 1) + (xcd - r) * q) + off; }
        const int nig = wgm * nN, gid = wgid / nig, fm = gid * wgm, gsz = (nM - fm) < wgm ? (nM - fm) : wgm;
        u.pm = fm + ((wgid % nig) % gsz); u.pn = (wgid % nig) / gsz; return true;
    }
    __device__ __forceinline__ void a_ready(const Unit&) const {}
    __device__ __forceinline__ void done(const Unit&) const {}
};

typedef float f32x2_t __attribute__((ext_vector_type(2))); typedef __bf16 bf16x2_t __attribute__((ext_vector_type(2)));
__device__ __forceinline__ unsigned cvt_pk_bf16(float lo, float hi) { const f32x2_t v = {lo, hi}; const bf16x2_t b = __builtin_convertvector(v, bf16x2_t); return __builtin_bit_cast(unsigned, b); }
typedef unsigned u32x2 __attribute__((ext_vector_type(2)));

struct EpiProj {
    static constexpr bool PERM = true, AFTER_DRAIN = false;
    bf16_t* O; int ldc; float* dt; int dt_pn;
    __device__ __forceinline__ void operator()(const f32x4 (&acc)[2][2][4][2], const Unit& u, int wr, int wc, int fr, int fq) const {
        const int row0 = u.pm * BM + wr * 64 + fr; const int col0 = u.pn * BM + wc * 32 + 8 * fq;
#pragma unroll
        for (int ai = 0; ai < 2; ++ai)
#pragma unroll
            for (int m = 0; m < 4; ++m) { bf16_t* rowp = O + (size_t)(row0 + ai * HALF + m * 16) * ldc + col0;
#pragma unroll
                for (int bj = 0; bj < 2; ++bj) { const f32x4 v0 = acc[ai][bj][m][0], v1 = acc[ai][bj][m][1];
                    u32x4 w; w.x = cvt_pk_bf16(v0[0], v0[1]); w.y = cvt_pk_bf16(v0[2], v0[3]); w.z = cvt_pk_bf16(v1[0], v1[1]); w.w = cvt_pk_bf16(v1[2], v1[3]);
                    *(u32x4*)(rowp + bj * HALF) = w; } }
        if (u.pn == dt_pn && wc == 0) {
#pragma unroll
            for (int ai = 0; ai < 2; ++ai)
#pragma unroll
                for (int m = 0; m < 4; ++m) { float* dp = dt + (size_t)(row0 + ai * HALF + m * 16) * 32 + 8 * fq;
                    *(f32x4*)(dp) = acc[ai][0][m][0]; *(f32x4*)(dp + 4) = acc[ai][0][m][1]; }
        }
    }
};
struct EpiOut {
    static constexpr bool PERM = true, AFTER_DRAIN = false;
    const float* xp; const float* xs; float* out; bf16_t* xb; float* part; int np_rows;
    __device__ __forceinline__ void operator()(const f32x4 (&acc)[2][2][4][2], const Unit& u, int wr, int wc, int fr, int fq) const {
        const int col0 = u.pn * BM + wc * 32 + 8 * fq;
#pragma unroll
        for (int ai = 0; ai < 2; ++ai)
#pragma unroll
            for (int m = 0; m < 4; ++m) { const int row = u.pm * BM + ai * HALF + wr * 64 + m * 16 + fr;
                const float* xr = (row < np_rows) ? xp + (size_t)row * 4096 : xs + (size_t)(row - np_rows) * 4096;
                float ss = 0.f;
#pragma unroll
                for (int bj = 0; bj < 2; ++bj) { const int c = col0 + bj * HALF;
                    const f32x4 v0 = *(const f32x4*)(xr + c) + acc[ai][bj][m][0], v1 = *(const f32x4*)(xr + c + 4) + acc[ai][bj][m][1];
                    ss += ((v0[0] * v0[0] + v0[1] * v0[1]) + (v0[2] * v0[2] + v0[3] * v0[3])) + ((v1[0] * v1[0] + v1[1] * v1[1]) + (v1[2] * v1[2] + v1[3] * v1[3]));
                    u32x4 w; w.x = cvt_pk_bf16(v0[0], v0[1]); w.y = cvt_pk_bf16(v0[2], v0[3]); w.z = cvt_pk_bf16(v1[0], v1[1]); w.w = cvt_pk_bf16(v1[2], v1[3]);
#if defined(X1B_BLK)
                    *(u32x4*)(xb + blk_off(row, c, 4096)) = w; }
#else
                    *(u32x4*)(xb + (size_t)row * 4096 + c) = w; }
#endif
                ss += __shfl_xor(ss, 16); ss += __shfl_xor(ss, 32);
                if (fq == 0) part[(size_t)row * 64 + u.pn * 4 + wc] = ss; }
    }
};
struct EpiUp {
    static constexpr bool PERM = true, AFTER_DRAIN = false;
    bf16_t* O; int ldc; const float* rstd;
    __device__ __forceinline__ void operator()(const f32x4 (&acc)[2][2][4][2], const Unit& u, int wr, int wc, int fr, int fq) const {
        const int row0 = u.pm * BM + wr * 64 + fr; const int col0 = u.pn * BM + wc * 32 + 8 * fq;
#pragma unroll
        for (int ai = 0; ai < 2; ++ai)
#pragma unroll
            for (int m = 0; m < 4; ++m) { const int row = row0 + ai * HALF + m * 16; const float rs = rstd[row]; bf16_t* rowp = O + blk_off(row, col0, ldc);
#pragma unroll
                for (int bj = 0; bj < 2; ++bj) { f32x4 v0 = acc[ai][bj][m][0] * rs, v1 = acc[ai][bj][m][1] * rs;
#pragma unroll
                    for (int i = 0; i < 4; ++i) { const float a = v0[i] > 0.f ? v0[i] : 0.f, b = v1[i] > 0.f ? v1[i] : 0.f; v0[i] = a * a; v1[i] = b * b; }
                    u32x4 w; w.x = cvt_pk_bf16(v0[0], v0[1]); w.y = cvt_pk_bf16(v0[2], v0[3]); w.z = cvt_pk_bf16(v1[0], v1[1]); w.w = cvt_pk_bf16(v1[2], v1[3]);
                    *(u32x4*)(rowp + (size_t)bj * 2 * 16384) = w; } }
    }
};
struct EpiDown {
    static constexpr bool PERM = true, AFTER_DRAIN = false;
    float* out; const bf16_t* xb;
    __device__ __forceinline__ void operator()(const f32x4 (&acc)[2][2][4][2], const Unit& u, int wr, int wc, int fr, int fq) const {
        const int col0 = u.pn * BM + wc * 32 + 8 * fq;
#pragma unroll
        for (int ai = 0; ai < 2; ++ai)
#pragma unroll
            for (int m = 0; m < 4; ++m) { const size_t ro = (size_t)(u.pm * BM + ai * HALF + wr * 64 + m * 16 + fr) * 4096 + col0;
#pragma unroll
#if defined(X1B_BLK)
                for (int bj = 0; bj < 2; ++bj) { const u32x4 w = *(const u32x4*)(xb + blk_off(u.pm * BM + ai * HALF + wr * 64 + m * 16 + fr, col0 + bj * HALF, 4096));
#else
                for (int bj = 0; bj < 2; ++bj) { const u32x4 w = *(const u32x4*)(xb + ro + bj * HALF);
#endif
                    const f32x4 r0 = {__builtin_bit_cast(float, w.x << 16), __builtin_bit_cast(float, w.x & 0xffff0000u), __builtin_bit_cast(float, w.y << 16), __builtin_bit_cast(float, w.y & 0xffff0000u)};
                    const f32x4 r1 = {__builtin_bit_cast(float, w.z << 16), __builtin_bit_cast(float, w.z & 0xffff0000u), __builtin_bit_cast(float, w.w << 16), __builtin_bit_cast(float, w.w & 0xffff0000u)};
                    *(f32x4*)(out + ro + bj * HALF) = r0 + acc[ai][bj][m][0]; *(f32x4*)(out + ro + bj * HALF + 4) = r1 + acc[ai][bj][m][1]; } }
    }
};

struct EpiPart {
    static constexpr bool PERM = true, AFTER_DRAIN = false;
    bf16_t* slab;
    __device__ __forceinline__ void operator()(const f32x4 (&acc)[2][2][4][2], const Unit& u, int wr, int wc, int fr, int fq) const {
        const int col0 = wc * 32 + 8 * fq;
#pragma unroll
        for (int ai = 0; ai < 2; ++ai)
#pragma unroll
            for (int m = 0; m < 4; ++m) { bf16_t* rowp = slab + (size_t)(ai * HALF + wr * 64 + m * 16 + fr) * 256 + col0;
#pragma unroll
                for (int bj = 0; bj < 2; ++bj) { const f32x4 v0 = acc[ai][bj][m][0], v1 = acc[ai][bj][m][1];
                    u32x4 w; w.x = cvt_pk_bf16(v0[0], v0[1]); w.y = cvt_pk_bf16(v0[2], v0[3]); w.z = cvt_pk_bf16(v1[0], v1[1]); w.w = cvt_pk_bf16(v1[2], v1[3]);
                    *(u32x4*)(rowp + bj * HALF) = w; } }
    }
};
struct HeadOrder : StaticOrder { int nr; __device__ __forceinline__ bool next(int i, Unit& u) const { return i < nr && StaticOrder::next(i, u); } };
struct TailOrder : StaticOrder { int round; __device__ __forceinline__ bool next(int i, Unit& u) const { return i == 0 && StaticOrder::next(round, u); } };

struct PanelTail { int pm, pn; __device__ __forceinline__ bool next(int i, Unit& u) const { if (i) return false; u.pm = pm; u.pn = pn; return true; }
    __device__ __forceinline__ void a_ready(const Unit&) const {} __device__ __forceinline__ void done(const Unit&) const {} };
#if defined(PROBE_SHADOW_UP)
struct ShEpi { static constexpr bool PERM = true, AFTER_DRAIN = false; EpiUp e;
    __device__ __forceinline__ void operator()(const f32x4 (&acc)[2][2][4][2], const Unit& u, int wr, int wc, int fr, int fq) const { Unit z; z.pm = PROBE_SHADOW_UP == 2 ? 0 : u.pm; z.pn = PROBE_SHADOW_UP == 2 ? 0 : u.pn; e(acc, z, wr, wc, fr, fq); } };
#endif
#if defined(PROBE_SHADOW_DOWN)
struct ShEpiD { static constexpr bool PERM = false, AFTER_DRAIN = false; EpiDown e;
    __device__ __forceinline__ void operator()(const f32x4 (&acc)[2][2][4][2], const Unit& u, int wr, int wc, int fr, int fq) const { Unit z; z.pm = 0; z.pn = 0; e(acc, z, wr, wc, fr, fq); } };
#endif
struct RangeOrder : StaticOrder { int r0, r1; __device__ __forceinline__ bool next(int i, Unit& u) const { return (i + r0) < r1 && StaticOrder::next(i + r0, u); } };
struct BandOrder {
    int nN8, c; bool tail = true;
    __device__ __forceinline__ void init(int N, int c_) { nN8 = N / BM / 8; c = c_; }
    __device__ __forceinline__ bool next(int i, Unit& u) const {
        const int x = c & 7, j = c >> 3;
        if (i < 2 * nN8) { const int band = i / nN8, cr_ = i - band * nN8, cr = band ? nN8 - 1 - cr_ : cr_;
            u.pm = band * 32 + 4 * x + (j & 3); u.pn = cr * 8 + (j >> 2); return true; }
        const int k = i - 2 * nN8; if (!tail || k >= nN8 / 8 + (nN8 % 8 != 0)) return false;
        const int col = (k * 8 + x) * 8 + (j >> 2); if (col >= nN8 * 8) return false;
        u.pm = 64 + (j & 3); u.pn = col; return true;
    }
    __device__ __forceinline__ void a_ready(const Unit&) const {} __device__ __forceinline__ void done(const Unit&) const {}
};
struct BandIn {
    int c, r0, r1;
    __device__ __forceinline__ bool next(int i_, Unit& u) const {
        const int i = i_ + r0; if (i >= r1) return false;
        const int x = c & 7, j = c >> 3;
        if (i < 8) { const int band = i >> 2, cr = band ? 3 - (i & 3) : (i & 3); u.pm = band * 32 + 4 * x + (j & 3); u.pn = cr * 8 + (j >> 2); return true; }
        if (i == 8) { u.pm = 8 * x + (j & 7); u.pn = 32 + (j >> 3); return true; }
        if (i == 9) { if (c < 64) { u.pm = c; u.pn = 36; return true; } const int k = c - 64; if (k >= 148) return false; u.pm = 64 + (k & 3); u.pn = k >> 2; return true; }
        return false;
    }
    __device__ __forceinline__ void a_ready(const Unit&) const {} __device__ __forceinline__ void done(const Unit&) const {}
};
struct BandDown {
    int c;
    __device__ __forceinline__ bool next(int i, Unit& u) const {
        if (i >= 4) return false;
        const int x = c & 7, j = c >> 3;
        u.pm = 16 * i + 4 * (x >> 1) + (j & 3); u.pn = 8 * (x & 1) + (j >> 2); return true;
    }
    __device__ __forceinline__ void a_ready(const Unit&) const {} __device__ __forceinline__ void done(const Unit&) const {}
};

template <class Epi, class Sched, bool ALIGN_EPI = false, bool SP2 = false>
__device__ __forceinline__ void gemm_phase(PG8_LAS unsigned char* lds, const Gemm g, const Sched& S, const Epi& E) {
    int tid_ = threadIdx.x; asm volatile("" : "+v"(tid_));
    const int tid = tid_, wid = __builtin_amdgcn_readfirstlane(tid >> 6), lane = tid & 63, wr = wid >> 2, wc = wid & 3, fr = lane & 15, fq = lane >> 4;
    const int K = g.K, nt = K / BK, LD = g.ld;
    unsigned voffA[2], voffB[2];
#pragma unroll
    for (int i = 0; i < 2; ++i) { int R, C; stage_rc(tid * 16 + i * 8192, R, C); const int Rb = Epi::PERM ? ((R & ~31) + perm32(R & 31)) : R;
        voffA[i] = (unsigned)(R * LD + C) * 2u; voffB[i] = (unsigned)(Rb * LD + C) * 2u; }
    const size_t kstep = (size_t)g.kstep;
    const size_t hstep = (size_t)HALF * LD * 2;
    const size_t tstep = g.tstep;
    const unsigned ldsw = (unsigned)wid * 1024u;
    const int aoff = lds_byte(wr * 64 + fr, fq * 8), boff = lds_byte(wc * 32 + fr, fq * 8);
#define PG8_SA(b, h) (((b) * 2 + (h)) * HTB)
#define PG8_SB(b, h) ((4 + (b) * 2 + (h)) * HTB)
#define PG8_STAGE(bufoff, gbase, voff) do { _Pragma("unroll") for (int _i = 0; _i < 2; ++_i) \
        __builtin_amdgcn_global_load_lds((const unsigned*)((const char*)(gbase) + (voff)[_i]), (PG8_LAS unsigned*)(lds + (bufoff) + ldsw + _i * 8192), 16, 0, 0); } while (0)
#define PG8_LDA(dst, b, h) do { _Pragma("unroll") for (int m = 0; m < 4; ++m) _Pragma("unroll") for (int k = 0; k < 2; ++k) dst[m][k] = *(const PG8_LAS bf16x8*)(lds + PG8_SA(b, h) + aoff + m * 2048 + k * 1024); } while (0)
#define PG8_LDB(dst, b, h) do { _Pragma("unroll") for (int n = 0; n < 2; ++n) _Pragma("unroll") for (int k = 0; k < 2; ++k) dst[n][k] = *(const PG8_LAS bf16x8*)(lds + PG8_SB(b, h) + boff + n * 2048 + k * 1024); } while (0)
#ifndef PG8_MMA_ORDER
#define PG8_MMA_ORDER 0
#endif
#if PG8_MMA_ORDER == 0
#define PG8_MMA(ai, bj, At, Bt) do { __builtin_amdgcn_s_setprio(1); _Pragma("unroll") for (int m = 0; m < 4; ++m) _Pragma("unroll") for (int n = 0; n < 2; ++n) _Pragma("unroll") for (int k = 0; k < 2; ++k) \
        acc[ai][bj][m][n] = __builtin_amdgcn_mfma_f32_16x16x32_bf16(Bt[n][k], At[m][k], acc[ai][bj][m][n], 0, 0, 0); __builtin_amdgcn_s_setprio(0); } while (0)
#elif PG8_MMA_ORDER == 1
#define PG8_MMA(ai, bj, At, Bt) do { __builtin_amdgcn_s_setprio(1); _Pragma("unroll") for (int k = 0; k < 2; ++k) _Pragma("unroll") for (int m = 0; m < 4; ++m) _Pragma("unroll") for (int n = 0; n < 2; ++n) \
        acc[ai][bj][m][n] = __builtin_amdgcn_mfma_f32_16x16x32_bf16(Bt[n][k], At[m][k], acc[ai][bj][m][n], 0, 0, 0); __builtin_amdgcn_s_setprio(0); } while (0)
#elif PG8_MMA_ORDER == 3
#define PG8_MMA(ai, bj, At, Bt) do { __builtin_amdgcn_s_setprio(1); _Pragma("unroll") for (int m = 0; m < 4; ++m) _Pragma("unroll") for (int n_ = 0; n_ < 2; ++n_) _Pragma("unroll") for (int k_ = 0; k_ < 2; ++k_) { \
        const int n = (m & 1) ? 1 - n_ : n_, k = (n_ & 1) ? 1 - k_ : k_; \
        acc[ai][bj][m][n] = __builtin_amdgcn_mfma_f32_16x16x32_bf16(Bt[n][k], At[m][k], acc[ai][bj][m][n], 0, 0, 0); } __builtin_amdgcn_s_setprio(0); } while (0)
#elif PG8_MMA_ORDER == 4
#define PG8_MMA(ai, bj, At, Bt) do { __builtin_amdgcn_s_setprio(1); _Pragma("unroll") for (int m = 0; m < 4; ++m) _Pragma("unroll") for (int n = 0; n < 2; ++n) { _Pragma("unroll") for (int k = 0; k < 2; ++k) \
        acc[ai][bj][m][n] = __builtin_amdgcn_mfma_f32_16x16x32_bf16(Bt[n][k], At[m][k], acc[ai][bj][m][n], 0, 0, 0); __builtin_amdgcn_sched_barrier(0); } __builtin_amdgcn_s_setprio(0); } while (0)
#elif PG8_MMA_ORDER == 5 || PG8_MMA_ORDER == 7
#define PG8_MMA(ai, bj, At, Bt) do { __builtin_amdgcn_s_setprio(1); _Pragma("unroll") for (int m = 0; m < 4; ++m) _Pragma("unroll") for (int n_ = 0; n_ < 2; ++n_) _Pragma("unroll") for (int k_ = 0; k_ < 2; ++k_) { \
        const int n = (m & 1) ? 1 - n_ : n_, k = (n_ & 1) ? 1 - k_ : k_; \
        acc[ai][bj][m][n] = __builtin_amdgcn_mfma_f32_16x16x32_bf16(Bt[n][k], At[m][k], acc[ai][bj][m][n], 0, 0, 0); __builtin_amdgcn_sched_barrier(0); } __builtin_amdgcn_s_setprio(0); } while (0)
#else
#define PG8_MMA(ai, bj, At, Bt) do { __builtin_amdgcn_s_setprio(1); _Pragma("unroll") for (int k = 0; k < 2; ++k) _Pragma("unroll") for (int n = 0; n < 2; ++n) _Pragma("unroll") for (int m = 0; m < 4; ++m) \
        acc[ai][bj][m][n] = __builtin_amdgcn_mfma_f32_16x16x32_bf16(Bt[n][k], At[m][k], acc[ai][bj][m][n], 0, 0, 0); __builtin_amdgcn_s_setprio(0); } while (0)
#endif
#if PG8_MMA_ORDER == 7
#define PG8_MMA2(ai, At, Ba, Bb) do { __builtin_amdgcn_s_setprio(1); _Pragma("unroll") for (int m = 0; m < 4; ++m) _Pragma("unroll") for (int q_ = 0; q_ < 4; ++q_) _Pragma("unroll") for (int k_ = 0; k_ < 2; ++k_) { \
        const int q = (m & 1) ? 3 - q_ : q_, bj = q >> 1, n = q & 1, k = (q_ & 1) ? 1 - k_ : k_; \
        acc[ai][bj][m][n] = __builtin_amdgcn_mfma_f32_16x16x32_bf16(bj ? Bb[n][k] : Ba[n][k], At[m][k], acc[ai][bj][m][n], 0, 0, 0); __builtin_amdgcn_sched_barrier(0); } __builtin_amdgcn_s_setprio(0); } while (0)
#else
#define PG8_MMA2(ai, At, Ba, Bb) do { PG8_MMA(ai, 0, At, Ba); PG8_MMA(ai, 1, At, Bb); } while (0)
#endif
#define PG8_WAIT_V(n) asm volatile("s_waitcnt vmcnt(" #n ")" ::: "memory")
#define PG8_WAIT_L(n) asm volatile("s_waitcnt lgkmcnt(" #n ")" ::: "memory")
#define PG8_BAR __builtin_amdgcn_s_barrier()
#define PG8_SCHED __builtin_amdgcn_sched_barrier(0)
    Unit cur, nxt; int ui = 0;
    if (!S.next(0, cur)) return;
    f32x4 acc[2][2][4][2];
#pragma unroll
    for (int a = 0; a < 2; ++a)
#pragma unroll
        for (int b = 0; b < 2; ++b)
#pragma unroll
            for (int m = 0; m < 4; ++m)
#pragma unroll
                for (int n = 0; n < 2; ++n) acc[a][b][m][n] = (f32x4){0.f, 0.f, 0.f, 0.f};
    bf16x8 At[4][2], B0[2][2], B1[2][2];
    const char* cA = (const char*)g.A + (size_t)cur.pm * tstep; const char* cB = (const char*)g.Bt + (size_t)cur.pn * tstep;
    S.a_ready(cur);
    if constexpr (SP2) {
        PG8_STAGE(PG8_SB(0, 0), cB, voffB); PG8_STAGE(PG8_SB(0, 1), cB + hstep, voffB); PG8_STAGE(PG8_SA(0, 0), cA, voffA); PG8_STAGE(PG8_SA(0, 1), cA + hstep, voffA);
        if (wr == 1) PG8_BAR;
        PG8_WAIT_V(2); PG8_BAR;
        PG8_STAGE(PG8_SB(1, 0), cB + kstep, voffB); PG8_STAGE(PG8_SA(1, 0), cA + kstep, voffA); PG8_STAGE(PG8_SB(1, 1), cB + hstep + kstep, voffB);
        PG8_WAIT_V(6); PG8_BAR;
    } else {
        PG8_STAGE(PG8_SB(0, 0), cB, voffB); PG8_STAGE(PG8_SA(0, 0), cA, voffA); PG8_STAGE(PG8_SB(0, 1), cB + hstep, voffB); PG8_STAGE(PG8_SA(0, 1), cA + hstep, voffA);
        if (wr == 1) PG8_BAR;
        PG8_WAIT_V(4); PG8_BAR;
        PG8_STAGE(PG8_SB(1, 0), cB + kstep, voffB); PG8_STAGE(PG8_SA(1, 0), cA + kstep, voffA); PG8_STAGE(PG8_SB(1, 1), cB + hstep + kstep, voffB);
        PG8_WAIT_V(6); PG8_BAR;
    }
#if defined(PROBE_BND)
#define PB_STAMP(j) do { if (blockIdx.x == 0 && wid == 0 && *(volatile PG8_LAS unsigned*)(lds + PROBE_BND_OFF + 32) != 0u) { const unsigned c_ = (unsigned)__builtin_amdgcn_s_memtime(); \
        if (lane == 0) *(volatile PG8_LAS unsigned*)(lds + PROBE_BND_OFF + 128 + (ui * 3 + (j)) * 4) = c_; } } while (0)
#endif
    for (;;) {
        const bool has_next = S.next(ui + 1, nxt);
        const char* nA = has_next ? (const char*)g.A + (size_t)nxt.pm * tstep : cA; const char* nB = has_next ? (const char*)g.Bt + (size_t)nxt.pn * tstep : cB;
        for (int t = 0; t < nt; t += 2) {
            const bool last = (t == nt - 2);
            const char* a1 = cA + (size_t)(t + 1) * kstep;
            const char* a2 = last ? nA : cA + (size_t)(t + 2) * kstep; const char* b2 = last ? nB : cB + (size_t)(t + 2) * kstep;
            const char* a3 = a2 + kstep; const char* b3 = b2 + kstep;
            if (last && has_next) S.a_ready(nxt);
            if constexpr (SP2) {
            PG8_LDB(B0, 0, 0); PG8_LDB(B1, 0, 1); PG8_SCHED; PG8_LDA(At, 0, 0); PG8_STAGE(PG8_SA(1, 1), a1 + hstep, voffA);
            PG8_WAIT_V(8); PG8_WAIT_L(0); PG8_BAR; PG8_MMA2(0, At, B0, B1); PG8_BAR; PG8_SCHED;
            PG8_LDA(At, 0, 1); PG8_STAGE(PG8_SB(0, 0), b2, voffB); PG8_STAGE(PG8_SB(0, 1), b2 + hstep, voffB); PG8_STAGE(PG8_SA(0, 0), a2, voffA);
            PG8_WAIT_V(8); PG8_WAIT_L(0); PG8_BAR; PG8_MMA2(1, At, B0, B1); PG8_BAR; PG8_SCHED;
            PG8_LDB(B0, 1, 0); PG8_LDB(B1, 1, 1); PG8_SCHED; PG8_LDA(At, 1, 0); PG8_STAGE(PG8_SA(0, 1), a2 + hstep, voffA);
            PG8_WAIT_V(8); PG8_WAIT_L(0); PG8_BAR; PG8_MMA2(0, At, B0, B1); PG8_BAR; PG8_SCHED;
            PG8_LDA(At, 1, 1); PG8_STAGE(PG8_SB(1, 0), b3, voffB); PG8_STAGE(PG8_SB(1, 1), b3 + hstep, voffB); PG8_STAGE(PG8_SA(1, 0), a3, voffA);
            PG8_WAIT_V(8); PG8_WAIT_L(0); PG8_BAR; PG8_MMA2(1, At, B0, B1); PG8_BAR; PG8_SCHED;
            } else {
            PG8_LDB(B0, 0, 0); PG8_SCHED; PG8_LDA(At, 0, 0); PG8_STAGE(PG8_SA(1, 1), a1 + hstep, voffA);
            PG8_WAIT_L(8); PG8_BAR; PG8_WAIT_L(0); PG8_MMA(0, 0, At, B0); PG8_BAR; PG8_SCHED;
            PG8_LDB(B1, 0, 1); PG8_STAGE(PG8_SB(0, 0), b2, voffB);
            PG8_BAR; PG8_WAIT_L(0); PG8_MMA(0, 1, At, B1); PG8_BAR;
            PG8_LDA(At, 0, 1); PG8_STAGE(PG8_SA(0, 0), a2, voffA);
            PG8_BAR; PG8_WAIT_L(0); PG8_MMA(1, 0, At, B0); PG8_BAR; PG8_SCHED;
            PG8_STAGE(PG8_SB(0, 1), b2 + hstep, voffB);
            PG8_WAIT_V(6); PG8_BAR; PG8_MMA(1, 1, At, B1); PG8_BAR;
            PG8_LDB(B0, 1, 0); PG8_SCHED; PG8_LDA(At, 1, 0); PG8_STAGE(PG8_SA(0, 1), a2 + hstep, voffA);
            PG8_WAIT_L(8); PG8_BAR; PG8_WAIT_L(0); PG8_MMA(0, 0, At, B0); PG8_BAR; PG8_SCHED;
            PG8_LDB(B1, 1, 1); PG8_STAGE(PG8_SB(1, 0), b3, voffB);
            PG8_BAR; PG8_WAIT_L(0); PG8_MMA(0, 1, At, B1); PG8_BAR;
            PG8_LDA(At, 1, 1); PG8_STAGE(PG8_SA(1, 0), a3, voffA);
            PG8_BAR; PG8_WAIT_L(0); PG8_MMA(1, 0, At, B0); PG8_BAR; PG8_SCHED;
            PG8_STAGE(PG8_SB(1, 1), b3 + hstep, voffB);
            PG8_WAIT_V(6); PG8_BAR; PG8_MMA(1, 1, At, B1); PG8_BAR;
            }
#if defined(PROBE_BND)
            if (t == 0) PB_STAMP(0); else if (t == 2) PB_STAMP(1);
#endif
        }
#if defined(PROBE_BND)
        PB_STAMP(2);
#endif
        if constexpr (ALIGN_EPI) { if (wr == 0) PG8_BAR; }
        if constexpr (!Epi::AFTER_DRAIN) { E(acc, cur, wr, wc, fr, fq); S.done(cur); }
        if (!has_next) break;
#pragma unroll
        for (int a = 0; a < 2; ++a)
#pragma unroll
            for (int b = 0; b < 2; ++b)
#pragma unroll
                for (int m = 0; m < 4; ++m)
#pragma unroll
                    for (int n = 0; n < 2; ++n) acc[a][b][m][n] = (f32x4){0.f, 0.f, 0.f, 0.f};
        cur = nxt; cA = nA; cB = nB; ++ui;
        if constexpr (ALIGN_EPI) { if (wr == 1) PG8_BAR; }
    }
    PG8_WAIT_V(0);
    if constexpr (!ALIGN_EPI) { if (wr == 0) PG8_BAR; }
    PG8_BAR;
    if constexpr (Epi::AFTER_DRAIN) { E.fused(acc, cur, wr, wc, fr, fq, lds, wid, lane); S.done(cur); }
#undef PG8_SA
#undef PG8_SB
#undef PG8_STAGE
#undef PG8_LDA
#undef PG8_LDB
#undef PG8_MMA
#undef PG8_WAIT_V
#undef PG8_WAIT_L
#undef PG8_BAR
#undef PG8_SCHED
}
}
#ifndef PG8_SP2
#define PG8_SP2 true
#endif
#ifndef PG8_ALIGN
#define PG8_ALIGN true
#endif
constexpr int NWAVES = 8;
constexpr int DM = 4096, SEQ = 8192, NB_P = 2, NB_S = 32, DSEQ = 32, PAST = 1024;
constexpr int NTOK_P = NB_P * SEQ, NTOK_S = NB_S * DSEQ, M = NTOK_P + NTOK_S;
constexpr int NPROJ = 9248, LDP = 9472;
constexpr int OFF_Q = 0, OFF_K = 2048, OFF_V = 2560, OFF_XS = 3072, OFF_Z = 5120, OFF_B = 7168, OFF_C = 8192, OFF_DT = 9216;
constexpr int FF = 16384;
constexpr float RMS_EPS = 1e-6f;
constexpr size_t O_Y = 0, O_KP = (size_t)M * DM, O_VP = O_KP + 131072, O_CP = O_VP + 131072, O_SP = O_CP + 24576, O_KS = O_SP + 524288, O_VS = O_KS + 2097152,
                 O_CS = O_VS + 2097152, O_SS = O_CS + 393216, O_END = O_SS + 8388608;
constexpr size_t MiB = 1u << 20;
constexpr size_t WS_CTL = 0, CTL_ZERO_BYTES = 64 * 1024;
constexpr size_t WS_ROPE = 1 * MiB;
constexpr size_t WS_DT = 2 * MiB;
constexpr size_t WS_PART = 5 * MiB;
constexpr size_t WS_RSTD = 10 * MiB;
constexpr size_t WS_DECAY = 11 * MiB;
constexpr size_t WS_WUP = 16 * MiB;
constexpr size_t WS_WDN = 144 * MiB;
constexpr size_t WS_X1B = 272 * MiB;
constexpr size_t WS_WOUT = 408 * MiB;
constexpr size_t WS_U = 440 * MiB;
constexpr size_t WS_WIN = 440 * MiB;
constexpr size_t WS_H = 514 * MiB;
constexpr size_t WS_PROJ = 650 * MiB;
constexpr size_t WS_KN = 984 * MiB;
constexpr size_t WS_END = 1020 * MiB;
static_assert(WS_PROJ + (size_t)M * LDP * 2 <= WS_KN && WS_U + (size_t)M * FF * 2 <= WS_KN && WS_WIN + (size_t)LDP * DM * 2 <= WS_H && WS_H + (size_t)M * DM * 2 <= WS_PROJ, "ws map");
static_assert(WS_X1B + (size_t)M * DM * 2 <= WS_WOUT && WS_DT + (size_t)M * 32 * 4 <= WS_PART && WS_PART + (size_t)M * 64 * 4 <= WS_RSTD, "ws map 2");
constexpr int CW_TMO = 0, CW_CODE = 1, CW_BAR = 4096;
static_assert((CW_BAR + 3 * 3456) * 4 <= (int)CTL_ZERO_BYTES, "barrier regions inside the per-call memset");

constexpr int RING_OFF = 0, RING_BYTES = 133120;
constexpr int LDSCTL_OFF = RING_BYTES, MISC_OFF = LDSCTL_OFF + 320;
constexpr int LDS_BYTES = 147456;
static_assert(MISC_OFF + 128 <= LDS_BYTES, "LDS map");

#define GAS __attribute__((address_space(1)))
#define LAS __attribute__((address_space(3)))
typedef unsigned short bf16;
typedef unsigned v4u __attribute__((ext_vector_type(4)));
typedef unsigned v2u __attribute__((ext_vector_type(2)));
typedef float f32x4 __attribute__((ext_vector_type(4)));
typedef short bf16x8 __attribute__((ext_vector_type(8)));
typedef GAS unsigned gu32;
#define RLX_AGENT __ATOMIC_RELAXED, __HIP_MEMORY_SCOPE_AGENT
#define LDS_WAIT() asm volatile("s_waitcnt lgkmcnt(0)" ::: "memory")
#define VM_WAIT() asm volatile("s_waitcnt vmcnt(0)" ::: "memory")
__device__ __forceinline__ unsigned f2bf(float f) { unsigned u = __builtin_bit_cast(unsigned, f); return (u + 0x7fffu + ((u >> 16) & 1u)) >> 16; }
typedef float f32x2_g __attribute__((ext_vector_type(2))); typedef __bf16 bf16x2_g __attribute__((ext_vector_type(2)));
__device__ __forceinline__ unsigned pk2(float lo, float hi) { const f32x2_g v = {lo, hi}; const bf16x2_g b = __builtin_convertvector(v, bf16x2_g); return __builtin_bit_cast(unsigned, b); }
__device__ __forceinline__ float bf2f(unsigned short b) { return __builtin_bit_cast(float, (unsigned)b << 16); }
__device__ __forceinline__ float bflo(unsigned w) { return __builtin_bit_cast(float, w << 16); }
__device__ __forceinline__ float bfhi(unsigned w) { return __builtin_bit_cast(float, w & 0xffff0000u); }
__device__ __forceinline__ float silu_f(float v) { return v * __builtin_amdgcn_rcpf(1.f + __expf(-v)); }
__device__ __forceinline__ float softplus_f(float v) { return v > 20.f ? v : log1pf(__expf(v)); }

#define XB_TMO      128
#define XB_XCNT(j)  (256  + 64 * (j))
#define XB_XSUB(j)  (1280 + 64 * (j))
#define XB_XGEN(j)  (2304 + 64 * (j))
#define XB_TOP      3328
#define XB_TOPGEN   3392
#define XCD_BAR_WORDS 3456
#define XB_SPIN_CAP (1u << 18)

__device__ __forceinline__ unsigned xb_ld(unsigned* p)              { return __hip_atomic_load(p, __ATOMIC_RELAXED, __HIP_MEMORY_SCOPE_AGENT); }
__device__ __forceinline__ unsigned xb_add(unsigned* p, unsigned v) { return __hip_atomic_fetch_add(p, v, __ATOMIC_RELAXED, __HIP_MEMORY_SCOPE_AGENT); }
__device__ __forceinline__ unsigned xb_xcc_id() { return (unsigned)__builtin_amdgcn_s_getreg((3 << 11) | 20) & 0xFu; }
#define XB_SPIN(cond, bar) do { unsigned _sp = 0; while (cond) { __builtin_amdgcn_s_sleep(1); \
    if ((++_sp & 255u) == 0u) { if (xb_ld(&(bar)[XB_TMO])) break; if (_sp > XB_SPIN_CAP) { atomicAdd(&(bar)[XB_TMO], 1u); break; } } } } while (0)

struct XcdBarrier {
    unsigned* bar; unsigned x;
    volatile LAS unsigned* st;
};

__device__ __forceinline__ XcdBarrier xcd_barrier_post(unsigned* bar, volatile LAS unsigned* st) {
    XcdBarrier b; b.bar = bar; b.x = xb_xcc_id(); b.st = st;
    if (threadIdx.x == 0) (void)xb_add(&bar[XB_XCNT(b.x)], 1u);
    return b;
}
__device__ __forceinline__ void xcd_barrier_complete(unsigned* bar, unsigned x, unsigned& nloc, unsigned& nx) {
    const unsigned G = gridDim.x * gridDim.y * gridDim.z;
    unsigned sum, cnt, mine, sp = 0u;
    for (;;) {
        sum = 0u; cnt = 0u; mine = 0u;
#pragma unroll
        for (unsigned j = 0; j < 16; ++j) { const unsigned c = xb_ld(&bar[XB_XCNT(j)]); sum += c; cnt += (c > 0u) ? 1u : 0u; mine = (j == x) ? c : mine; }
        if (sum == G) break;
        __builtin_amdgcn_s_sleep(1);
        if ((++sp & 255u) == 0u) { if (xb_ld(&bar[XB_TMO])) break; if (sp > XB_SPIN_CAP) { atomicAdd(&bar[XB_TMO], 1u); break; } }
    }
    nloc = mine > 0u ? mine : 1u; nx = cnt > 0u ? cnt : 1u;
}

__device__ __forceinline__ void xcd_barrier(const XcdBarrier& b) {
    asm volatile("s_waitcnt vmcnt(0)" ::: "memory");
    __syncthreads();
    if (threadIdx.x == 0) {
        unsigned* bar = b.bar;
        __builtin_amdgcn_s_waitcnt(0);
        unsigned nloc = b.st[0], nx = b.st[1];
        if (nloc == 0u) { xcd_barrier_complete(bar, b.x, nloc, nx); b.st[0] = nloc; b.st[1] = nx; }
        const unsigned old = xb_add(&bar[XB_XSUB(b.x)], 1u);
        const unsigned gen = old / nloc;
        if (old + 1u == (gen + 1u) * nloc) {
            __builtin_amdgcn_fence(__ATOMIC_RELEASE, "agent");
            asm volatile("s_waitcnt vmcnt(0)" ::: "memory");
            const unsigned og = xb_add(&bar[XB_TOP], 1u);
            const unsigned tg = og / nx;
            if (og + 1u == (tg + 1u) * nx) xb_add(&bar[XB_TOPGEN], 1u);
            else XB_SPIN(xb_ld(&bar[XB_TOPGEN]) == tg, bar);
            __builtin_amdgcn_fence(__ATOMIC_ACQUIRE, "agent");
            xb_add(&bar[XB_XGEN(b.x)], 1u);
            asm volatile("s_waitcnt vmcnt(0)" ::: "memory");
        } else {
            XB_SPIN(xb_ld(&bar[XB_XGEN(b.x)]) == gen, bar);
            __builtin_amdgcn_fence(__ATOMIC_ACQUIRE, "agent");
            asm volatile("s_waitcnt vmcnt(0)" ::: "memory");
        }
    }
    __syncthreads();
}

struct Args {
    const float* in[21]; float* out; unsigned char* ws; int ph_lo, ph_hi, li, pad;
};
enum { IN_XP = 0, IN_XS, IN_CK, IN_CV, IN_SCONV, IN_SSSM, IN_NMIX, IN_WIN, IN_QNW, IN_KNW, IN_SINK, IN_CONVW, IN_CONVB, IN_DTB, IN_ALOG, IN_DSKIP, IN_SNW, IN_WOUT, IN_NFFN, IN_WUP, IN_WDN };
enum { PH_PRO = 0, PH_INPROJ = 1, PH_MIXA = 2, PH_MIXB = 3, PH_MIXC = 4, PH_OUT = 5, PH_RSTD = 6, PH_UP = 7, PH_DOWN = 8, PH_DOWN2 = 9, PH_N = 10 };

struct Frame {
    LAS unsigned char* lds;
    volatile LAS unsigned* MISC;
    gu32* ctl;
    int tid, lane, wave;
    int vcu, G;
};
__device__ __forceinline__ float wave_sum(float v) {
#pragma unroll
    for (int o = 1; o < 64; o <<= 1) v += __shfl_xor(v, o);
    return v;
}
struct TItem { const float* W; bf16* WT; const float* kscale; int K, N, k0, n0, ncols, blocked; };
constexpr int T_NB_IN = (NPROJ + 63) / 64;
constexpr int T_I_IN = (DM / 64) * T_NB_IN, T_I_OUT = (DM / 64) * (DM / 64), T_I_UP = (DM / 64) * (FF / 64), T_I_DN = (FF / 64) * (DM / 64);
constexpr int T_NITEMS = T_I_IN + T_I_OUT + T_I_UP + T_I_DN;
__device__ __forceinline__ TItem p0_item(const Args& A, int it) {
    unsigned char* ws = A.ws;
    constexpr int NB_IN = T_NB_IN;
    constexpr int I_IN = T_I_IN, I_OUT = T_I_OUT, I_UP = T_I_UP;
    TItem t; int r = it;
    if (r < I_IN) { const int kb = r / NB_IN, nb = r % NB_IN; t = TItem{A.in[IN_WIN], (bf16*)(ws + WS_WIN), nullptr, DM, NPROJ, 64 * kb, 64 * nb, (nb == NB_IN - 1) ? NPROJ - 64 * (NB_IN - 1) : 64, 0}; return t; } r -= I_IN;
    if (r < I_OUT) { t = TItem{A.in[IN_WOUT], (bf16*)(ws + WS_WOUT), nullptr, DM, DM, 64 * (r / (DM / 64)), 64 * (r % (DM / 64)), 64, 0}; return t; } r -= I_OUT;
#if defined(X1B_BLK)
    if (r < I_UP) { t = TItem{A.in[IN_WUP], (bf16*)(ws + WS_WUP), A.in[IN_NFFN], DM, FF, 64 * (r / (FF / 64)), 64 * (r % (FF / 64)), 64, 1}; return t; } r -= I_UP;
#else
    if (r < I_UP) { t = TItem{A.in[IN_WUP], (bf16*)(ws + WS_WUP), A.in[IN_NFFN], DM, FF, 64 * (r / (FF / 64)), 64 * (r % (FF / 64)), 64, 0}; return t; } r -= I_UP;
#endif
    t = TItem{A.in[IN_WDN], (bf16*)(ws + WS_WDN), nullptr, FF, DM, 64 * (r / (DM / 64)), 64 * (r % (DM / 64)), 64, 1}; return t;
}
__device__ __forceinline__ void p0_tload(const TItem& t, int lane, f32x4 (&v)[16]) {
    const int kr = lane >> 4, c4 = (lane & 15) * 4; const bool lok = c4 < t.ncols;
#pragma unroll
    for (int i = 0; i < 16; ++i) v[i] = lok ? __builtin_nontemporal_load((const GAS f32x4*)(t.W + (size_t)(t.k0 + 4 * i + kr) * t.N + t.n0 + c4)) : (f32x4){0.f, 0.f, 0.f, 0.f};
}
__device__ __forceinline__ void p0_tstore(const TItem& t, int lane, LAS float* scr, f32x4 (&v)[16]) {
    const int kr = lane >> 4, c4 = (lane & 15) * 4;
    if (t.kscale) {
#pragma unroll
        for (int i = 0; i < 16; ++i) v[i] = v[i] * t.kscale[t.k0 + 4 * i + kr]; }
#pragma unroll
    for (int i = 0; i < 16; ++i) { LAS float* d = scr + (4 * i + kr) * 65 + c4; d[0] = v[i][0]; d[1] = v[i][1]; d[2] = v[i][2]; d[3] = v[i][3]; }
    LDS_WAIT(); asm volatile("" ::: "memory");
    const int c = lane & 7;
#pragma unroll
    for (int j = 0; j < 8; ++j) { const int n = (lane >> 3) + 8 * j; const LAS float* s = scr + (8 * c) * 65 + n;
        v4u o; o.x = pk2(s[0 * 65], s[1 * 65]); o.y = pk2(s[2 * 65], s[3 * 65]); o.z = pk2(s[4 * 65], s[5 * 65]); o.w = pk2(s[6 * 65], s[7 * 65]);
        if (n < t.ncols) *(GAS v4u*)(t.WT + (t.blocked ? pg8::blk_off(t.n0 + n, t.k0 + 8 * c, t.K) : (size_t)(t.n0 + n) * t.K + t.k0 + 8 * c)) = o; }
    LDS_WAIT(); asm volatile("" ::: "memory");
}
__device__ __forceinline__ void rms_row_to_bf16(int lane, const float* xrow, const float* w, bf16* orow) {
    const GAS f32x4* xr = (const GAS f32x4*)xrow + lane; const GAS f32x4* wr = (const GAS f32x4*)w + lane;
    f32x4 v[16]; float s = 0.f;
#pragma unroll
    for (int j = 0; j < 16; ++j) { v[j] = xr[64 * j]; s += (v[j].x * v[j].x + v[j].y * v[j].y) + (v[j].z * v[j].z + v[j].w * v[j].w); }
    const float rstd = 1.f / sqrtf(wave_sum(s) * (1.f / DM) + RMS_EPS);
    GAS unsigned long long* o8 = (GAS unsigned long long*)orow + lane;
#pragma unroll
    for (int j = 0; j < 16; ++j) { const f32x4 g = wr[64 * j];
        o8[64 * j] = (unsigned long long)pk2(v[j].x * rstd * g.x, v[j].y * rstd * g.y) | ((unsigned long long)pk2(v[j].z * rstd * g.z, v[j].w * rstd * g.w) << 32); }
}
__device__ __forceinline__ void p0_convert(Frame& F, const Args& A, int it0, int it1, int gw, int NGW) {
    LAS float* scr = (LAS float*)(F.lds + RING_OFF + F.wave * 16640);
    f32x4 va[16], vb[16];
    int it = it0 + gw; TItem ta, tb;
    if (it < it1) { ta = p0_item(A, it); p0_tload(ta, F.lane, va); }
    while (it < it1) {
        const int i1 = it + NGW; if (i1 < it1) { tb = p0_item(A, i1); p0_tload(tb, F.lane, vb); }
        p0_tstore(ta, F.lane, scr, va);
        if (i1 >= it1) break;
        const int i2 = i1 + NGW; if (i2 < it1) { ta = p0_item(A, i2); p0_tload(ta, F.lane, va); }
        p0_tstore(tb, F.lane, scr, vb);
        it = i2; }
}
__device__ __forceinline__ void p0_prologue(Frame& F, const Args& A) {
    unsigned char* ws = A.ws;
    const int gw = F.vcu * NWAVES + F.wave, NGW = F.G * NWAVES;
    p0_convert(F, A, 0, (F.G == 256) ? T_I_IN : T_NITEMS, gw, NGW);
    { GAS v4u* z = (GAS v4u*)(ws + WS_WIN + (size_t)NPROJ * DM * 2); const int nz = (LDP - NPROJ) * DM * 2 / 16;
      for (int i = gw * 64 + F.lane; i < nz; i += NGW * 64) z[i] = (v4u){0u, 0u, 0u, 0u}; }
    { float* rope = (float*)(ws + WS_ROPE);
      for (int i = gw * 64 + F.lane; i < SEQ * 8; i += NGW * 64) { const int pos = i >> 3, k = i & 7;
          const double inv = k == 0 ? 0x1.0000000000000p+0 : k == 1 ? 0x1.8d275e352b568p-3 : k == 2 ? 0x1.3411901f5fa45p-5 : k == 3 ? 0x1.ddee9c8c0aceep-8 : k == 4 ? 0x1.72ba43fff3717p-10 : k == 5 ? 0x1.1f91ef20d667dp-12 : k == 6 ? 0x1.be2188e4aa32fp-15 : 0x1.5a0f4e49b7c16p-17;
          const double ang = (double)pos * inv, nn = __builtin_rint(ang * 0x1.45f306dc9c883p-3);
          const float red = (float)__builtin_fma(-nn, 0x1.1a62633145c07p-52, __builtin_fma(-nn, 0x1.921fb54442d18p+2, ang));
          rope[pos * 16 + k] = __builtin_cosf(red); rope[pos * 16 + 8 + k] = __builtin_sinf(red); } }
    bf16* H = (bf16*)(ws + WS_H);
    for (int m = gw; m < M; m += NGW) { const float* xr = m < NTOK_P ? A.in[IN_XP] + (size_t)m * DM : A.in[IN_XS] + (size_t)(m - NTOK_P) * DM;
        rms_row_to_bf16(F.lane, xr, A.in[IN_NMIX], H + (size_t)m * DM); }
}


struct RowInfo { int samp, b, t, pos; };
__device__ __forceinline__ RowInfo row_info(int row) { RowInfo r; if (row < NTOK_P) { r.samp = 0; r.b = row >> 13; r.t = row & (SEQ - 1); r.pos = r.t; } else { const int q = row - NTOK_P; r.samp = 1; r.b = q >> 5; r.t = q & 31; r.pos = PAST + r.t; } return r; }

__device__ __forceinline__ void nv_prep(const Args& A, int vb, int tid, bool write_kv) {
    const int row = vb, lane = tid & 63, w = tid >> 6;
    const RowInfo ri = row_info(row);
    unsigned char* ws = A.ws; const bf16* proj = (const bf16*)(ws + WS_PROJ); const bf16* pr = proj + (size_t)row * LDP;
    const float* rope = (const float*)(ws + WS_ROPE) + ri.pos * 16; float* kn = (float*)(ws + WS_KN) + (size_t)row * 512; float* bc = (float*)(ws + WS_X1B) + (size_t)row * 2048;
    float* out = A.out;
    for (int hh = 0; hh < 2; ++hh) { const int h = w + 4 * hh;
        const float kv = bf2f(pr[OFF_K + h * 64 + lane]);
        const float ss = wave_sum(kv * kv);
        const float kk = kv * (1.f / sqrtf(ss * (1.f / 64.f) + RMS_EPS)) * A.in[IN_KNW][lane];
        const float partner = __shfl_xor(kk, 8);
        float o = kk;
        if (lane < 16) { const float c = rope[lane & 7], s = rope[8 + (lane & 7)]; o = (lane < 8) ? kk * c - partner * s : kk * c + partner * s; }
        kn[h * 64 + lane] = o;
        const float vv = bf2f(pr[OFF_V + h * 64 + lane]);
        if (!write_kv) continue;
        if (!ri.samp) { if (ri.t >= SEQ - 128) { const size_t off = ((size_t)(ri.b * 128 + ri.t - (SEQ - 128)) * 8 + h) * 64 + lane; out[O_KP + off] = o; out[O_VP + off] = vv; } }
        else { const size_t off = ((size_t)(ri.b * 128 + 96 + ri.t) * 8 + h) * 64 + lane; out[O_KS + off] = o; out[O_VS + off] = vv; }
    }
    if (ri.samp && write_kv) {
        for (int i = tid; i < 3 * 512; i += 256) { const int j = ri.t * 3 + i / 512, e = i % 512; const size_t src = ((size_t)(ri.b * 128 + 32 + j)) * 512 + e, dst = ((size_t)(ri.b * 128 + j)) * 512 + e;
            out[O_KS + dst] = A.in[IN_CK][src]; out[O_VS + dst] = A.in[IN_CV][src]; }
    }
    for (int i = 0; i < 8; ++i) { const int c2 = tid * 8 + i, cc = 2048 + c2; float acc = A.in[IN_CONVB][cc];
        for (int j = 0; j < 4; ++j) { const int tt = ri.t - 3 + j; float v;
            if (tt >= 0) v = bf2f(proj[(size_t)(row - 3 + j) * LDP + OFF_B + c2]); else v = ri.samp ? A.in[IN_SCONV][((size_t)ri.b * 3 + (3 + tt)) * 4096 + cc] : 0.f;
            acc += A.in[IN_CONVW][j * 4096 + cc] * v; }
        bc[c2] = silu_f(acc); }
    const int tl = ri.samp ? DSEQ : SEQ;
    if (ri.t >= tl - 3) { float* dst = out + (ri.samp ? O_CS : O_CP) + ((size_t)ri.b * 3 + (ri.t - (tl - 3))) * 4096;
        for (int c = tid; c < 4096; c += 256) dst[c] = bf2f(pr[c < 2048 ? OFF_XS + c : OFF_B + (c - 2048)]); }
}

template <bool SAMPLE> __device__ __forceinline__ void nv_attn(const Args& A, int vb, int tid) {
    const int lane = tid & 63, g = tid >> 6;
    unsigned char* ws = A.ws; const bf16* proj = (const bf16*)(ws + WS_PROJ); const float* knb = (const float*)(ws + WS_KN); bf16* mix = (bf16*)(ws + WS_H);
    int b, c, kvh, row, pos; bool valid = true;
    if (!SAMPLE) { const int blk = vb; b = blk >> 10; c = (blk >> 3) & 127; kvh = blk & 7; row = b * SEQ + c * 64 + lane; pos = c * 64 + lane; }
    else { const int blk = vb; b = blk >> 3; c = 0; kvh = blk & 7; const int t = lane & 31; valid = lane < 32; row = NTOK_P + b * DSEQ + t; pos = PAST + t; }
    const int qh = kvh * 4 + g;
    float q[64]; float ss = 0.f;
    for (int d = 0; d < 64; ++d) { q[d] = bf2f(proj[(size_t)row * LDP + OFF_Q + qh * 64 + d]); ss += q[d] * q[d]; }
    const float rs = 1.f / sqrtf(ss * (1.f / 64.f) + RMS_EPS);
    for (int d = 0; d < 64; ++d) q[d] = q[d] * rs * A.in[IN_QNW][d];
    { const float* rope = (const float*)(ws + WS_ROPE) + pos * 16;
      for (int i = 0; i < 8; ++i) { const float cs = rope[i], sn = rope[8 + i], x1 = q[i], x2 = q[8 + i]; q[i] = x1 * cs - x2 * sn; q[8 + i] = x2 * cs + x1 * sn; } }
    for (int d = 0; d < 64; ++d) q[d] *= 0.125f;
    float m = A.in[IN_SINK][qh], l = 1.f; float o[64];
    for (int d = 0; d < 64; ++d) o[d] = 0.f;
    const int nk = SAMPLE ? 160 : 192;
    for (int kk = 0; kk < nk; ++kk) {
        const float* kp; const float* vpf = nullptr; const bf16* vpb = nullptr;
        if (!SAMPLE) { const int kt = c * 64 - 128 + kk; if (kt < 0) continue; const size_t kr = (size_t)b * SEQ + kt; kp = knb + kr * 512 + kvh * 64; vpb = proj + kr * LDP + OFF_V + kvh * 64; }
        else if (kk < 128) { const size_t off = ((size_t)(b * 128 + kk) * 8 + kvh) * 64; kp = A.in[IN_CK] + off; vpf = A.in[IN_CV] + off; }
        else { const size_t kr = (size_t)NTOK_P + b * DSEQ + (kk - 128); kp = knb + kr * 512 + kvh * 64; vpb = proj + kr * LDP + OFF_V + kvh * 64; }
        float s = 0.f;
        for (int d = 0; d < 64; ++d) s += q[d] * kp[d];
        const float mn = fmaxf(m, s), corr = __expf(m - mn), p = __expf(s - mn);
        l = l * corr + p; m = mn;
        if (vpf) { for (int d = 0; d < 64; ++d) o[d] = o[d] * corr + p * vpf[d]; }
        else { for (int d = 0; d < 64; ++d) o[d] = o[d] * corr + p * bf2f(vpb[d]); }
    }
    if (valid) { const float il = 1.f / l; bf16* dst = mix + (size_t)row * DM + qh * 64;
        for (int d = 0; d < 64; d += 2) *(unsigned*)(dst + d) = pk2(o[d] * il, o[d + 1] * il); }
}

__device__ __forceinline__ void nv_scan(const Args& A, int vb_, int Tloop, int tid, LAS float* sBp) {
    LAS float (*sB)[256] = (LAS float (*)[256])sBp;
    const bool live = vb_ >= 0; const int vb = live ? vb_ : 0;
    const int p = tid & 63, r = tid >> 6;
    const int seq = vb >> 3, g = vb & 7, h = g * 4 + r, ch = h * 64 + p;
    const bool samp = seq >= NB_P; const int b = samp ? seq - NB_P : seq; const int T = samp ? DSEQ : SEQ; const int row0 = samp ? NTOK_P + b * DSEQ : b * SEQ;
    unsigned char* ws = A.ws; const bf16* proj = (const bf16*)(ws + WS_PROJ); const float* bc = (const float*)(ws + WS_X1B); const float* dtr = (const float*)(ws + WS_DT);
    bf16* ybuf = (bf16*)(ws + WS_WIN);
    const float a = -__expf(A.in[IN_ALOG][h]), dtb = A.in[IN_DTB][h], D = A.in[IN_DSKIP][h];
    const float w0 = A.in[IN_CONVW][ch], w1 = A.in[IN_CONVW][4096 + ch], w2 = A.in[IN_CONVW][8192 + ch], w3 = A.in[IN_CONVW][12288 + ch], cb = A.in[IN_CONVB][ch];
    float x1 = 0.f, x2 = 0.f, x3 = 0.f; float st[128];
    if (samp) { x1 = A.in[IN_SCONV][((size_t)b * 3 + 0) * 4096 + ch]; x2 = A.in[IN_SCONV][((size_t)b * 3 + 1) * 4096 + ch]; x3 = A.in[IN_SCONV][((size_t)b * 3 + 2) * 4096 + ch];
        const float* s0 = A.in[IN_SSSM] + ((size_t)(b * 32 + h) * 64 + p) * 128;
        for (int n = 0; n < 128; ++n) st[n] = s0[n]; }
    else { for (int n = 0; n < 128; ++n) st[n] = 0.f; }
    for (int t0 = 0; t0 < Tloop; t0 += 16) {
        __syncthreads();
        for (int i = tid; i < 16 * 256; i += 256) { const int tt = i >> 8, j = i & 255; sB[tt][j] = bc[(size_t)(row0 + t0 + tt) * 2048 + (j < 128 ? g * 128 + j : 1024 + g * 128 + (j - 128))]; }
        __syncthreads();
        for (int tt = 0; tt < 16; ++tt) { const int row = row0 + t0 + tt;
            const float xr = bf2f(proj[(size_t)row * LDP + OFF_XS + ch]);
            const float xc = silu_f(cb + w0 * x1 + w1 * x2 + w2 * x3 + w3 * xr); x1 = x2; x2 = x3; x3 = xr;
            const float dtv = softplus_f(dtr[(size_t)row * 32 + h] + dtb), dA = __expf(dtv * a), xdt = xc * dtv;
            float y = 0.f;
#pragma unroll
            for (int n = 0; n < 128; ++n) { st[n] = st[n] * dA + xdt * sB[tt][n]; y += sB[tt][128 + n] * st[n]; }
            y += xc * D;
            if (live) ybuf[(size_t)row * 2048 + ch] = (bf16)f2bf(y); }
    }
    float* so = A.out + (samp ? O_SS : O_SP) + ((size_t)(b * 32 + h) * 64 + p) * 128;
    if (live) { for (int n = 0; n < 128; ++n) so[n] = st[n]; }
}

__device__ __forceinline__ void nv_gate(const Args& A, int vb, int tid) {
    const int row = vb;
    unsigned char* ws = A.ws; const bf16* proj = (const bf16*)(ws + WS_PROJ); const bf16* ybuf = (const bf16*)(ws + WS_WIN); bf16* mix = (bf16*)(ws + WS_H);
    float gv[8]; float ss = 0.f;
    for (int i = 0; i < 8; ++i) { const int c = tid * 8 + i; const float y = bf2f(ybuf[(size_t)row * 2048 + c]), z = bf2f(proj[(size_t)row * LDP + OFF_Z + c]); gv[i] = y * silu_f(z); ss += gv[i] * gv[i]; }
#pragma unroll
    for (int o = 1; o < 32; o <<= 1) ss += __shfl_xor(ss, o);
    const float rs = 1.f / sqrtf(ss * (1.f / 256.f) + RMS_EPS);
    for (int i = 0; i < 8; i += 2) { const int c = tid * 8 + i; *(unsigned*)(mix + (size_t)row * DM + 2048 + c) = pk2(gv[i] * rs * A.in[IN_SNW][c], gv[i + 1] * rs * A.in[IN_SNW][c + 1]); }
}

namespace mx {
#if defined(PROBE_SEG)
#define MXS(k) do { if (blockIdx.x == 0 && tid == 0) { volatile LAS unsigned* m_ = (volatile LAS unsigned*)(lds + MISC_OFF) + 200; const unsigned t_ = (unsigned)__builtin_amdgcn_s_memrealtime(); m_[1 + (k)] += t_ - m_[0]; m_[0] = t_; } } while (0)
#else
#define MXS(k) do { } while (0)
#endif
typedef short v4i16 __attribute__((ext_vector_type(4)));
constexpr float LOG2E = 1.4426950408889634f;
__device__ __forceinline__ f32x4 mfma16(bf16x8 a, bf16x8 b, f32x4 c) { return __builtin_amdgcn_mfma_f32_16x16x32_bf16(a, b, c, 0, 0, 0); }
__device__ __forceinline__ bf16x8 ld_nat(LAS const unsigned char* img, int stride, int row0, int k0, int r16, int quad) {
    return *(LAS const bf16x8*)(img + (row0 + r16) * stride + (k0 + quad * 8) * 2);
}
__device__ __forceinline__ bf16x8 ld_trp(LAS const unsigned char* img, int stride, int krow0, int col0, int r16, int quad) {
    LAS const unsigned char* p = img + (krow0 + quad * 4 + (r16 >> 2)) * stride + (col0 + 4 * (r16 & 3)) * 2;
    const v4i16 lo = __builtin_amdgcn_ds_read_tr16_b64_v4i16((LAS v4i16*)p);
    const v4i16 hi = __builtin_amdgcn_ds_read_tr16_b64_v4i16((LAS v4i16*)(p + 16 * stride));
    return (bf16x8){lo[0], lo[1], lo[2], lo[3], hi[0], hi[1], hi[2], hi[3]};
}
typedef float f32x2_t __attribute__((ext_vector_type(2))); typedef __bf16 bf16x2_t __attribute__((ext_vector_type(2)));
__device__ __forceinline__ unsigned pkh(float lo, float hi) { const f32x2_t v = {lo, hi}; const bf16x2_t b = __builtin_convertvector(v, bf16x2_t); return __builtin_bit_cast(unsigned, b); }
__device__ __forceinline__ bf16x8 ld_trp_g(LAS const unsigned char* img, int stride, int krow0, int colbase, int r16, int quad, int t) {
    LAS const unsigned char* p = img + (krow0 + quad * 4 + (r16 >> 2)) * stride + (colbase + 16 * (r16 & 3) + 4 * t) * 2;
    const v4i16 lo = __builtin_amdgcn_ds_read_tr16_b64_v4i16((LAS v4i16*)p);
    const v4i16 hi = __builtin_amdgcn_ds_read_tr16_b64_v4i16((LAS v4i16*)(p + 16 * stride));
    return (bf16x8){lo[0], lo[1], lo[2], lo[3], hi[0], hi[1], hi[2], hi[3]};
}
__device__ __forceinline__ bf16x8 pack_p(const f32x4 lo, const f32x4 hi) {
    v4u w; w.x = pkh(lo[0], lo[1]); w.y = pkh(lo[2], lo[3]); w.z = pkh(hi[0], hi[1]); w.w = pkh(hi[2], hi[3]); return __builtin_bit_cast(bf16x8, w);
}
__device__ __forceinline__ void unpack8(const v4u w, float* x) { x[0] = bflo(w.x); x[1] = bfhi(w.x); x[2] = bflo(w.y); x[3] = bfhi(w.y); x[4] = bflo(w.z); x[5] = bfhi(w.z); x[6] = bflo(w.w); x[7] = bfhi(w.w); }
__device__ __forceinline__ v4u pack8(const float* x) { v4u w; w.x = pkh(x[0], x[1]); w.y = pkh(x[2], x[3]); w.z = pkh(x[4], x[5]); w.w = pkh(x[6], x[7]); return w; }

constexpr int AQ_OFF = 0, AK_OFF = 40960, AV_OFF = 40960 + 30720, A_STRIDE = 160;
struct AttnRegs { v4u q[4], k[4], v[3]; };
__device__ __forceinline__ void attn_load(const Args& A, int tid, int b, int c, int kvh, AttnRegs& R) {
    const int lane = tid & 63, w = __builtin_amdgcn_readfirstlane(tid >> 6);
    const bf16* proj = (const bf16*)(A.ws + WS_PROJ);
    const int vv = 32 * w + (lane & 31), hf = lane >> 5;
    { const int g = vv >> 6, tok = vv & 63; const v4u* src = (const v4u*)(proj + (size_t)(b * SEQ + c * 64 + tok) * LDP + OFF_Q + (kvh * 4 + g) * 64 + hf * 32);
#pragma unroll
      for (int j = 0; j < 4; ++j) R.q[j] = src[j]; }
    { const int vk = w < 6 ? vv : (lane & 31); int kt = c * 64 - 128 + vk; kt = kt < 0 ? 0 : kt; const v4u* src = (const v4u*)(proj + (size_t)(b * SEQ + kt) * LDP + OFF_K + kvh * 64 + hf * 32);
#pragma unroll
      for (int j = 0; j < 4; ++j) R.k[j] = src[j]; }
#pragma unroll
    for (int i = 0; i < 3; ++i) { const int id = tid + 512 * i, key = id >> 3, ch = id & 7; int kt = c * 64 - 128 + key; kt = kt < 0 ? 0 : kt;
        R.v[i] = *(const v4u*)(proj + (size_t)(b * SEQ + kt) * LDP + OFF_V + kvh * 64 + ch * 8); }
}
__device__ __forceinline__ void norm_rope_half(float* x, int hf, const float* nw, const float* rp, float scale) {
    float ss = 0.f;
#pragma unroll
    for (int i = 0; i < 32; ++i) ss += x[i] * x[i];
    ss += __shfl_xor(ss, 32);
    const float rs = scale / sqrtf(ss * (1.f / 64.f) + RMS_EPS);
#pragma unroll
    for (int i = 0; i < 8; ++i) { const f32x4 w4 = *(const f32x4*)(nw + hf * 32 + 4 * i);
        x[4 * i] = x[4 * i] * rs * w4[0]; x[4 * i + 1] = x[4 * i + 1] * rs * w4[1]; x[4 * i + 2] = x[4 * i + 2] * rs * w4[2]; x[4 * i + 3] = x[4 * i + 3] * rs * w4[3]; }
    if (hf == 0) {
#pragma unroll
        for (int i = 0; i < 8; ++i) { const float cs = rp[i], sn = rp[8 + i], x1 = x[i], x2 = x[8 + i]; x[i] = x1 * cs - x2 * sn; x[8 + i] = x2 * cs + x1 * sn; } }
}
__device__ __forceinline__ void attn_stage(const Args& A, LAS unsigned char* lds, int tid, int b, int c, int kvh, const AttnRegs& R) {
    const int lane = tid & 63, w = __builtin_amdgcn_readfirstlane(tid >> 6);
    const float* rope = (const float*)(A.ws + WS_ROPE);
    LAS unsigned char* Qs = lds + AQ_OFF; LAS unsigned char* Ks = lds + AK_OFF; LAS unsigned char* Vs = lds + AV_OFF;
    float* out = A.out;
    const int v = 32 * w + (lane & 31), hf = lane >> 5;
    { const int tok = v & 63; float x[32];
#pragma unroll
      for (int j = 0; j < 4; ++j) unpack8(R.q[j], x + 8 * j);
      norm_rope_half(x, hf, A.in[IN_QNW], rope + (c * 64 + tok) * 16, 0.125f * LOG2E);
#pragma unroll
      for (int j = 0; j < 4; ++j) *(LAS v4u*)(Qs + v * A_STRIDE + hf * 64 + j * 16) = pack8(x + 8 * j); }
    if (w < 6) { const int kt = c * 64 - 128 + v; float x[32];
#pragma unroll
        for (int j = 0; j < 4; ++j) unpack8(R.k[j], x + 8 * j);
        norm_rope_half(x, hf, A.in[IN_KNW], rope + (kt < 0 ? 0 : kt) * 16, kt < 0 ? 0.f : 1.f);
#pragma unroll
        for (int j = 0; j < 4; ++j) *(LAS v4u*)(Ks + v * A_STRIDE + hf * 64 + j * 16) = pack8(x + 8 * j);
        if (c >= 126 && v >= 128) { float* dst = out + O_KP + ((size_t)(b * 128 + (c - 126) * 64 + (v - 128)) * 8 + kvh) * 64 + hf * 32;
#pragma unroll
            for (int j = 0; j < 8; ++j) *(f32x4*)(dst + 4 * j) = (f32x4){x[4 * j], x[4 * j + 1], x[4 * j + 2], x[4 * j + 3]}; } }
#pragma unroll
    for (int i = 0; i < 3; ++i) { const int id = tid + 512 * i, key = id >> 3, ch = id & 7; const int kt = c * 64 - 128 + key;
        v4u raw = R.v[i]; if (kt < 0) raw = (v4u){0u, 0u, 0u, 0u};
        *(LAS v4u*)(Vs + key * A_STRIDE + ch * 16) = raw;
        if (c >= 126 && key >= 128) { float x[8]; unpack8(raw, x); float* dst = out + O_VP + ((size_t)(b * 128 + (c - 126) * 64 + (key - 128)) * 8 + kvh) * 64 + ch * 8;
            *(f32x4*)(dst) = (f32x4){x[0], x[1], x[2], x[3]}; *(f32x4*)(dst + 4) = (f32x4){x[4], x[5], x[6], x[7]}; } }
}
__device__ __forceinline__ void attn_stage_sample(const Args& A, LAS unsigned char* lds, int tid, int b, int kvh) {
    const int lane = tid & 63, w = __builtin_amdgcn_readfirstlane(tid >> 6);
    const bf16* proj = (const bf16*)(A.ws + WS_PROJ); const float* rope = (const float*)(A.ws + WS_ROPE);
    LAS unsigned char* Qs = lds + AQ_OFF; LAS unsigned char* Ks = lds + AK_OFF; LAS unsigned char* Vs = lds + AV_OFF;
    float* out = A.out; const int qrow0 = NTOK_P + b * DSEQ;
    const int v = 32 * w + (lane & 31), hf = lane >> 5;
    { const int g = v >> 6, tok = v & 63; const bool ok = tok < DSEQ; float x[32];
      const v4u* src = (const v4u*)(proj + (size_t)(qrow0 + (ok ? tok : 0)) * LDP + OFF_Q + (kvh * 4 + g) * 64 + hf * 32);
#pragma unroll
      for (int j = 0; j < 4; ++j) unpack8(src[j], x + 8 * j);
      norm_rope_half(x, hf, A.in[IN_QNW], rope + (PAST + (ok ? tok : 0)) * 16, ok ? 0.125f * LOG2E : 0.f);
#pragma unroll
      for (int j = 0; j < 4; ++j) *(LAS v4u*)(Qs + v * A_STRIDE + hf * 64 + j * 16) = pack8(x + 8 * j); }
    if (w < 6) { float x[32];
        if (w < 4) { const f32x4* src = (const f32x4*)(A.in[IN_CK] + ((size_t)(b * 128 + v) * 8 + kvh) * 64 + hf * 32);
#pragma unroll
            for (int j = 0; j < 8; ++j) { const f32x4 t = src[j]; x[4 * j] = t[0]; x[4 * j + 1] = t[1]; x[4 * j + 2] = t[2]; x[4 * j + 3] = t[3]; } }
        else if (w == 4) { const v4u* src = (const v4u*)(proj + (size_t)(qrow0 + (v - 128)) * LDP + OFF_K + kvh * 64 + hf * 32);
#pragma unroll
            for (int j = 0; j < 4; ++j) unpack8(src[j], x + 8 * j);
            norm_rope_half(x, hf, A.in[IN_KNW], rope + (PAST + (v - 128)) * 16, 1.f); }
        else {
#pragma unroll
            for (int i = 0; i < 32; ++i) x[i] = 0.f; }
#pragma unroll
        for (int j = 0; j < 4; ++j) *(LAS v4u*)(Ks + v * A_STRIDE + hf * 64 + j * 16) = pack8(x + 8 * j);
        if (v >= 32 && v < 160) { float* dst = out + O_KS + ((size_t)(b * 128 + (v - 32)) * 8 + kvh) * 64 + hf * 32;
#pragma unroll
            for (int j = 0; j < 8; ++j) *(f32x4*)(dst + 4 * j) = (f32x4){x[4 * j], x[4 * j + 1], x[4 * j + 2], x[4 * j + 3]}; } }
#pragma unroll
    for (int i = 0; i < 3; ++i) { const int id = tid + 512 * i, key = id >> 3, ch = id & 7; float x[8];
        if (key < 128) { const f32x4* src = (const f32x4*)(A.in[IN_CV] + ((size_t)(b * 128 + key) * 8 + kvh) * 64 + ch * 8); const f32x4 t0 = src[0], t1 = src[1];
            x[0] = t0[0]; x[1] = t0[1]; x[2] = t0[2]; x[3] = t0[3]; x[4] = t1[0]; x[5] = t1[1]; x[6] = t1[2]; x[7] = t1[3]; }
        else if (key < 160) unpack8(*(const v4u*)(proj + (size_t)(qrow0 + (key - 128)) * LDP + OFF_V + kvh * 64 + ch * 8), x);
        else {
#pragma unroll
            for (int e = 0; e < 8; ++e) x[e] = 0.f; }
        *(LAS v4u*)(Vs + key * A_STRIDE + ch * 16) = pack8(x);
        if (key >= 32 && key < 160) { float* dst = out + O_VS + ((size_t)(b * 128 + (key - 32)) * 8 + kvh) * 64 + ch * 8;
            *(f32x4*)(dst) = (f32x4){x[0], x[1], x[2], x[3]}; *(f32x4*)(dst + 4) = (f32x4){x[4], x[5], x[6], x[7]}; } }
}
template <bool SAMPLE>
__device__ __forceinline__ void attn_compute(const Args& A, LAS unsigned char* lds, int tid, int b, int c, int kvh) {
    const int lane = tid & 63, w = __builtin_amdgcn_readfirstlane(tid >> 6), r16 = lane & 15, quad = lane >> 4;
    bf16* mix = (bf16*)(A.ws + WS_H);
    LAS const unsigned char* Qs = lds + AQ_OFF; LAS const unsigned char* Ks = lds + AK_OFF; LAS const unsigned char* Vs = lds + AV_OFF;
    const int qrow0 = SAMPLE ? NTOK_P + b * DSEQ : b * SEQ + c * 64;
    const int g = w >> 1, qh = kvh * 4 + g;
    const float sink2 = A.in[IN_SINK][qh] * LOG2E;
    const int kmin = SAMPLE ? 0 : (c >= 2 ? 0 : 128 - 64 * c), kmax = SAMPLE ? 160 : 192;
#pragma unroll
    for (int qt = 0; qt < 2; ++qt) {
        const bf16x8 q0 = ld_nat(Qs, A_STRIDE, 32 * w + 16 * qt, 0, r16, quad), q1 = ld_nat(Qs, A_STRIDE, 32 * w + 16 * qt, 32, r16, quad);
        f32x4 s[12];
#pragma unroll
        for (int kt = 0; kt < 12; ++kt) { const bf16x8 k0 = ld_nat(Ks, A_STRIDE, 16 * kt, 0, r16, quad), k1 = ld_nat(Ks, A_STRIDE, 16 * kt, 32, r16, quad);
            s[kt] = mfma16(k1, q1, mfma16(k0, q0, (f32x4){0.f, 0.f, 0.f, 0.f}));
            if ((kt & 3) == 3) asm volatile("" ::: "memory"); }
        float mx = sink2;
        if (kmin > 0 || kmax < 192) {
#pragma unroll
            for (int kt = 0; kt < 12; ++kt)
#pragma unroll
                for (int j = 0; j < 4; ++j) { const int key = 16 * kt + 4 * quad + j; s[kt][j] = (key >= kmin && key < kmax) ? s[kt][j] : -1e30f; } }
#pragma unroll
        for (int kt = 0; kt < 12; ++kt) mx = fmaxf(fmaxf(mx, fmaxf(s[kt][0], s[kt][1])), fmaxf(s[kt][2], s[kt][3]));
        mx = fmaxf(mx, __shfl_xor(mx, 16)); mx = fmaxf(mx, __shfl_xor(mx, 32));
        float l = 0.f;
#pragma unroll
        for (int kt = 0; kt < 12; ++kt)
#pragma unroll
            for (int j = 0; j < 4; ++j) { const float p = __builtin_amdgcn_exp2f(s[kt][j] - mx); s[kt][j] = p; l += p; }
        l += __shfl_xor(l, 16); l += __shfl_xor(l, 32); l += __builtin_amdgcn_exp2f(sink2 - mx);
        f32x4 o[4];
#pragma unroll
        for (int dt = 0; dt < 4; ++dt) o[dt] = (f32x4){0.f, 0.f, 0.f, 0.f};
#pragma unroll
        for (int s2 = 0; s2 < 6; ++s2) { const bf16x8 pf = pack_p(s[2 * s2], s[2 * s2 + 1]);
#pragma unroll
            for (int dt = 0; dt < 4; ++dt) o[dt] = mfma16(ld_trp_g(Vs, A_STRIDE, 32 * s2, 0, r16, quad, dt), pf, o[dt]);
            if (s2 & 1) asm volatile("" ::: "memory"); }
        const int tok = (w & 1) * 32 + 16 * qt + r16; const float il = 1.f / l;
        if (!SAMPLE || tok < DSEQ) { bf16* dst = mix + (size_t)(qrow0 + tok) * DM + qh * 64 + 16 * quad;
            v4u w0, w1; w0.x = pkh(o[0][0] * il, o[0][1] * il); w0.y = pkh(o[0][2] * il, o[0][3] * il); w0.z = pkh(o[1][0] * il, o[1][1] * il); w0.w = pkh(o[1][2] * il, o[1][3] * il);
            w1.x = pkh(o[2][0] * il, o[2][1] * il); w1.y = pkh(o[2][2] * il, o[2][3] * il); w1.z = pkh(o[3][0] * il, o[3][1] * il); w1.w = pkh(o[3][2] * il, o[3][3] * il);
            *(v4u*)dst = w0; *(v4u*)(dst + 8) = w1; }
    }
}

constexpr int SX_OFF = 0, SXW_OFF = 34816, SB_OFF = 69632, SC_OFF = 88064, SDT_OFF = 106496, SAC_OFF = 107520, SPART_OFF = 108544;
constexpr int X_STRIDE = 544, BC_STRIDE = 288;
struct SsdRegs { v4u raw[11]; float dtr; };
__device__ __forceinline__ void ssd_cols(int cc, int g, int& pcol, int& cch) {
    if (cc < 32) { pcol = OFF_XS + g * 256 + cc * 8; cch = g * 256 + cc * 8; }
    else if (cc < 48) { pcol = OFF_B + g * 128 + (cc - 32) * 8; cch = 2048 + g * 128 + (cc - 32) * 8; }
    else { pcol = OFF_C + g * 128 + (cc - 48) * 8; cch = 3072 + g * 128 + (cc - 48) * 8; }
}
template <bool SAMPLE, bool WANT_C = true>
__device__ __forceinline__ void ssd_load(const Args& A, int tid, int b, int c, int g, SsdRegs& R) {
    const int lane = tid & 63, w = __builtin_amdgcn_readfirstlane(tid >> 6);
    const bf16* proj = (const bf16*)(A.ws + WS_PROJ); const float* dtr = (const float*)(A.ws + WS_DT);
    const int row0 = SAMPLE ? NTOK_P + b * DSEQ : b * SEQ + c * 64; constexpr int L = SAMPLE ? DSEQ : 64;
    int pcol, cch; ssd_cols(lane, g, pcol, cch);
#pragma unroll
    for (int j = 0; j < 11; ++j) { int lr = 8 * w - 3 + j;
        if (SAMPLE) lr = lr < 0 ? 0 : (lr >= L ? L - 1 : lr); else if (c == 0 && lr < 0) lr = 0;
        if (WANT_C || lane < 48) R.raw[j] = *(const v4u*)(proj + (size_t)(row0 + lr) * LDP + pcol); else R.raw[j] = (v4u){0u, 0u, 0u, 0u}; }
    { const int l = lane < L ? lane : L - 1; R.dtr = dtr[(size_t)(row0 + l) * 32 + g * 4 + (w & 3)]; }
}
template <bool SAMPLE, bool WANT_X, bool WANT_XW, bool WANT_C>
__device__ __forceinline__ void ssd_stage(const Args& A, LAS unsigned char* lds, int tid, int b, int c, int g, const SsdRegs& R) {
    const int lane = tid & 63, w = __builtin_amdgcn_readfirstlane(tid >> 6);
    LAS float* sdt = (LAS float*)(lds + SDT_OFF); LAS float* sac = (LAS float*)(lds + SAC_OFF);
    constexpr int L = SAMPLE ? DSEQ : 64;
    if (w < 4) { const int r = w, l = lane, h = g * 4 + r;
        const float dtv = (l < L) ? softplus_f(R.dtr + A.in[IN_DTB][h]) : 0.f;
        const float a = -__expf(A.in[IN_ALOG][h]);
        float cs = dtv * a;
#pragma unroll
        for (int o = 1; o < 64; o <<= 1) { const float t = __shfl_up(cs, o); if (lane >= o) cs += t; }
        sdt[l * 4 + r] = dtv; sac[l * 4 + r] = cs; }
    if (WANT_XW) __syncthreads();
    const int cc = lane, rb = w;
    int pcol, cch; ssd_cols(cc, g, pcol, cch);
    if (WANT_C || cc < 48) {
        float wg[4][8], bias[8], win[3][8];
#pragma unroll
        for (int j = 0; j < 4; ++j) { const f32x4 t0 = *(const f32x4*)(A.in[IN_CONVW] + j * 4096 + cch), t1 = *(const f32x4*)(A.in[IN_CONVW] + j * 4096 + cch + 4);
            wg[j][0] = t0[0]; wg[j][1] = t0[1]; wg[j][2] = t0[2]; wg[j][3] = t0[3]; wg[j][4] = t1[0]; wg[j][5] = t1[1]; wg[j][6] = t1[2]; wg[j][7] = t1[3]; }
        { const f32x4 t0 = *(const f32x4*)(A.in[IN_CONVB] + cch), t1 = *(const f32x4*)(A.in[IN_CONVB] + cch + 4);
          bias[0] = t0[0]; bias[1] = t0[1]; bias[2] = t0[2]; bias[3] = t0[3]; bias[4] = t1[0]; bias[5] = t1[1]; bias[6] = t1[2]; bias[7] = t1[3]; }
#pragma unroll
        for (int j = 0; j < 3; ++j) { const int lr = 8 * rb - 3 + j;
            unpack8(R.raw[j], win[j]);
            if (SAMPLE && lr < 0) { const float* sp = A.in[IN_SCONV] + ((size_t)b * 3 + (3 + lr)) * 4096 + cch; const f32x4 t0 = *(const f32x4*)sp, t1 = *(const f32x4*)(sp + 4);
                win[j][0] = t0[0]; win[j][1] = t0[1]; win[j][2] = t0[2]; win[j][3] = t0[3]; win[j][4] = t1[0]; win[j][5] = t1[1]; win[j][6] = t1[2]; win[j][7] = t1[3]; }
            const bool z = SAMPLE ? (lr >= L) : (lr < 0 && c == 0);
            if (z) {
#pragma unroll
                for (int e = 0; e < 8; ++e) win[j][e] = 0.f; } }
        const int r = (cc >> 3) & 3;
        const float alast = WANT_XW ? sac[63 * 4 + r] : 0.f;
#pragma unroll
        for (int i = 0; i < 8; ++i) { const int l = 8 * rb + i; float cur[8], val[8];
            unpack8(R.raw[3 + i], cur);
            if (SAMPLE && l >= L) {
#pragma unroll
                for (int e = 0; e < 8; ++e) cur[e] = 0.f; }
#pragma unroll
            for (int e = 0; e < 8; ++e) val[e] = silu_f(bias[e] + wg[0][e] * win[0][e] + wg[1][e] * win[1][e] + wg[2][e] * win[2][e] + wg[3][e] * cur[e]);
            if (cc < 32) {
                if (WANT_X) *(LAS v4u*)(lds + SX_OFF + l * X_STRIDE + cc * 16) = pack8(val);
                if (WANT_XW) { const float sc = __expf(alast - sac[l * 4 + r]) * sdt[l * 4 + r]; float xw[8];
#pragma unroll
                    for (int e = 0; e < 8; ++e) xw[e] = val[e] * sc;
                    *(LAS v4u*)(lds + SXW_OFF + l * X_STRIDE + cc * 16) = pack8(xw); }
            } else if (cc < 48) *(LAS v4u*)(lds + SB_OFF + l * BC_STRIDE + (cc - 32) * 16) = pack8(val);
            else *(LAS v4u*)(lds + SC_OFF + l * BC_STRIDE + (cc - 48) * 16) = pack8(val);
            if (SAMPLE ? (l >= DSEQ - 3 && l < DSEQ) : (c == 127 && l >= 61)) {
                float* dst = A.out + (SAMPLE ? O_CS : O_CP) + ((size_t)b * 3 + (l - (L - 3))) * 4096 + cch;
                *(f32x4*)dst = (f32x4){cur[0], cur[1], cur[2], cur[3]}; *(f32x4*)(dst + 4) = (f32x4){cur[4], cur[5], cur[6], cur[7]}; }
#pragma unroll
            for (int e = 0; e < 8; ++e) { win[0][e] = win[1][e]; win[1][e] = win[2][e]; win[2][e] = cur[e]; } }
    }
}
template <bool SAMPLE>
__device__ __forceinline__ void ssd_states(const Args& A, LAS unsigned char* lds, int tid, int b, int c, int g) {
    const int lane = tid & 63, w = __builtin_amdgcn_readfirstlane(tid >> 6), r16 = lane & 15, quad = lane >> 4;
    const int r = w >> 1, nh = w & 1, h = g * 4 + r;
    LAS const unsigned char* Bi = lds + SB_OFF; LAS const unsigned char* XWi = lds + SXW_OFF; LAS const float* sac = (LAS const float*)(lds + SAC_OFF);
    f32x4 acc[4][4];
    f32x4 s0v[4][4];
    if (SAMPLE) { const float* s0 = A.in[IN_SSSM] + ((size_t)(b * 32 + h) * 64) * 128;
#pragma unroll
        for (int nt = 0; nt < 4; ++nt)
#pragma unroll
            for (int pt = 0; pt < 4; ++pt) s0v[nt][pt] = *(const f32x4*)(s0 + (size_t)(16 * pt + r16) * 128 + nh * 64 + 16 * quad + 4 * nt);
        asm volatile("" ::: "memory"); }
#pragma unroll
    for (int nt = 0; nt < 4; ++nt)
#pragma unroll
        for (int pt = 0; pt < 4; ++pt) acc[nt][pt] = (f32x4){0.f, 0.f, 0.f, 0.f};
#pragma unroll
    for (int s2 = 0; s2 < 2; ++s2) { bf16x8 af[4], bf[4];
#pragma unroll
        for (int nt = 0; nt < 4; ++nt) af[nt] = ld_trp_g(Bi, BC_STRIDE, 32 * s2, nh * 64, r16, quad, nt);
#pragma unroll
        for (int pt = 0; pt < 4; ++pt) bf[pt] = ld_trp(XWi, X_STRIDE, 32 * s2, r * 64 + 16 * pt, r16, quad);
#pragma unroll
        for (int nt = 0; nt < 4; ++nt)
#pragma unroll
            for (int pt = 0; pt < 4; ++pt) acc[nt][pt] = mfma16(af[nt], bf[pt], acc[nt][pt]); }
    const float dec = __expf(sac[63 * 4 + r]);
    if (!SAMPLE) {
        bf16* st = (bf16*)(A.ws + WS_X1B) + ((size_t)((b * 128 + c) * 32 + h) * 64) * 128;
#pragma unroll
        for (int pt = 0; pt < 4; ++pt) { bf16* d = st + (size_t)(16 * pt + r16) * 128 + nh * 64 + 16 * quad;
            v4u w0, w1; w0.x = pkh(acc[0][pt][0], acc[0][pt][1]); w0.y = pkh(acc[0][pt][2], acc[0][pt][3]); w0.z = pkh(acc[1][pt][0], acc[1][pt][1]); w0.w = pkh(acc[1][pt][2], acc[1][pt][3]);
            w1.x = pkh(acc[2][pt][0], acc[2][pt][1]); w1.y = pkh(acc[2][pt][2], acc[2][pt][3]); w1.z = pkh(acc[3][pt][0], acc[3][pt][1]); w1.w = pkh(acc[3][pt][2], acc[3][pt][3]);
            *(v4u*)d = w0; *(v4u*)(d + 8) = w1; }
        if (nh == 0 && lane == 0) ((float*)(A.ws + WS_DECAY))[(b * 128 + c) * 32 + h] = dec;
    } else {
        float* so = A.out + O_SS + ((size_t)(b * 32 + h) * 64) * 128;
        asm volatile("" ::: "memory");
#pragma unroll
        for (int nt = 0; nt < 4; ++nt)
#pragma unroll
            for (int pt = 0; pt < 4; ++pt) { const size_t off = (size_t)(16 * pt + r16) * 128 + nh * 64 + 16 * quad + 4 * nt;
                *(f32x4*)(so + off) = s0v[nt][pt] * dec + acc[nt][pt]; }
    }
}
template <bool SAMPLE>
__device__ __forceinline__ void ssd_output(const Args& A, LAS unsigned char* lds, int tid, int b, int c, int g, int un = -1, SsdRegs* Rn = nullptr) {
    const int lane = tid & 63, w = __builtin_amdgcn_readfirstlane(tid >> 6), r16 = lane & 15, quad = lane >> 4;
    const int r = w >> 1, lh = w & 1, h = g * 4 + r;
    unsigned char* ws = A.ws; const bf16* proj = (const bf16*)(ws + WS_PROJ); bf16* mix = (bf16*)(ws + WS_H);
    LAS const unsigned char* Xi = lds + SX_OFF; LAS const unsigned char* Bi = lds + SB_OFF; LAS const unsigned char* Ci = lds + SC_OFF;
    LAS const float* sdt = (LAS const float*)(lds + SDT_OFF); LAS const float* sac = (LAS const float*)(lds + SAC_OFF); LAS float* spart = (LAS float*)(lds + SPART_OFF);
    const int row0 = SAMPLE ? NTOK_P + b * DSEQ : b * SEQ + c * 64;
    v2u zreg[2][4];
#pragma unroll
    for (int lti = 0; lti < 2; ++lti) { const int l = 32 * lh + 16 * lti + r16; const int lz = (!SAMPLE || l < DSEQ) ? l : 0;
#pragma unroll
        for (int pt = 0; pt < 4; ++pt) zreg[lti][pt] = *(const v2u*)(proj + (size_t)(row0 + lz) * LDP + OFF_Z + h * 64 + 16 * quad + 4 * pt); }
    bf16x8 pst[2][4];
    if (!SAMPLE) { asm volatile("" ::: "memory");
#pragma unroll
        for (int ks = 0; ks < 2; ++ks)
#pragma unroll
            for (int pt = 0; pt < 4; ++pt) pst[ks][pt] = *(const bf16x8*)((const bf16*)(ws + WS_X1B) + ((size_t)((b * 128 + c) * 32 + h) * 64 + 16 * (r16 >> 2) + 4 * pt + (r16 & 3)) * 128 + 32 * ks + 8 * quad);
        asm volatile("" ::: "memory"); }
    f32x4 gt[4][2];
#pragma unroll
    for (int st = 0; st < 4; ++st) { gt[st][0] = (f32x4){0.f, 0.f, 0.f, 0.f}; gt[st][1] = (f32x4){0.f, 0.f, 0.f, 0.f}; }
#pragma unroll
    for (int ks = 0; ks < 4; ++ks) { const bf16x8 c0 = ld_nat(Ci, BC_STRIDE, 32 * lh, 32 * ks, r16, quad), c1 = ld_nat(Ci, BC_STRIDE, 32 * lh + 16, 32 * ks, r16, quad);
#pragma unroll
        for (int st = 0; st < 4; ++st) { const bf16x8 bfr = ld_nat(Bi, BC_STRIDE, 16 * st, 32 * ks, r16, quad); gt[st][0] = mfma16(bfr, c0, gt[st][0]); gt[st][1] = mfma16(bfr, c1, gt[st][1]); } }
    float al[2];
#pragma unroll
    for (int lti = 0; lti < 2; ++lti) al[lti] = sac[(32 * lh + 16 * lti + r16) * 4 + r];
#pragma unroll
    for (int st = 0; st < 4; ++st)
#pragma unroll
        for (int j = 0; j < 4; ++j) { const int s = 16 * st + 4 * quad + j; const float as = sac[s * 4 + r], ds = sdt[s * 4 + r];
#pragma unroll
            for (int lti = 0; lti < 2; ++lti) { const int l = 32 * lh + 16 * lti + r16; gt[st][lti][j] = (s <= l) ? gt[st][lti][j] * __expf(al[lti] - as) * ds : 0.f; } }
    f32x4 ya[4][2];
#pragma unroll
    for (int pt = 0; pt < 4; ++pt) { ya[pt][0] = (f32x4){0.f, 0.f, 0.f, 0.f}; ya[pt][1] = (f32x4){0.f, 0.f, 0.f, 0.f}; }
#pragma unroll
    for (int s2 = 0; s2 < 2; ++s2) { const bf16x8 m0 = pack_p(gt[2 * s2][0], gt[2 * s2 + 1][0]), m1 = pack_p(gt[2 * s2][1], gt[2 * s2 + 1][1]);
#pragma unroll
        for (int pt = 0; pt < 4; ++pt) { const bf16x8 xa = ld_trp_g(Xi, X_STRIDE, 32 * s2, r * 64, r16, quad, pt); ya[pt][0] = mfma16(xa, m0, ya[pt][0]); ya[pt][1] = mfma16(xa, m1, ya[pt][1]); } }
    if (!SAMPLE) MXS(1);
    bf16x8 pst2[2][4];
    if (!SAMPLE) { asm volatile("" ::: "memory");
#pragma unroll
        for (int ks = 2; ks < 4; ++ks)
#pragma unroll
            for (int pt = 0; pt < 4; ++pt) pst2[ks - 2][pt] = *(const bf16x8*)((const bf16*)(ws + WS_X1B) + ((size_t)((b * 128 + c) * 32 + h) * 64 + 16 * (r16 >> 2) + 4 * pt + (r16 & 3)) * 128 + 32 * ks + 8 * quad);
        asm volatile("" ::: "memory"); }
    if (!SAMPLE) { asm volatile("" ::: "memory"); if (un >= 0) ssd_load<false>(A, tid, un >> 10, (un >> 3) & 127, un & 7, *Rn); asm volatile("" ::: "memory"); }
    {
        f32x4 oa[4][2];
#pragma unroll
        for (int pt = 0; pt < 4; ++pt) { oa[pt][0] = (f32x4){0.f, 0.f, 0.f, 0.f}; oa[pt][1] = (f32x4){0.f, 0.f, 0.f, 0.f}; }
#pragma unroll
        for (int ks = 0; ks < 4; ++ks) { const bf16x8 c0 = ld_nat(Ci, BC_STRIDE, 32 * lh, 32 * ks, r16, quad), c1 = ld_nat(Ci, BC_STRIDE, 32 * lh + 16, 32 * ks, r16, quad);
#pragma unroll
            for (int pt = 0; pt < 4; ++pt) { bf16x8 pa;
                if (!SAMPLE) { if (ks < 2) pa = pst[ks][pt]; else pa = pst2[ks - 2][pt]; }
                else { const float* sp = A.in[IN_SSSM] + ((size_t)(b * 32 + h) * 64 + 16 * (r16 >> 2) + 4 * pt + (r16 & 3)) * 128 + 32 * ks + 8 * quad; const f32x4 t0 = *(const f32x4*)sp, t1 = *(const f32x4*)(sp + 4);
                    v4u wv; wv.x = pkh(t0[0], t0[1]); wv.y = pkh(t0[2], t0[3]); wv.z = pkh(t1[0], t1[1]); wv.w = pkh(t1[2], t1[3]); pa = __builtin_bit_cast(bf16x8, wv); }
                oa[pt][0] = mfma16(pa, c0, oa[pt][0]); oa[pt][1] = mfma16(pa, c1, oa[pt][1]); }
            if (ks & 1) asm volatile("" ::: "memory"); }
#pragma unroll
        for (int lti = 0; lti < 2; ++lti) { const float el = __expf(al[lti]);
#pragma unroll
            for (int pt = 0; pt < 4; ++pt) ya[pt][lti] = ya[pt][lti] + oa[pt][lti] * el; }
    }
    const float D = A.in[IN_DSKIP][h];
    float ss[2];
#pragma unroll
    for (int lti = 0; lti < 2; ++lti) { const int l = 32 * lh + 16 * lti + r16; ss[lti] = 0.f;
#pragma unroll
        for (int pt = 0; pt < 4; ++pt) { const v2u xw = *(LAS const v2u*)(Xi + l * X_STRIDE + (r * 64 + 16 * quad + 4 * pt) * 2);
            const v2u zw = zreg[lti][pt];
            const float xv[4] = {bflo(xw.x), bfhi(xw.x), bflo(xw.y), bfhi(xw.y)}, zv[4] = {bflo(zw.x), bfhi(zw.x), bflo(zw.y), bfhi(zw.y)};
#pragma unroll
            for (int j = 0; j < 4; ++j) { const float y = ya[pt][lti][j] + xv[j] * D, gv = y * silu_f(zv[j]); ya[pt][lti][j] = gv; ss[lti] += gv * gv; } }
        ss[lti] += __shfl_xor(ss[lti], 16); ss[lti] += __shfl_xor(ss[lti], 32);
        if (quad == 0) spart[l * 4 + r] = ss[lti]; }
    __syncthreads();
    if (!SAMPLE) MXS(2);
#pragma unroll
    for (int lti = 0; lti < 2; ++lti) { const int l = 32 * lh + 16 * lti + r16;
        const f32x4 pr = *(LAS const f32x4*)(spart + l * 4); const float rs = 1.f / sqrtf(((pr[0] + pr[1]) + (pr[2] + pr[3])) * (1.f / 256.f) + RMS_EPS);
        if (!SAMPLE || l < DSEQ) {
            unsigned wv[8];
#pragma unroll
            for (int pt = 0; pt < 4; ++pt) { const f32x4 nw = *(const f32x4*)(A.in[IN_SNW] + h * 64 + 16 * quad + 4 * pt);
                wv[2 * pt] = pkh(ya[pt][lti][0] * rs * nw[0], ya[pt][lti][1] * rs * nw[1]); wv[2 * pt + 1] = pkh(ya[pt][lti][2] * rs * nw[2], ya[pt][lti][3] * rs * nw[3]); }
            bf16* d = mix + (size_t)(row0 + l) * DM + 2048 + h * 64 + 16 * quad;
            *(v4u*)d = (v4u){wv[0], wv[1], wv[2], wv[3]}; *(v4u*)(d + 8) = (v4u){wv[4], wv[5], wv[6], wv[7]}; } }
    __syncthreads();
}
template <bool DRY = false> __device__ __forceinline__ void ssd_pass(const Args& A, int gid) {
    const int n4 = gid & 31, p = (gid >> 5) & 63, h = (gid >> 11) & 31, b = gid >> 16;
    bf16* st = (bf16*)(A.ws + WS_X1B); const float* dec = (const float*)(A.ws + WS_DECAY);
    f32x4 run = (f32x4){0.f, 0.f, 0.f, 0.f};
    for (int c0 = 0; c0 < 128; c0 += 8) { v2u loc[8]; float d[8];
#pragma unroll
        for (int i = 0; i < 8; ++i) { const int c = c0 + i; loc[i] = *(const v2u*)(st + ((size_t)((b * 128 + c) * 32 + h) * 64 + p) * 128 + n4 * 4); d[i] = dec[(b * 128 + c) * 32 + h]; }
#pragma unroll
        for (int i = 0; i < 8; ++i) { const int c = c0 + i; v2u pv; pv.x = pkh(run[0], run[1]); pv.y = pkh(run[2], run[3]);
            *(v2u*)(st + ((size_t)((b * 128 + c) * 32 + h) * 64 + p) * 128 + n4 * 4) = DRY ? loc[i] : pv;
            run = run * d[i] + (f32x4){bflo(loc[i].x), bfhi(loc[i].x), bflo(loc[i].y), bfhi(loc[i].y)}; } }
    if (!DRY) *(f32x4*)(A.out + O_SP + ((size_t)(b * 32 + h) * 64 + p) * 128 + n4 * 4) = run;
    else if (run[0] == 12345.678f) *(f32x4*)(A.out + O_SP) = run;
}
}
#ifndef PROBE_DUP
#define PROBE_DUP -1
#endif
#define REP(k) for (int rep_ = 0; rep_ < ((PROBE_DUP == (k)) ? 2 : 1); ++rep_)
#ifndef IN_WGM
#define IN_WGM 8
#endif
#ifndef OUT_WGM
#define OUT_WGM 8
#endif
#ifndef DOWN_WGM
#define DOWN_WGM 8
#endif
#ifndef MIX_FAST_ATTN
#define MIX_FAST_ATTN 1
#endif
#ifndef MIX_FAST_SSD
#define MIX_FAST_SSD 1
#endif
#if defined(PROBE_CLK)
__device__ __forceinline__ void clk_mark(volatile LAS unsigned* m, int slot) {
    const unsigned long long c = __builtin_amdgcn_s_memtime(), r = __builtin_amdgcn_s_memrealtime();
    m[64 + slot * 4 + 0] = (unsigned)c; m[64 + slot * 4 + 1] = (unsigned)(c >> 32); m[64 + slot * 4 + 2] = (unsigned)r; m[64 + slot * 4 + 3] = (unsigned)(r >> 32);
}
#define CLK_MARK(k, slot) do { if (PROBE_CLK == (k) && blockIdx.x == 0 && F.tid == 0) clk_mark(F.MISC, slot); } while (0)
#else
#define CLK_MARK(k, slot) do { } while (0)
#endif
#if defined(PROBE_PH)
#define PH_STAMP(slot) do { if (blockIdx.x == 0 && F.tid == 0) F.MISC[160 + (slot)] = (unsigned)__builtin_amdgcn_s_memrealtime(); } while (0)
#else
#define PH_STAMP(slot) do { } while (0)
#endif
__global__ void __launch_bounds__(NWAVES * 64, 2) mega_fwd(Args args) {
    extern __shared__ __attribute__((aligned(16))) unsigned char lds[];
    Frame F;
    F.lds = (LAS unsigned char*)lds;
    F.MISC = (volatile LAS unsigned*)(F.lds + MISC_OFF);
    F.tid = threadIdx.x; F.lane = F.tid & 63; F.wave = __builtin_amdgcn_readfirstlane(F.tid >> 6);
    F.G = gridDim.x; { const int bx = blockIdx.x; F.vcu = (F.G % 8 == 0) ? (bx % 8) * (F.G / 8) + bx / 8 : bx; }
    unsigned char* ws = args.ws;
    F.ctl = (gu32*)(ws + WS_CTL);
    for (int u = F.tid; u < (LDS_BYTES - LDSCTL_OFF) / 4; u += NWAVES * 64) ((LAS unsigned*)(F.lds + LDSCTL_OFF))[u] = 0u;
    __syncthreads();
#if defined(PROBE_SUB)
    const int sub_ = args.ph_lo >= 100 ? args.ph_lo - 100 : -1;
    const int lo = sub_ >= 0 ? PH_MIXA : args.ph_lo, hi = sub_ >= 0 ? PH_MIXA + 1 : args.ph_hi;
#define SUB(k) (sub_ < 0 || sub_ == (k))
#else
    const int lo = args.ph_lo, hi = args.ph_hi;
#define SUB(k) true
#endif
    const bool multi = (hi - lo) > 1;
    XcdBarrier bar; bar.bar = (unsigned*)(F.ctl + CW_BAR) + args.li * XCD_BAR_WORDS; bar.x = 0; bar.st = nullptr;
    if (multi) bar = xcd_barrier_post((unsigned*)(F.ctl + CW_BAR) + args.li * XCD_BAR_WORDS, F.MISC + 8);
#define IN(k) (lo <= (k) && (k) < hi)
#define SEAM(k) do { if (IN(k) && IN((k) + 1)) xcd_barrier(bar); } while (0)

    PH_STAMP(PH_PRO);
    if (IN(PH_PRO)) { REP(PH_PRO) { p0_prologue(F, args); } SEAM(PH_PRO); }

    PH_STAMP(PH_INPROJ);
    if (IN(PH_INPROJ)) { CLK_MARK(PH_INPROJ, 0);
        const pg8::Gemm g = pg8::gemm_rm((const bf16*)(ws + WS_H), (const bf16*)(ws + WS_WIN), M, LDP, DM, DM); pg8::StaticOrder S; S.init(M, LDP, F.G, (int)blockIdx.x);
        pg8::EpiProj E{(bf16*)(ws + WS_PROJ), LDP, (float*)(ws + WS_DT), OFF_DT / 256};
        if (F.G != 256) { pg8::gemm_phase<pg8::EpiProj, pg8::StaticOrder, PG8_ALIGN, PG8_SP2>(F.lds + RING_OFF, g, S, E); }
        else {
            constexpr int NR = (M / 256) * (LDP / 256) / 256 + 1;
            const int sr = 1 + ((int)blockIdx.x & 7);
#if defined(IN_BAND)
            { pg8::BandIn S1{(int)blockIdx.x, 0, sr}; pg8::gemm_phase<pg8::EpiProj, pg8::BandIn, PG8_ALIGN, PG8_SP2>(F.lds + RING_OFF, g, S1, E); }
#else
            pg8::RangeOrder S1; S1.init(M, LDP, F.G, (int)blockIdx.x); S1.r0 = 0; S1.r1 = sr; S1.wgm = IN_WGM;
            pg8::gemm_phase<pg8::EpiProj, pg8::RangeOrder, PG8_ALIGN, PG8_SP2>(F.lds + RING_OFF, g, S1, E);
#endif
            __syncthreads();
            PH_STAMP(20);
            p0_convert(F, args, T_I_IN + T_I_OUT, T_NITEMS, (int)blockIdx.x * NWAVES + F.wave, F.G * NWAVES);
            { constexpr int NLIGHT = 256 - ((M / 256) * (LDP / 256) - (NR - 1) * 256);
              const int lc = (int)blockIdx.x - (256 - NLIGHT);
              if (lc >= 0) p0_convert(F, args, T_I_IN, T_I_IN + T_I_OUT, lc * NWAVES + F.wave, NLIGHT * NWAVES); }
            __syncthreads();
            PH_STAMP(21);
#if defined(IN_BAND)
            { pg8::BandIn S2{(int)blockIdx.x, sr, NR}; pg8::gemm_phase<pg8::EpiProj, pg8::BandIn, PG8_ALIGN, PG8_SP2>(F.lds + RING_OFF, g, S2, E); }
#else
            pg8::RangeOrder S2; S2.init(M, LDP, F.G, (int)blockIdx.x); S2.r0 = sr; S2.r1 = NR; S2.wgm = IN_WGM;
            pg8::gemm_phase<pg8::EpiProj, pg8::RangeOrder, PG8_ALIGN, PG8_SP2>(F.lds + RING_OFF, g, S2, E);
#endif
        }
        CLK_MARK(PH_INPROJ, 1);
        SEAM(PH_INPROJ);
    }
    PH_STAMP(PH_MIXA);
    if (IN(PH_MIXA)) { REP(PH_MIXA) {
#if !MIX_FAST_SSD || !MIX_FAST_ATTN
        { const int vt = F.tid & 255, half = F.tid >> 8;
          for (int vb = (int)blockIdx.x * 2 + half; vb < M; vb += F.G * 2) nv_prep(args, vb, vt, !MIX_FAST_ATTN); }
#endif
#if MIX_FAST_ATTN
        { int mt = F.tid; asm volatile("" : "+v"(mt)); LAS unsigned char* L = F.lds + RING_OFF; constexpr int NU = NB_P * 128 * 8; mx::AttnRegs R;
          int u = (int)blockIdx.x; if (u < NU) mx::attn_load(args, mt, u >> 10, (u >> 3) & 127, u & 7, R);
          if (!SUB(0)) u = NU;
          while (u < NU) { const int un = u + F.G;
              mx::attn_stage(args, L, mt, u >> 10, (u >> 3) & 127, u & 7, R); __syncthreads();
              if (un < NU) mx::attn_load(args, mt, un >> 10, (un >> 3) & 127, un & 7, R);
              mx::attn_compute<false>(args, L, mt, u >> 10, (u >> 3) & 127, u & 7); __syncthreads(); u = un; }
          asm volatile("" : "+v"(mt)); PH_STAMP(16);
          if (SUB(1)) for (int us = (int)blockIdx.x; us < NB_S * 8; us += F.G) { mx::attn_stage_sample(args, L, mt, us >> 3, us & 7); __syncthreads(); mx::attn_compute<true>(args, L, mt, us >> 3, 0, us & 7); __syncthreads(); } }
#endif
#if MIX_FAST_SSD
        PH_STAMP(17);
        { int mt = F.tid; asm volatile("" : "+v"(mt)); LAS unsigned char* L = F.lds + RING_OFF; constexpr int NU = NB_P * 128 * 8; mx::SsdRegs R;
          int u = (int)blockIdx.x; if (u < NU) mx::ssd_load<false, false>(args, mt, u >> 10, (u >> 3) & 127, u & 7, R);
          if (!SUB(2)) u = NU;
          while (u < NU) { const int un = u + F.G; const int b = u >> 10, c = (u >> 3) & 127, g = u & 7;
              mx::ssd_stage<false, false, true, false>(args, L, mt, b, c, g, R); __syncthreads();
              if (un < NU) mx::ssd_load<false, false>(args, mt, un >> 10, (un >> 3) & 127, un & 7, R);
              mx::ssd_states<false>(args, L, mt, b, c, g); __syncthreads(); u = un; }
          asm volatile("" : "+v"(mt)); PH_STAMP(18);
          if (SUB(3)) for (int us = (int)blockIdx.x; us < NB_S * 8; us += F.G) { const int b = us >> 3, g = us & 7;
              mx::ssd_load<true>(args, mt, b, 0, g, R); mx::ssd_stage<true, true, true, true>(args, L, mt, b, 0, g, R); __syncthreads();
              mx::ssd_states<true>(args, L, mt, b, 0, g); mx::ssd_output<true>(args, L, mt, b, 0, g); } }
#endif
        }
        SEAM(PH_MIXA);
    }
    PH_STAMP(PH_MIXB);
    if (IN(PH_MIXB)) {
#if MIX_FAST_SSD
        for (int gid = (int)blockIdx.x * 512 + F.tid; gid < NB_P * 32 * 64 * 32; gid += F.G * 512) mx::ssd_pass<false>(args, gid);
#if defined(PROBE_MIXB)
        __syncthreads();
        for (int gid = (int)blockIdx.x * 512 + F.tid; gid < NB_P * 32 * 64 * 32; gid += F.G * 512) mx::ssd_pass<true>(args, gid);
#endif
#else
        { const int vt = F.tid & 255, half = F.tid >> 8;
          LAS float* sB = (LAS float*)(F.lds + RING_OFF + half * 16384);
          constexpr int NSCAN = (NB_P + NB_S) * 8;
          for (int i = (int)blockIdx.x; 2 * i < NSCAN; i += F.G) { const int vb = 2 * i + half; nv_scan(args, vb < NSCAN ? vb : -1, (2 * i < NB_P * 8) ? SEQ : DSEQ, vt, sB); } }
#endif
#if !MIX_FAST_ATTN
        { const int vt = F.tid & 255, half = F.tid >> 8;
          for (int vb = (int)blockIdx.x * 2 + half; vb < NB_P * 128 * 8; vb += F.G * 2) nv_attn<false>(args, vb, vt);
          for (int vb = (int)blockIdx.x * 2 + half; vb < NB_S * 8; vb += F.G * 2) nv_attn<true>(args, vb, vt); }
#endif
        SEAM(PH_MIXB);
    }
    PH_STAMP(PH_MIXC);
    if (IN(PH_MIXC)) { REP(PH_MIXC) {
#if MIX_FAST_SSD
        { int mt = F.tid; asm volatile("" : "+v"(mt)); LAS unsigned char* L = F.lds + RING_OFF; constexpr int NU = NB_P * 128 * 8; mx::SsdRegs R;
          int u = (int)blockIdx.x; if (u < NU) mx::ssd_load<false>(args, mt, u >> 10, (u >> 3) & 127, u & 7, R);
          while (u < NU) { const int un = u + F.G; const int b = u >> 10, c = (u >> 3) & 127, g = u & 7;
#if defined(PROBE_SEG)
              { LAS unsigned char* lds = L; const int tid = F.tid; if (blockIdx.x == 0 && tid == 0) ((volatile LAS unsigned*)(lds + MISC_OFF))[200] = (unsigned)__builtin_amdgcn_s_memrealtime(); }
#endif
              mx::ssd_stage<false, true, false, true>(args, L, mt, b, c, g, R); __syncthreads();
#if defined(PROBE_SEG)
              { LAS unsigned char* lds = L; const int tid = F.tid; MXS(0); }
#endif
              mx::ssd_output<false>(args, L, mt, b, c, g, un < NU ? un : -1, &R);
#if defined(PROBE_SEG)
              { LAS unsigned char* lds = L; const int tid = F.tid; MXS(3); }
#endif
              u = un; } }
#else
        { const int vt = F.tid & 255, half = F.tid >> 8;
          for (int vb = (int)blockIdx.x * 2 + half; vb < M; vb += F.G * 2) nv_gate(args, vb, vt); }
#endif
        }
        SEAM(PH_MIXC);
    }
    PH_STAMP(PH_OUT);
    if (IN(PH_OUT)) { CLK_MARK(PH_OUT, 0);
        const pg8::Gemm g = pg8::gemm_rm((const bf16*)(ws + WS_H), (const bf16*)(ws + WS_WOUT), M, DM, DM, DM);
        pg8::EpiOut E{args.in[IN_XP], args.in[IN_XS], args.out + O_Y, (bf16*)(ws + WS_X1B), (float*)(ws + WS_PART), NTOK_P};
        if (F.G != 256) { pg8::StaticOrder S; S.init(M, DM, F.G, (int)blockIdx.x); pg8::gemm_phase<pg8::EpiOut, pg8::StaticOrder, PG8_ALIGN, PG8_SP2>(F.lds + RING_OFF, g, S, E); }
        else {
#if defined(OUT_BAND)
            { pg8::BandOrder Bo; Bo.init(DM, (int)blockIdx.x); Bo.tail = false; pg8::gemm_phase<pg8::EpiOut, pg8::BandOrder, PG8_ALIGN, PG8_SP2>(F.lds + RING_OFF, g, Bo, E); }
#else
            { pg8::StaticOrder S; S.init(NTOK_P, DM, F.G, (int)blockIdx.x); S.wgm = OUT_WGM;
              pg8::gemm_phase<pg8::EpiOut, pg8::StaticOrder, PG8_ALIGN, PG8_SP2>(F.lds + RING_OFF, g, S, E); }
#endif
            PH_STAMP(22);
            const int j = (int)blockIdx.x >> 2, q = (int)blockIdx.x & 3;
            const pg8::Gemm g2 = pg8::gemm_rm((const bf16*)(ws + WS_H) + q * (DM / 4), (const bf16*)(ws + WS_WOUT) + q * (DM / 4), M, DM, DM / 4, DM);
            pg8::PanelTail T{NTOK_P / 256 + (j >> 4), j & 15};
            pg8::EpiPart EP{(bf16*)(ws + WS_PROJ) + (size_t)blockIdx.x * 65536};
            pg8::gemm_phase<pg8::EpiPart, pg8::PanelTail, PG8_ALIGN, PG8_SP2>(F.lds + RING_OFF, g2, T, EP);
        }
        CLK_MARK(PH_OUT, 1);
        SEAM(PH_OUT);
    }
    PH_STAMP(PH_RSTD);
    if (IN(PH_RSTD)) {
        const float* part = (const float*)(ws + WS_PART); float* rstd = (float*)(ws + WS_RSTD);
        const int gw = F.vcu * NWAVES + F.wave, NGW = F.G * NWAVES;
        const int mlim = (F.G == 256) ? NTOK_P : M;
        for (int m0 = gw; m0 < mlim; m0 += 8 * NGW) { float pv[8];
#pragma unroll
            for (int k = 0; k < 8; ++k) { const int m = m0 + k * NGW; pv[k] = part[(size_t)(m < mlim ? m : m0) * 64 + F.lane]; }
#pragma unroll
            for (int k = 0; k < 8; ++k) { const int m = m0 + k * NGW; const float s = wave_sum(pv[k]); if (F.lane == 0 && m < mlim) rstd[m] = 1.f / sqrtf(s * (1.f / DM) + RMS_EPS); } }
        if (F.G == 256) {
            const bf16* slabs = (const bf16*)(ws + WS_PROJ); bf16* xb = (bf16*)(ws + WS_X1B);
            for (int r = gw; r < NTOK_S; r += NGW) { const int pmr = r >> 8, rr = r & 255; float ss = 0.f;
#pragma unroll
              for (int ph = 0; ph < 2; ++ph) { v2u sv[8][4]; f32x4 xv[8];
#pragma unroll
                for (int i = 0; i < 8; ++i) { const int pn = 8 * ph + i; const v2u* s = (const v2u*)(slabs + (size_t)(4 * (pmr * 16 + pn)) * 65536 + rr * 256) + F.lane;
                    sv[i][0] = s[0]; sv[i][1] = s[16384]; sv[i][2] = s[2 * 16384]; sv[i][3] = s[3 * 16384]; xv[i] = *((const f32x4*)(args.in[IN_XS] + (size_t)r * DM + pn * 256) + F.lane); }
                asm volatile("" ::: "memory");
#pragma unroll
                for (int i = 0; i < 8; ++i) { const int pn = 8 * ph + i; const v2u s0 = sv[i][0], s1 = sv[i][1], s2 = sv[i][2], s3 = sv[i][3];
                    const f32x4 ps = ((f32x4){bflo(s0.x), bfhi(s0.x), bflo(s0.y), bfhi(s0.y)} + (f32x4){bflo(s1.x), bfhi(s1.x), bflo(s1.y), bfhi(s1.y)}) + ((f32x4){bflo(s2.x), bfhi(s2.x), bflo(s2.y), bfhi(s2.y)} + (f32x4){bflo(s3.x), bfhi(s3.x), bflo(s3.y), bfhi(s3.y)});
                    const f32x4 v = xv[i] + ps;
                    ss += (v[0] * v[0] + v[1] * v[1]) + (v[2] * v[2] + v[3] * v[3]);
                    v2u w; w.x = pk2(v[0], v[1]); w.y = pk2(v[2], v[3]);
#if defined(X1B_BLK)
                    *(v2u*)(xb + pg8::blk_off(NTOK_P + r, pn * 256 + 4 * F.lane, DM)) = w;
#else
                    *((v2u*)(xb + (size_t)(NTOK_P + r) * DM + pn * 256) + F.lane) = w;
#endif
                    } }
                ss = wave_sum(ss); if (F.lane == 0) rstd[NTOK_P + r] = 1.f / sqrtf(ss * (1.f / DM) + RMS_EPS); }
        }
        SEAM(PH_RSTD);
    }
    PH_STAMP(PH_UP);
    if (IN(PH_UP)) { CLK_MARK(PH_UP, 0);
#if defined(PROBE_BND)
        if (F.tid == 0) { F.MISC[72] = 0u; F.MISC[80] = 1u; } __syncthreads();
#endif
#if defined(X1B_BLK)
        const pg8::Gemm g = pg8::gemm_blk((const bf16*)(ws + WS_X1B), (const bf16*)(ws + WS_WUP), M, FF, DM, DM);
#else
        const pg8::Gemm g = pg8::gemm_rm((const bf16*)(ws + WS_X1B), (const bf16*)(ws + WS_WUP), M, FF, DM, DM);
#endif
        pg8::StaticOrder S; S.init(M, FF, F.G, (int)blockIdx.x);
#if defined(UP_WGM)
        S.wgm = UP_WGM;
#endif
        pg8::EpiUp E{(bf16*)(ws + WS_U), FF, (const float*)(ws + WS_RSTD)};
#if defined(UP_BAND)
        if (F.G == 256 && M == 68 * 256) { pg8::BandOrder Bo; Bo.init(FF, (int)blockIdx.x); pg8::gemm_phase<pg8::EpiUp, pg8::BandOrder, PG8_ALIGN, PG8_SP2>(F.lds + RING_OFF, g, Bo, E); }
        else
#endif
        REP(PH_UP) { pg8::gemm_phase<pg8::EpiUp, pg8::StaticOrder, PG8_ALIGN, PG8_SP2>(F.lds + RING_OFF, g, S, E); }
#if defined(PROBE_SHADOW_UP)
        {
          struct ZeroOrder : pg8::StaticOrder { __device__ __forceinline__ bool next(int i, pg8::Unit& u) const { pg8::Unit t; const bool ok = pg8::StaticOrder::next(i, t); u.pm = PROBE_SHADOW_UP == 0 ? 0 : t.pm; u.pn = PROBE_SHADOW_UP == 0 ? 0 : t.pn; return ok; } };
          ZeroOrder Z; Z.init(M, FF, F.G, (int)blockIdx.x);
          pg8::ShEpi SE{pg8::EpiUp{PROBE_SHADOW_UP == 2 ? (bf16*)(ws + WS_KN) : (bf16*)(ws + WS_U), FF, (const float*)(ws + WS_RSTD)}};
          pg8::gemm_phase<pg8::ShEpi, ZeroOrder, PG8_ALIGN, PG8_SP2>(F.lds + RING_OFF, g, Z, SE); }
#endif
        CLK_MARK(PH_UP, 1);
#if defined(PROBE_BND)
        __syncthreads(); if (F.tid == 0) F.MISC[80] = 0u;
#endif
        SEAM(PH_UP);
    }
    PH_STAMP(PH_DOWN);
    if (IN(PH_DOWN)) { CLK_MARK(PH_DOWN, 0);
        constexpr int NU = (M / 256) * (DM / 256), NFULL = NU / 256, NLEFT = NU - NFULL * 256;
        const bool split = (F.G == 256) && (NLEFT * 4 == 256);
        const pg8::Gemm g = pg8::gemm_blk((const bf16*)(ws + WS_U), (const bf16*)(ws + WS_WDN), M, DM, FF, FF);
        pg8::EpiDown E{args.out + O_Y, (const bf16*)(ws + WS_X1B)};
        if (!split) { pg8::StaticOrder S; S.init(M, DM, F.G, (int)blockIdx.x); pg8::gemm_phase<pg8::EpiDown, pg8::StaticOrder, PG8_ALIGN, PG8_SP2>(F.lds + RING_OFF, g, S, E); }
        else {
#if defined(DOWN_BAND)
#if defined(DOWN_BAND16)
            { pg8::BandDown Bo{(int)blockIdx.x}; pg8::gemm_phase<pg8::EpiDown, pg8::BandDown, PG8_ALIGN, PG8_SP2>(F.lds + RING_OFF, g, Bo, E); }
#else
            { pg8::BandOrder Bo; Bo.init(DM, (int)blockIdx.x); Bo.tail = false; pg8::gemm_phase<pg8::EpiDown, pg8::BandOrder, PG8_ALIGN, PG8_SP2>(F.lds + RING_OFF, g, Bo, E); }
#endif
#else
            pg8::HeadOrder S; S.init(M, DM, F.G, (int)blockIdx.x); S.nr = NFULL; S.wgm = DOWN_WGM;
            pg8::gemm_phase<pg8::EpiDown, pg8::HeadOrder, PG8_ALIGN, PG8_SP2>(F.lds + RING_OFF, g, S, E);
#endif
#if defined(PROBE_SHADOW_DOWN)
            { pg8::ShEpiD SD{pg8::EpiDown{(float*)(ws + WS_KN), (const bf16*)(ws + WS_X1B)}}; pg8::gemm_phase<pg8::ShEpiD, pg8::HeadOrder, PG8_ALIGN, PG8_SP2>(F.lds + RING_OFF, g, S, SD); }
#endif
            const int q = (int)blockIdx.x & 3;
            const pg8::Gemm g2 = pg8::gemm_blk((const bf16*)(ws + WS_U) + (size_t)q * (FF / 4 / 64) * 16384, (const bf16*)(ws + WS_WDN) + (size_t)q * (FF / 4 / 64) * 16384, M, DM, FF / 4, FF);
            pg8::EpiPart EP{(bf16*)(ws + WS_WUP) + (size_t)blockIdx.x * 65536};
#if defined(DOWN_BAND)
            { const int j = (int)blockIdx.x >> 2; pg8::PanelTail T{64 + (j & 3), j >> 2}; pg8::gemm_phase<pg8::EpiPart, pg8::PanelTail, PG8_ALIGN, PG8_SP2>(F.lds + RING_OFF, g2, T, EP); }
#else
            pg8::TailOrder T; T.init(M, DM, 256, (int)blockIdx.x >> 2); T.round = NFULL; T.wgm = DOWN_WGM;
            pg8::gemm_phase<pg8::EpiPart, pg8::TailOrder, PG8_ALIGN, PG8_SP2>(F.lds + RING_OFF, g2, T, EP);
#endif
        }
        CLK_MARK(PH_DOWN, 1);
        SEAM(PH_DOWN);
    }
    PH_STAMP(PH_DOWN2);
    if (IN(PH_DOWN2)) {
        constexpr int NU = (M / 256) * (DM / 256), NFULL = NU / 256, NLEFT = NU - NFULL * 256;
        if ((F.G == 256) && (NLEFT * 4 == 256)) {
            const bf16* slabs = (const bf16*)(ws + WS_WUP); float* out = args.out + O_Y;
            const int gw = (int)blockIdx.x * NWAVES + F.wave;
            for (int rr = gw; rr < NLEFT * 256; rr += F.G * NWAVES) { const int j = rr >> 8, r = rr & 255;
#if defined(DOWN_BAND)
                pg8::Unit u; u.pm = 64 + (j & 3); u.pn = j >> 2;
#else
                pg8::StaticOrder T; T.init(M, DM, 256, j); T.wgm = DOWN_WGM; pg8::Unit u; T.next(NFULL, u);
#endif
                f32x4* o = (f32x4*)(out + (size_t)(u.pm * 256 + r) * DM + u.pn * 256) + F.lane;
#if defined(X1B_BLK)
                const v2u xw = *(const v2u*)((const bf16*)(ws + WS_X1B) + pg8::blk_off(u.pm * 256 + r, u.pn * 256 + 4 * F.lane, DM));
#else
                const v2u xw = *((const v2u*)((const bf16*)(ws + WS_X1B) + (size_t)(u.pm * 256 + r) * DM + u.pn * 256) + F.lane);
#endif
                const v2u* s = (const v2u*)(slabs + (size_t)(4 * j) * 65536 + r * 256) + F.lane;
                const v2u s0 = s[0], s1 = s[16384], s2 = s[2 * 16384], s3 = s[3 * 16384];
                const f32x4 ps = ((f32x4){bflo(s0.x), bfhi(s0.x), bflo(s0.y), bfhi(s0.y)} + (f32x4){bflo(s1.x), bfhi(s1.x), bflo(s1.y), bfhi(s1.y)}) + ((f32x4){bflo(s2.x), bfhi(s2.x), bflo(s2.y), bfhi(s2.y)} + (f32x4){bflo(s3.x), bfhi(s3.x), bflo(s3.y), bfhi(s3.y)});
                *o = (f32x4){bflo(xw.x), bfhi(xw.x), bflo(xw.y), bfhi(xw.y)} + ps; }
        }
    }
    PH_STAMP(PH_N);
#if defined(PROBE_SEG)
    if (blockIdx.x == 0 && F.tid == 0) {
        const unsigned d = F.MISC[200 + 1 + (PROBE_SEG)];
        const unsigned long long t0 = __builtin_amdgcn_s_memrealtime(), wait = (unsigned long long)d * (PROBE_MUL);
        while (__builtin_amdgcn_s_memrealtime() - t0 < wait) __builtin_amdgcn_s_sleep(8);
    }
#endif
#if defined(PROBE_PH)
    if (blockIdx.x == 0 && F.tid == 0) {
        const unsigned d = F.MISC[160 + (PROBE_PH_B)] - F.MISC[160 + (PROBE_PH_A)];
        const unsigned long long t0 = __builtin_amdgcn_s_memrealtime(), wait = (unsigned long long)d * (PROBE_MUL);
        while (__builtin_amdgcn_s_memrealtime() - t0 < wait) __builtin_amdgcn_s_sleep(8);
    }
#endif
#if defined(PROBE_BND)
    if (blockIdx.x == 0 && F.tid == 0) {
        unsigned sum = 0;
        for (int u = 1; u < 17; ++u) sum += (F.MISC[72 + 32 + u * 3 + 0] - F.MISC[72 + 32 + (u - 1) * 3 + 2]) - (F.MISC[72 + 32 + u * 3 + 1] - F.MISC[72 + 32 + u * 3 + 0]);
        const unsigned long long t0 = __builtin_amdgcn_s_memrealtime(), wait = (unsigned long long)sum * 100ull / 336ull;
        while (__builtin_amdgcn_s_memrealtime() - t0 < wait) __builtin_amdgcn_s_sleep(8);
    }
#endif
#if defined(PROBE_CLK)
    if (blockIdx.x == 0 && F.tid == 0) {
        const unsigned long long c0 = F.MISC[64] | ((unsigned long long)F.MISC[65] << 32), r0 = F.MISC[66] | ((unsigned long long)F.MISC[67] << 32);
        const unsigned long long c1 = F.MISC[68] | ((unsigned long long)F.MISC[69] << 32), r1 = F.MISC[70] | ((unsigned long long)F.MISC[71] << 32);
        const unsigned long long mhz = (c1 - c0) * 100ull / (r1 - r0 + 1);
        const unsigned long long t0 = __builtin_amdgcn_s_memrealtime(), wait = mhz * 50ull;
        while (__builtin_amdgcn_s_memrealtime() - t0 < wait) __builtin_amdgcn_s_sleep(8);
    }
#endif
#undef IN
#undef SEAM
}

extern "C" void kernel_launch(void* const* d_in, const int* in_sizes, int n_in, void* d_out, int out_size, void* d_ws, size_t ws_size, hipStream_t stream) {
    static int grid = 0;
    if (grid == 0) {
        if (n_in != 21 || in_sizes[0] != NTOK_P * DM || (size_t)out_size != O_END || ws_size < WS_END) {
            fprintf(stderr, "kernel_launch: unexpected shapes: n_in %d in0 %d out %d ws %zu (need %zu)\n", n_in, n_in > 0 ? in_sizes[0] : -1, out_size, ws_size, (size_t)WS_END); grid = -1; return; }
        int dev = 0, cus = 0, per_cu = 0;
        if (hipGetDevice(&dev) != hipSuccess || hipDeviceGetAttribute(&cus, hipDeviceAttributeMultiprocessorCount, dev) != hipSuccess) { grid = -1; return; }
        if (hipFuncSetAttribute((const void*)mega_fwd, hipFuncAttributeMaxDynamicSharedMemorySize, LDS_BYTES) != hipSuccess) { fprintf(stderr, "kernel_launch: hipFuncSetAttribute failed\n"); grid = -1; return; }
        if (hipOccupancyMaxActiveBlocksPerMultiprocessor(&per_cu, (const void*)mega_fwd, NWAVES * 64, LDS_BYTES) != hipSuccess || per_cu < 1)
            fprintf(stderr, "kernel_launch: note: occupancy query reports %d workgroups per CU\n", per_cu);
        (void)hipGetLastError();
        grid = cus;
    }
    if (grid < 0) return;
    if (hipMemsetAsync((char*)d_ws + WS_CTL, 0, CTL_ZERO_BYTES, stream) != hipSuccess) return;
    Args a{};
    for (int i = 0; i < 21; ++i) a.in[i] = (const float*)d_in[i];
    a.out = (float*)d_out; a.ws = (unsigned char*)d_ws; int n_launch = 0;
#define MEGA(lo_, hi_) do { a.ph_lo = (lo_); a.ph_hi = (hi_); a.li = n_launch++; hipLaunchKernelGGL(mega_fwd, dim3(grid), dim3(NWAVES * 64), LDS_BYTES, stream, a); } while (0)
#if defined(PROBE_SUB)
    MEGA(PH_PRO, PH_MIXA + 1); MEGA(100 + PROBE_SUB, 100 + PROBE_SUB + 1); MEGA(PH_MIXA + 1, PH_N);
#elif defined(PROBE_SPLIT)
    MEGA(PH_PRO, PROBE_SPLIT + 1); MEGA(PROBE_SPLIT, PROBE_SPLIT + 1); if (PROBE_SPLIT + 1 < PH_N) MEGA(PROBE_SPLIT + 1, PH_N);
#else
    MEGA(PH_PRO, PH_N);
#endif
    const hipError_t le = hipPeekAtLastError();
    if (le != hipSuccess) fprintf(stderr, "kernel_launch: launch failed: %s\n", hipGetErrorName(le));
}
```
